# Optimizing an MI355X kernel written in HIP

```python
import jax, jax.numpy as jnp
from jax import lax
import numpy as np

D_MODEL = 1024
BATCH = 2
SEQ = 16384
DEPTH = 2

HEAD_DIM = 64
FOX_HEADS = 6
DIL_KV_HEADS = 4
DIL_PATTERNS = ((128, 1), (512, 4), (2048, 16))
DIL_Q_HEADS = DIL_KV_HEADS * len(DIL_PATTERNS)
MOBA_HEADS = 6
MOBA_BLOCK = 256
MOBA_TOPK = 3
Q_BLOCK = 128
ROPE_THETA = 500000.0
ROPE_DIM = HEAD_DIM // 4
N_BRANCH = 3
D_FF = -(-(8 * D_MODEL) // (3 * 256)) * 256
LN_EPS = 1e-5
DN_ALPHA = (2 * DEPTH) ** 0.25
DN_BETA = (8 * DEPTH) ** -0.25
IN_SIZES = (FOX_HEADS * HEAD_DIM, FOX_HEADS * HEAD_DIM, FOX_HEADS * HEAD_DIM, FOX_HEADS,
            DIL_Q_HEADS * HEAD_DIM, DIL_KV_HEADS * HEAD_DIM, DIL_KV_HEADS * HEAD_DIM,
            MOBA_HEADS * HEAD_DIM, MOBA_HEADS * HEAD_DIM, MOBA_HEADS * HEAD_DIM,
            N_BRANCH * D_MODEL)
D_IN = sum(IN_SIZES)

kernel_name = 'hybrid_fox_dilated_moba_deepnorm'


def _layer_norm(x, g, b):
    xf = x.astype(jnp.float32)
    mu = jnp.mean(xf, axis=-1, keepdims=True)
    var = jnp.mean(jnp.square(xf - mu), axis=-1, keepdims=True)
    y = (xf - mu) * lax.rsqrt(var + LN_EPS)
    return (y * g + b).astype(x.dtype)


def _heads(t, n):
    b, s, _ = t.shape
    return t.reshape(b, s, n, HEAD_DIM).transpose(0, 2, 1, 3)


def _merge_heads(t):
    b, h, s, d = t.shape
    return t.transpose(0, 2, 1, 3).reshape(b, s, h * d)


def _rope(t, pos):
    half = ROPE_DIM // 2
    inv_freq = jnp.power(ROPE_THETA, -jnp.arange(half, dtype=jnp.float32) * 2.0 / ROPE_DIM)
    ang = pos.astype(jnp.float32)[:, None] * inv_freq[None, :]
    cos, sin = jnp.cos(ang), jnp.sin(ang)
    t1 = t[..., :half].astype(jnp.float32)
    t2 = t[..., half:ROPE_DIM].astype(jnp.float32)
    rot = jnp.concatenate([t1 * cos - t2 * sin, t2 * cos + t1 * sin], axis=-1).astype(t.dtype)
    return jnp.concatenate([rot, t[..., ROPE_DIM:]], axis=-1)


def _fox_attention(q, k, v, f_logit):
    b, h, s, d = q.shape
    scale = d ** -0.5
    logf = jax.nn.log_sigmoid(f_logit.astype(jnp.float32)).transpose(0, 2, 1)
    c = jnp.cumsum(logf, axis=-1)
    nq = s // Q_BLOCK
    qb = q.reshape(b, h, nq, Q_BLOCK, d).transpose(2, 0, 1, 3, 4)
    cb = c.reshape(b, h, nq, Q_BLOCK).transpose(2, 0, 1, 3)
    kpos = jnp.arange(s)

    def block(args):
        i, qi, ci = args
        logits = jnp.einsum('bhqd,bhkd->bhqk', qi, k, preferred_element_type=jnp.float32) * scale
        logits = logits + ci[..., None] - c[:, :, None, :]
        qpos = i * Q_BLOCK + jnp.arange(Q_BLOCK)
        logits = jnp.where(kpos[None, :] <= qpos[:, None], logits, -jnp.inf)
        p = jax.nn.softmax(logits, axis=-1)
        return jnp.einsum('bhqk,bhkd->bhqd', p.astype(v.dtype), v, preferred_element_type=jnp.float32)

    o = lax.map(block, (jnp.arange(nq), qb, cb))
    return o.transpose(1, 2, 0, 3, 4).reshape(b, h, s, d)


def _dilated_group(q, k, v, window, dil):
    b, h, s, d = q.shape
    scale = d ** -0.5
    span = window // dil
    n_prev = -(-span // Q_BLOCK)
    length = -(-s // (dil * Q_BLOCK)) * Q_BLOCK
    pad = length * dil - s
    nb = length // Q_BLOCK

    def strided(t):
        t = jnp.pad(t, ((0, 0), (0, 0), (0, pad), (0, 0)))
        t = t.reshape(b, h, length, dil, d).transpose(0, 1, 3, 2, 4)
        return t.reshape(b, h, dil, nb, Q_BLOCK, d)

    def band(t):
        tp = jnp.pad(t, ((0, 0), (0, 0), (0, 0), (n_prev, 0), (0, 0), (0, 0)))
        return jnp.concatenate([tp[:, :, :, j:j + nb] for j in range(n_prev + 1)], axis=4)

    qs = strided(q)
    kb, vb = band(strided(k)), band(strided(v))
    logits = jnp.einsum('bhrnqd,bhrnkd->bhrnqk', qs, kb, preferred_element_type=jnp.float32) * scale
    qi = jnp.arange(Q_BLOCK)[:, None] + n_prev * Q_BLOCK
    ki = jnp.arange((n_prev + 1) * Q_BLOCK)[None, :]
    dist = qi - ki
    abs_k = jnp.arange(nb)[:, None, None] * Q_BLOCK - n_prev * Q_BLOCK + ki[None]
    mask = (dist >= 0)[None] & (dist <= span)[None] & (abs_k >= 0)
    logits = jnp.where(mask, logits, -jnp.inf)
    m = jnp.max(logits, axis=-1, keepdims=True)
    p = jnp.exp(logits - m)
    den = jnp.sum(p, axis=-1, keepdims=True)
    o = jnp.einsum('bhrnqk,bhrnkd->bhrnqd', p.astype(v.dtype), vb, preferred_element_type=jnp.float32) / den
    lse = m[..., 0] + jnp.log(den[..., 0])
    o = o.reshape(b, h, dil, length, d).transpose(0, 1, 3, 2, 4).reshape(b, h, length * dil, d)[:, :, :s]
    lse = lse.reshape(b, h, dil, length).transpose(0, 1, 3, 2).reshape(b, h, length * dil)[:, :, :s]
    return o, lse


def _dilated_attention(q, k, v):
    outs, lses = [], []
    for g, (window, dil) in enumerate(DIL_PATTERNS):
        o, l = _dilated_group(q[:, g * DIL_KV_HEADS:(g + 1) * DIL_KV_HEADS], k, v, window, dil)
        outs.append(o)
        lses.append(l)
    w = jax.nn.softmax(jnp.stack(lses, axis=0), axis=0)
    return jnp.sum(w[..., None] * jnp.stack(outs, axis=0), axis=0)


def _moba_attention(q, k, v):
    b, h, s, d = q.shape
    scale = d ** -0.5
    nkb = -(-s // MOBA_BLOCK)
    sp = nkb * MOBA_BLOCK
    kp = jnp.pad(k, ((0, 0), (0, 0), (0, sp - s), (0, 0)))
    vp = jnp.pad(v, ((0, 0), (0, 0), (0, sp - s), (0, 0)))
    kb = kp.reshape(b, h, nkb, MOBA_BLOCK, d)
    vb = vp.reshape(b, h, nkb, MOBA_BLOCK, d)
    kmean = jnp.mean(kb.astype(jnp.float32), axis=3)
    topk = min(MOBA_TOPK, nkb)
    nq = s // Q_BLOCK
    qb = q.reshape(b, h, nq, Q_BLOCK, d).transpose(2, 0, 1, 3, 4)
    bi = jnp.arange(b)[:, None, None, None]
    hi = jnp.arange(h)[None, :, None, None]

    def block(args):
        i, qi = args
        qpos = i * Q_BLOCK + jnp.arange(Q_BLOCK)
        own_blk = (i * Q_BLOCK) // MOBA_BLOCK
        gate = jnp.einsum('bhqd,bhnd->bhqn', qi.astype(jnp.float32), kmean)
        past = jnp.arange(nkb)[None, :] < (qpos // MOBA_BLOCK)[:, None]
        gate = jnp.where(past, gate, -jnp.inf)
        gval, idx = lax.top_k(gate, topk)
        valid = jnp.isfinite(gval)
        ksel = kb[bi, hi, idx]
        vsel = vb[bi, hi, idx]
        s_sel = jnp.einsum('bhqd,bhqnkd->bhqnk', qi, ksel, preferred_element_type=jnp.float32) * scale
        s_sel = jnp.where(valid[..., None], s_sel, -jnp.inf).reshape(b, h, Q_BLOCK, topk * MOBA_BLOCK)
        kown = lax.dynamic_slice_in_dim(kp, own_blk * MOBA_BLOCK, MOBA_BLOCK, axis=2)
        vown = lax.dynamic_slice_in_dim(vp, own_blk * MOBA_BLOCK, MOBA_BLOCK, axis=2)
        s_own = jnp.einsum('bhqd,bhkd->bhqk', qi, kown, preferred_element_type=jnp.float32) * scale
        kpos_own = own_blk * MOBA_BLOCK + jnp.arange(MOBA_BLOCK)
        s_own = jnp.where(kpos_own[None, :] <= qpos[:, None], s_own, -jnp.inf)
        p = jax.nn.softmax(jnp.concatenate([s_sel, s_own], axis=-1), axis=-1)
        p_sel = p[..., :topk * MOBA_BLOCK].reshape(b, h, Q_BLOCK, topk, MOBA_BLOCK).astype(v.dtype)
        p_own = p[..., topk * MOBA_BLOCK:].astype(v.dtype)
        return (jnp.einsum('bhqnk,bhqnkd->bhqd', p_sel, vsel, preferred_element_type=jnp.float32)
                + jnp.einsum('bhqk,bhkd->bhqd', p_own, vown, preferred_element_type=jnp.float32))

    o = lax.map(block, (jnp.arange(nq), qb))
    return o.transpose(1, 2, 0, 3, 4).reshape(b, h, s, d)


def _mixer(x, w_in, b_f, w_pa, w_pb, w_pc, w_o):
    bsz, s, _ = x.shape
    pos = jnp.arange(s)
    hcat = jnp.einsum('bsd,de->bse', x, w_in)
    offsets = [int(o) for o in np.cumsum(IN_SIZES)[:-1]]
    qa, ka, va, fa, qb, kb, vb, qc, kc, vc, g = jnp.split(hcat, offsets, axis=-1)
    ya = _fox_attention(_heads(qa, FOX_HEADS), _heads(ka, FOX_HEADS), _heads(va, FOX_HEADS), fa + b_f)
    yb = _dilated_attention(_rope(_heads(qb, DIL_Q_HEADS), pos), _rope(_heads(kb, DIL_KV_HEADS), pos),
                            _heads(vb, DIL_KV_HEADS))
    yc = _moba_attention(_rope(_heads(qc, MOBA_HEADS), pos), _rope(_heads(kc, MOBA_HEADS), pos),
                         _heads(vc, MOBA_HEADS))
    gates = jax.nn.sigmoid(g.astype(jnp.float32)).reshape(bsz, s, N_BRANCH, D_MODEL)
    merged = (gates[:, :, 0] * jnp.einsum('bse,ed->bsd', _merge_heads(ya).astype(x.dtype), w_pa)
              + gates[:, :, 1] * jnp.einsum('bse,ed->bsd', _merge_heads(yb).astype(x.dtype), w_pb)
              + gates[:, :, 2] * jnp.einsum('bse,ed->bsd', _merge_heads(yc).astype(x.dtype), w_pc))
    return jnp.einsum('bsd,de->bse', merged.astype(x.dtype), w_o)


def _swiglu(x, w_gate, w_up, w_down):
    hid = jax.nn.silu(jnp.einsum('bsd,df->bsf', x, w_gate)) * jnp.einsum('bsd,df->bsf', x, w_up)
    return jnp.einsum('bsf,fd->bsd', hid, w_down)


def setup_inputs(seed: int = 0) -> dict:
    key = jax.random.key(seed)
    ks = jax.random.split(key, 20)
    f32 = jnp.float32
    in_scales = (1.0, 1.0, DN_BETA, 0.1, 1.0, 1.0, DN_BETA, 1.0, 1.0, DN_BETA, 1.0)
    col_scale = jnp.concatenate([jnp.full((n,), sc, f32) for n, sc in zip(IN_SIZES, in_scales)])
    wa = FOX_HEADS * HEAD_DIM
    wb = DIL_KV_HEADS * HEAD_DIM
    wc = MOBA_HEADS * HEAD_DIM
    nrm = lambda k, shp: jax.random.normal(k, shp, f32)
    return {
        'x': nrm(ks[0], (BATCH, SEQ, D_MODEL)),
        'ln_in_g': 1.0 + 0.02 * nrm(ks[1], (D_MODEL,)),
        'ln_in_b': 0.02 * nrm(ks[2], (D_MODEL,)),
        'w_in': nrm(ks[3], (DEPTH, D_MODEL, D_IN)) * D_MODEL ** -0.5 * col_scale,
        'b_f': jax.random.uniform(ks[4], (DEPTH, FOX_HEADS), f32, 2.0, 6.0),
        'w_pa': nrm(ks[5], (DEPTH, wa, D_MODEL)) * wa ** -0.5,
        'w_pb': nrm(ks[6], (DEPTH, wb, D_MODEL)) * wb ** -0.5,
        'w_pc': nrm(ks[7], (DEPTH, wc, D_MODEL)) * wc ** -0.5,
        'w_o': nrm(ks[8], (DEPTH, D_MODEL, D_MODEL)) * D_MODEL ** -0.5 * DN_BETA,
        'ln1_g': 1.0 + 0.02 * nrm(ks[9], (DEPTH, D_MODEL)),
        'ln1_b': 0.02 * nrm(ks[10], (DEPTH, D_MODEL)),
        'w_gate': nrm(ks[11], (DEPTH, D_MODEL, D_FF)) * D_MODEL ** -0.5,
        'w_up': nrm(ks[12], (DEPTH, D_MODEL, D_FF)) * D_MODEL ** -0.5,
        'w_down': nrm(ks[13], (DEPTH, D_FF, D_MODEL)) * D_FF ** -0.5 * DN_BETA,
        'ln2_g': 1.0 + 0.02 * nrm(ks[14], (DEPTH, D_MODEL)),
        'ln2_b': 0.02 * nrm(ks[15], (DEPTH, D_MODEL)),
    }


def reference(x, ln_in_g, ln_in_b, w_in, b_f, w_pa, w_pb, w_pc, w_o, ln1_g, ln1_b,
              w_gate, w_up, w_down, ln2_g, ln2_b):
    x = _layer_norm(x, ln_in_g, ln_in_b)
    for l in range(DEPTH):
        mix = _mixer(x, w_in[l], b_f[l], w_pa[l], w_pb[l], w_pc[l], w_o[l])
        x = _layer_norm(DN_ALPHA * x + mix, ln1_g[l], ln1_b[l])
        ffn = _swiglu(x, w_gate[l], w_up[l], w_down[l])
        x = _layer_norm(DN_ALPHA * x + ffn, ln2_g[l], ln2_b[l])
    return x
```

```cpp
#include <hip/hip_runtime.h>
#include <hip/hip_cooperative_groups.h>
#include <hip/hip_bf16.h>
#include <cstdio>
#include <cstdint>
#include <cmath>
namespace cg = cooperative_groups;

#define LAS __attribute__((address_space(3)))
typedef unsigned short bf16_t;
typedef short bf16x8 __attribute__((ext_vector_type(8)));
typedef short s16x4 __attribute__((ext_vector_type(4)));
typedef float f32x2 __attribute__((ext_vector_type(2)));
typedef float f32x4 __attribute__((ext_vector_type(4)));
typedef float f32x16 __attribute__((ext_vector_type(16)));
typedef unsigned u32x4 __attribute__((ext_vector_type(4)));
typedef unsigned u32x2 __attribute__((ext_vector_type(2)));

constexpr int BATCH = 2, SEQ = 16384, DM = 1024, T = BATCH * SEQ, DEPTH = 2, DFF = 2816, DIN = 6662;
constexpr int NQKV = 3584, NG = 3072;
constexpr float LN_EPS = 1e-5f;
constexpr float DN_ALPHA = 1.4142135623730951f;
constexpr float LOG2E = 1.4426950408889634f;
constexpr float C2 = 0.125f * LOG2E;
constexpr int NWAVES = 8;

typedef __bf16 bf16x2_t __attribute__((ext_vector_type(2)));
__device__ __forceinline__ unsigned cvt_pk_bf16(float lo, float hi) { f32x2 v = {lo, hi}; bf16x2_t b = __builtin_convertvector(v, bf16x2_t); return __builtin_bit_cast(unsigned, b); }
__device__ __forceinline__ float bf2f(unsigned short b) { return __uint_as_float(((unsigned)b) << 16); }
__device__ __forceinline__ float bflo(unsigned w) { return __uint_as_float(w << 16); }
__device__ __forceinline__ float bfhi(unsigned w) { return __uint_as_float(w & 0xffff0000u); }

namespace pg8 {
constexpr int BM = 256, BK = 64, HALF = 128, HTB = HALF * BK * 2, STAGE_BYTES = 8 * HTB, NXCD = 8, WGM = 8;
__host__ __device__ __forceinline__ int lds_byte(int r, int c) { const int st = (r >> 4) * 2 + (c >> 5), rr = r & 15, cc = c & 31, ob = rr * 64 + cc * 2; return st * 1024 + (ob ^ (((ob >> 9) & 1) << 5)); }
__host__ __device__ __forceinline__ void stage_rc(int b, int& R, int& C) { const int st = b / 1024, sb = b % 1024, swz = sb ^ (((sb >> 9) & 1) << 5); R = (st >> 1) * 16 + swz / 64; C = (st & 1) * 32 + (swz % 64) / 2; }
__host__ __device__ __forceinline__ int perm32(int rho) { const int n = rho >> 4, i = rho & 15; return 8 * (i >> 2) + 4 * n + (i & 3); }

struct Unit { int pm, pn; };
struct Gemm { const bf16_t* A; const bf16_t* Bt; int lda, ldb, K; };

struct StaticOrder {
    int nM, nN, nwg, G, c;
    __host__ __device__ void init(int M, int N, int G_, int c_) { nM = M / BM; nN = N / BM; nwg = nM * nN; G = G_; c = c_; }
    __host__ __device__ bool next(int i, Unit& u) const {
        const long L = (long)i * G + c; if (L >= nwg) return false;
        int wgid = (int)L; { const int q = nwg / NXCD, r = nwg % NXCD, xcd = wgid % NXCD, off = wgid / NXCD; wgid = (xcd < r ? xcd * (q + 1) : r * (q + 1) + (xcd - r) * q) + off; }
        const int nig = WGM * nN, gid = wgid / nig, fm = gid * WGM, gsz = (nM - fm) < WGM ? (nM - fm) : WGM;
        u.pm = fm + ((wgid % nig) % gsz); u.pn = (wgid % nig) / gsz; return true;
    }
};

template <class Epi, bool ALIGN_EPI>
__device__ __forceinline__ void gemm_phase(LAS unsigned char* lds, const Gemm g, const StaticOrder& S, const Epi& E) {
    int tid_ = threadIdx.x; asm volatile("" : "+v"(tid_));
    const int tid = tid_, wid = __builtin_amdgcn_readfirstlane(tid >> 6), lane = tid & 63, wr = wid >> 2, wc = wid & 3, fr = lane & 15, fq = lane >> 4;
    const int nt = g.K / BK;
    unsigned voffA[2], voffB[2];
#pragma unroll
    for (int i = 0; i < 2; ++i) { int R, C; stage_rc(tid * 16 + i * 8192, R, C); const int Rb = (R & ~31) + perm32(R & 31);
        voffA[i] = (unsigned)(R * g.lda + C) * 2u; voffB[i] = (unsigned)(Rb * g.ldb + C) * 2u; }
    const size_t kstep = (size_t)(BK * 2);
    const size_t hA = (size_t)HALF * g.lda * 2, hB = (size_t)HALF * g.ldb * 2;
    const size_t tA = 2 * hA, tB = 2 * hB;
    const unsigned ldsw = (unsigned)wid * 1024u;
    const int aoff = lds_byte(wr * 64 + fr, fq * 8), boff = lds_byte(wc * 32 + fr, fq * 8);
#define PG8_SA(b, h) (((b) * 2 + (h)) * HTB)
#define PG8_SB(b, h) ((4 + (b) * 2 + (h)) * HTB)
#define PG8_STAGE(bufoff, gbase, voff) do { _Pragma("unroll") for (int _i = 0; _i < 2; ++_i) \
        __builtin_amdgcn_global_load_lds((const unsigned*)((const char*)(gbase) + (voff)[_i]), (LAS unsigned*)(lds + (bufoff) + ldsw + _i * 8192), 16, 0, 0); } while (0)
#define PG8_LDA(dst, b, h) do { _Pragma("unroll") for (int m = 0; m < 4; ++m) _Pragma("unroll") for (int k = 0; k < 2; ++k) dst[m][k] = *(const LAS bf16x8*)(lds + PG8_SA(b, h) + aoff + m * 2048 + k * 1024); } while (0)
#define PG8_LDB(dst, b, h) do { _Pragma("unroll") for (int n = 0; n < 2; ++n) _Pragma("unroll") for (int k = 0; k < 2; ++k) dst[n][k] = *(const LAS bf16x8*)(lds + PG8_SB(b, h) + boff + n * 2048 + k * 1024); } while (0)
#define PG8_MMA(ai, bj, At, Bt) do { __builtin_amdgcn_s_setprio(1); _Pragma("unroll") for (int m = 0; m < 4; ++m) _Pragma("unroll") for (int n = 0; n < 2; ++n) _Pragma("unroll") for (int k = 0; k < 2; ++k) \
        acc[ai][bj][m][n] = __builtin_amdgcn_mfma_f32_16x16x32_bf16(Bt[n][k], At[m][k], acc[ai][bj][m][n], 0, 0, 0); __builtin_amdgcn_s_setprio(0); } while (0)
#define PG8_WAIT_V(n) asm volatile("s_waitcnt vmcnt(" #n ")" ::: "memory")
#define PG8_WAIT_L(n) asm volatile("s_waitcnt lgkmcnt(" #n ")" ::: "memory")
#define PG8_BAR __builtin_amdgcn_s_barrier()
#define PG8_SCHED __builtin_amdgcn_sched_barrier(0)
    Unit cur, nxt; int ui = 0;
    if (!S.next(0, cur)) return;
    f32x4 acc[2][2][4][2];
#pragma unroll
    for (int a = 0; a < 2; ++a)
#pragma unroll
        for (int b = 0; b < 2; ++b)
#pragma unroll
            for (int m = 0; m < 4; ++m)
#pragma unroll
                for (int n = 0; n < 2; ++n) acc[a][b][m][n] = (f32x4){0.f, 0.f, 0.f, 0.f};
    bf16x8 At[4][2], B0[2][2], B1[2][2];
    const char* cA = (const char*)g.A + (size_t)cur.pm * tA; const char* cB = (const char*)g.Bt + (size_t)cur.pn * tB;
    PG8_STAGE(PG8_SB(0, 0), cB, voffB); PG8_STAGE(PG8_SB(0, 1), cB + hB, voffB); PG8_STAGE(PG8_SA(0, 0), cA, voffA); PG8_STAGE(PG8_SA(0, 1), cA + hA, voffA);
    if (wr == 1) PG8_BAR;
    PG8_WAIT_V(2); PG8_BAR;
    PG8_STAGE(PG8_SB(1, 0), cB + kstep, voffB); PG8_STAGE(PG8_SA(1, 0), cA + kstep, voffA); PG8_STAGE(PG8_SB(1, 1), cB + hB + kstep, voffB);
    PG8_WAIT_V(6); PG8_BAR;
    for (;;) {
        const bool has_next = S.next(ui + 1, nxt);
        const char* nA = has_next ? (const char*)g.A + (size_t)nxt.pm * tA : cA; const char* nB = has_next ? (const char*)g.Bt + (size_t)nxt.pn * tB : cB;
        for (int t = 0; t < nt; t += 2) {
            const bool last = (t == nt - 2);
            const char* a1 = cA + (size_t)(t + 1) * kstep;
            const char* a2 = last ? nA : cA + (size_t)(t + 2) * kstep; const char* b2 = last ? nB : cB + (size_t)(t + 2) * kstep;
            const char* a3 = a2 + kstep; const char* b3 = b2 + kstep;
            PG8_LDB(B0, 0, 0); PG8_LDB(B1, 0, 1); PG8_SCHED; PG8_LDA(At, 0, 0); PG8_STAGE(PG8_SA(1, 1), a1 + hA, voffA);
            PG8_WAIT_V(8); PG8_WAIT_L(0); PG8_BAR; PG8_MMA(0, 0, At, B0); PG8_MMA(0, 1, At, B1); PG8_BAR; PG8_SCHED;
            PG8_LDA(At, 0, 1); PG8_STAGE(PG8_SB(0, 0), b2, voffB); PG8_STAGE(PG8_SB(0, 1), b2 + hB, voffB); PG8_STAGE(PG8_SA(0, 0), a2, voffA);
            PG8_WAIT_V(8); PG8_WAIT_L(0); PG8_BAR; PG8_MMA(1, 0, At, B0); PG8_MMA(1, 1, At, B1); PG8_BAR; PG8_SCHED;
            PG8_LDB(B0, 1, 0); PG8_LDB(B1, 1, 1); PG8_SCHED; PG8_LDA(At, 1, 0); PG8_STAGE(PG8_SA(0, 1), a2 + hA, voffA);
            PG8_WAIT_V(8); PG8_WAIT_L(0); PG8_BAR; PG8_MMA(0, 0, At, B0); PG8_MMA(0, 1, At, B1); PG8_BAR; PG8_SCHED;
            PG8_LDA(At, 1, 1); PG8_STAGE(PG8_SB(1, 0), b3, voffB); PG8_STAGE(PG8_SB(1, 1), b3 + hB, voffB); PG8_STAGE(PG8_SA(1, 0), a3, voffA);
            PG8_WAIT_V(8); PG8_WAIT_L(0); PG8_BAR; PG8_MMA(1, 0, At, B0); PG8_MMA(1, 1, At, B1); PG8_BAR; PG8_SCHED;
        }
        if constexpr (ALIGN_EPI) { if (wr == 0) PG8_BAR; }
        E(acc, cur, wr, wc, fr, fq);
        if (!has_next) break;
#pragma unroll
        for (int a = 0; a < 2; ++a)
#pragma unroll
            for (int b = 0; b < 2; ++b)
#pragma unroll
                for (int m = 0; m < 4; ++m)
#pragma unroll
                    for (int n = 0; n < 2; ++n) acc[a][b][m][n] = (f32x4){0.f, 0.f, 0.f, 0.f};
        cur = nxt; cA = nA; cB = nB; ++ui;
        if constexpr (ALIGN_EPI) { if (wr == 1) PG8_BAR; }
    }
    PG8_WAIT_V(0);
    if constexpr (!ALIGN_EPI) { if (wr == 0) PG8_BAR; }
    PG8_BAR;
#undef PG8_SA
#undef PG8_SB
#undef PG8_STAGE
#undef PG8_LDA
#undef PG8_LDB
#undef PG8_MMA
#undef PG8_WAIT_V
#undef PG8_WAIT_L
#undef PG8_BAR
#undef PG8_SCHED
}
}
namespace attn_body {
using bf16=__hip_bfloat16;
using bf16x8=__attribute__((ext_vector_type(8)))short;
using s16x4=__attribute__((ext_vector_type(4)))short;
using f32x16=__attribute__((ext_vector_type(16)))float;
using u32x4=__attribute__((ext_vector_type(4)))unsigned;
using f32x4v=__attribute__((ext_vector_type(4)))float;
constexpr int BATCH=2,NHEAD=6,SEQ=16384,D=64,DM=NHEAD*D;
constexpr int NW=8,QBLK=32,QB=QBLK*NW,KVBLK=64,NQB=SEQ/QB;
constexpr int ATTN_PITCH=DM, ATTN_UNIT_ROWS=QB;
__device__ __forceinline__ int crow(int r,int hi){return (r&3)+8*(r>>2)+4*hi;}
#define SBAR() __builtin_amdgcn_sched_barrier(0)
__device__ __forceinline__ void cmask(f32x16&p0,f32x16&p1,int jb,int qrel,int hi){
  const float NEG=-INFINITY; int kb=64*jb+4*hi;
  #pragma unroll
  for(int r=0;r<16;++r){int kv=kb+(r&3)+8*(r>>2); if(kv>qrel)p0[r]=NEG; if(kv+32>qrel)p1[r]=NEG;}
}

constexpr int NSLOT=3, SLOTB=8192;
constexpr int LDS_K=0, LDS_V=NSLOT*SLOTB, LDS_WS=2*NSLOT*SLOTB, LDS_OST=LDS_WS+NW*64*4, LDS_BIAS=LDS_OST+NW*4096, LDS_BYTES=LDS_BIAS+SEQ*4;
constexpr float C2=0.125f*1.4426950408889634f;
__device__ __forceinline__ void glds16(const void*gsrc,unsigned lds_dst){unsigned keep;
  asm volatile("s_mov_b32 %0, m0\n\ts_mov_b32 m0, %2\n\ts_nop 0\n\tglobal_load_lds_dwordx4 %1, off\n\ts_mov_b32 m0, %0":"=&s"(keep):"v"(gsrc),"s"(lds_dst):"memory");}
__device__ __forceinline__ float max3f(float a,float b,float c){float r;asm("v_max3_f32 %0, %1, %2, %3":"=v"(r):"v"(a),"v"(b),"v"(c));return r;}
__device__ __forceinline__ float max2f(float a,float b){float r;asm("v_max_f32_e32 %0, %1, %2":"=v"(r):"v"(a),"v"(b));return r;}
__device__ __forceinline__ float fadd_s(float a,float b){float r;asm("v_add_f32_e32 %0, %1, %2":"=v"(r):"v"(a),"v"(b));return r;}
__device__ __forceinline__ float fsub_s(float a,float b){float r;asm("v_sub_f32_e32 %0, %1, %2":"=v"(r):"v"(a),"v"(b));return r;}
typedef float f32x2_t __attribute__((ext_vector_type(2))); typedef __bf16 bf16x2_t __attribute__((ext_vector_type(2)));
__device__ __forceinline__ unsigned cvtpk_s(float lo,float hi){f32x2_t v={lo,hi};bf16x2_t b=__builtin_convertvector(v,bf16x2_t);return __builtin_bit_cast(unsigned,b);}
#define WAIT_BAR(N) asm volatile("s_waitcnt vmcnt(" #N ") lgkmcnt(0)\n\ts_barrier":::"memory")

__device__ __forceinline__ void qkt(f32x16&p0,f32x16&p1,const char*Kslot,const bf16x8*qr,int r32,int hi){
  const char*kb=Kslot+hi*1024+r32*16;
  #pragma unroll
  for(int d0=0;d0<4;++d0){
    const bf16x8 b0=*reinterpret_cast<const bf16x8*>(kb+d0*2048);
    const bf16x8 b1=*reinterpret_cast<const bf16x8*>(kb+d0*2048+512);
    {p0=__builtin_amdgcn_mfma_f32_32x32x16_bf16(b0,qr[d0],p0,0,0,0);p1=__builtin_amdgcn_mfma_f32_32x32x16_bf16(b1,qr[d0],p1,0,0,0);}}
}
typedef __attribute__((address_space(3))) const char* lds_cptr;
typedef short v4i16_t __attribute__((ext_vector_type(4)));
__device__ __forceinline__ void kload8(bf16x8*kf,lds_cptr kp){
  kf[0]=*(const __attribute__((address_space(3))) bf16x8*)(kp);      kf[1]=*(const __attribute__((address_space(3))) bf16x8*)(kp+512);
  kf[2]=*(const __attribute__((address_space(3))) bf16x8*)(kp+2048); kf[3]=*(const __attribute__((address_space(3))) bf16x8*)(kp+2560);
  kf[4]=*(const __attribute__((address_space(3))) bf16x8*)(kp+4096); kf[5]=*(const __attribute__((address_space(3))) bf16x8*)(kp+4608);
  kf[6]=*(const __attribute__((address_space(3))) bf16x8*)(kp+6144); kf[7]=*(const __attribute__((address_space(3))) bf16x8*)(kp+6656);
}
__device__ __forceinline__ void kload2(bf16x8*kf,lds_cptr kp,int j){ kf[2*j]=*(const __attribute__((address_space(3))) bf16x8*)(kp+j*2048); kf[2*j+1]=*(const __attribute__((address_space(3))) bf16x8*)(kp+j*2048+512); }
__device__ __forceinline__ s16x4 vtr(lds_cptr p){ return __builtin_bit_cast(s16x4,__builtin_amdgcn_ds_read_tr16_b64_v4i16((__attribute__((address_space(3))) v4i16_t*)p)); }
__device__ __forceinline__ float rowmax(const f32x16&p0,const f32x16&p1){
  float a=max3f(p0[0],p0[1],p1[0]),b=max3f(p0[2],p0[3],p1[1]);a=max3f(a,p1[2],p1[3]);
  #pragma unroll
  for(int r=4;r<16;r+=4){a=max3f(a,p0[r],p0[r+1]);b=max3f(b,p0[r+2],p0[r+3]);a=max3f(a,p1[r],p1[r+1]);b=max3f(b,p1[r+2],p1[r+3]);}
  const float m=max2f(a,b);
  auto rr=__builtin_amdgcn_permlane32_swap(__float_as_uint(m),__float_as_uint(m),false,false);
  return max2f(__uint_as_float(rr[0]),__uint_as_float(rr[1]));
}
__device__ __forceinline__ void pv(f32x16*o,int vb,bf16x8 pa0,bf16x8 pa1,bf16x8 pa2,bf16x8 pa3){
  #pragma unroll
  for(int d0=0;d0<2;++d0){s16x4 lo[4],hi[4];
    #pragma unroll
    for(int ks=0;ks<4;++ks){
      asm volatile("ds_read_b64_tr_b16 %0,%1 offset:%c2":"=&v"(lo[ks]):"v"(vb),"i"(d0*4096+ks*1024):"memory");
      asm volatile("ds_read_b64_tr_b16 %0,%1 offset:%c2":"=&v"(hi[ks]):"v"(vb),"i"(d0*4096+ks*1024+512):"memory");}
    asm volatile("s_waitcnt lgkmcnt(0)":::"memory");SBAR();
    #define PK(k) (bf16x8){lo[k][0],lo[k][1],lo[k][2],lo[k][3],hi[k][0],hi[k][1],hi[k][2],hi[k][3]}
    o[d0]=__builtin_amdgcn_mfma_f32_32x32x16_bf16(pa0,PK(0),o[d0],0,0,0);
    o[d0]=__builtin_amdgcn_mfma_f32_32x32x16_bf16(pa1,PK(1),o[d0],0,0,0);
    o[d0]=__builtin_amdgcn_mfma_f32_32x32x16_bf16(pa2,PK(2),o[d0],0,0,0);
    o[d0]=__builtin_amdgcn_mfma_f32_32x32x16_bf16(pa3,PK(3),o[d0],0,0,0);
    #undef PK
  }
}

#ifndef ATTN_STORE16
#define ATTN_STORE16(p,v) (*(u32x4*)(p)=(v))
#endif
template<int THRL> __device__ __forceinline__ void attn_unit(int b,int h,int qb,const bf16*Q,const bf16*__restrict__ K,const bf16*__restrict__ V,bf16*O,const float*__restrict__ cum,char*shm){
  int tid_=threadIdx.x; asm volatile("":"+v"(tid_)); const int tid=tid_,lane=tid&63,r32=lane&31,hi=lane>>5; const int wid=__builtin_amdgcn_readfirstlane(tid>>6);
  const long rowbase=(long)b*SEQ; const int q0=qb*QB;
  const bf16*Qw=Q+(rowbase+q0+wid*QBLK)*DM+h*D;
  const bf16*Kh=K+rowbase*DM+h*D,*Vh=V+rowbase*DM+h*D;
  const unsigned lds0=(unsigned)(uintptr_t)shm;
  float*wsf=(float*)(shm+LDS_WS)+wid*64;
  const bf16*ksrc=Kh+(long)lane*DM+wid*8;
  const bf16*vsrc=Vh+(long)(16*(wid&3)+(lane>>2))*DM+(wid>>2)*32+(lane&3)*8;
  const unsigned kdst=lds0+LDS_K+wid*1024, vdst=lds0+LDS_V+wid*1024;
  #define DMA_K(t,slot) glds16(ksrc+(long)(t)*KVBLK*DM,(unsigned)__builtin_amdgcn_readfirstlane(kdst+(slot)))
  #define DMA_V(t,slot) glds16(vsrc+(long)(t)*KVBLK*DM,(unsigned)__builtin_amdgcn_readfirstlane(vdst+(slot)))
  const int vb0=(int)(lds0+LDS_V)+((lane>>4)&1)*32+(lane&3)*8+(4*hi+((lane&15)>>2))*64;
  const char*Kbase=shm+LDS_K; bf16x8 kf[8];
  const lds_cptr shm3=(lds_cptr)shm; const lds_cptr kp0=shm3+LDS_K+hi*1024+r32*16; const lds_cptr vp0=shm3+LDS_V+((lane>>4)&1)*32+(lane&3)*8+(4*hi+((lane&15)>>2))*64;
  const int NT=(q0+QB)/KVBLK;
  const __attribute__((address_space(3))) float* biasl=(const __attribute__((address_space(3))) float*)(shm3+LDS_BIAS);
  { __attribute__((address_space(3))) float* bw=(__attribute__((address_space(3))) float*)(shm3+LDS_BIAS);
    for(int i=tid*4;i<q0+QB;i+=NW*64*4){ f32x4v v=*reinterpret_cast<const f32x4v*>(cum+i); v=v*(-1.4426950408889634f); *(__attribute__((address_space(3))) f32x4v*)(bw+i)=v; }
    asm volatile("s_waitcnt vmcnt(0) lgkmcnt(0)\n\ts_barrier":::"memory"); }
  DMA_K(0,0);DMA_V(0,0);DMA_K(1,SLOTB);
  bf16x8 qr[4];
  #pragma unroll
  for(int d0=0;d0<4;++d0)qr[d0]=*reinterpret_cast<const bf16x8*>(&Qw[(long)r32*DM+d0*16+hi*8]);
  float mhat=0.f,l_reg=0.f;f32x16 o[2];o[0]=f32x16{};o[1]=f32x16{};
  #define BIASFILL(C0,C1,t) do{ const __attribute__((address_space(3))) float* bp_=biasl+64*(t)+4*hi; \
    _Pragma("unroll") for(int g_=0;g_<4;++g_){ const f32x4v v_=*(const __attribute__((address_space(3))) f32x4v*)(bp_+8*g_); const f32x4v w_=*(const __attribute__((address_space(3))) f32x4v*)(bp_+32+8*g_); \
      _Pragma("unroll") for(int i_=0;i_<4;++i_){ C0[4*g_+i_]=v_[i_]-mhat; C1[4*g_+i_]=w_[i_]-mhat; } } }while(0)
  const int qrel=wid*QBLK+r32;
  #define CMASK(P0,P1,t) do{int jb_=(t)-(NT-4); if(jb_>=0)cmask(P0,P1,jb_,qrel,hi);}while(0)
  bool resc=false;
  #define START(P0,P1) do{ const float rm=rowmax(P0,P1); resc=false; \
    { const float dl=rm; mhat=fadd_s(mhat,dl); \
      _Pragma("unroll") for(int r=0;r<16;++r){P0[r]=fsub_s(P0[r],dl);P1[r]=fsub_s(P1[r],dl);} \
      } \
    _Pragma("unroll") for(int r=0;r<16;++r)P0[r]=__builtin_amdgcn_exp2f(P0[r]); }while(0)
  #define RESC() do{ if(resc){ asm volatile("s_waitcnt lgkmcnt(0)":::"memory"); \
      _Pragma("unroll") for(int d_=0;d_<2;++d_) _Pragma("unroll") for(int r=0;r<16;++r)o[d_][r]*=wsf[crow(r,hi)]; } }while(0)
  f32x16 pA0,pA1,pB0,pB1;
  int sl_prev=0,sl_cur=0,sl_next=SLOTB;
  #define ROT() do{sl_prev=sl_cur;sl_cur=sl_next;sl_next=(sl_next==(NSLOT-1)*SLOTB)?0:sl_next+SLOTB;}while(0)
  DMA_K(2,2*SLOTB);
  WAIT_BAR(3);
  BIASFILL(pA0,pA1,0); qkt(pA0,pA1,Kbase,qr,r32,hi);asm volatile("s_nop 15\n\ts_nop 7":"+v"(pA0),"+v"(pA1));CMASK(pA0,pA1,0);
  START(pA0,pA1);
  _Pragma("unroll") for(int r=0;r<16;++r)pA1[r]=__builtin_amdgcn_exp2f(pA1[r]);
  WAIT_BAR(0);
  DMA_K(3,0);DMA_V(1,SLOTB);
  ROT();
  kload8(kf,kp0+sl_cur);
  WAIT_BAR(2);
  s16x4 vlo[8],vhi[8]; u32x4 pw0,pw1,pw2,pw3;
  #define PKW(P,B) cvtpk_s(P[B],P[B+1])
  #define PAF(k) __builtin_bit_cast(bf16x8,pw##k)
  #define VFR(i) (bf16x8){vlo[i][0],vlo[i][1],vlo[i][2],vlo[i][3],vhi[i][0],vhi[i][1],vhi[i][2],vhi[i][3]}
  #define PIN(x) asm volatile("":"+v"(x))
  #define MX3(a,b,c) __builtin_fmaxf(__builtin_fmaxf((a),(b)),(c))
  #define GAPA(MF,A0,A1,A2,A3,W0,W1,PW) do{ MF; sacc+=A0; sacc+=A1; sacc+=A2; sacc+=A3; PIN(sacc); W0; W1; PIN(PW); SBAR(); }while(0)
  #define EX(v) __builtin_amdgcn_exp2f(v)
  #define GAPB(MF,X,B) do{ MF; X[B]=EX(X[B]); X[B+1]=EX(X[B+1]); X[B+2]=EX(X[B+2]); X[B+3]=EX(X[B+3]); PIN(X); SBAR(); }while(0)
  #define VRD(i) do{ vlo[i]=vtr(vp_+(((i)>>2)*4096+((i)&3)*1024)); vhi[i]=vtr(vp_+(((i)>>2)*4096+((i)&3)*1024+512)); }while(0)
  #define KRD(G,j) do{ if(G){ kload2(kf,kp0+sl_next,j); SBAR(); } }while(0)
  #define STEP(C0,C1,P0,P1,t,GK,GV,GL) do{ SBAR(); \
    BIASFILL(C0,C1,t); SBAR(); \
    const lds_cptr vp_=vp0+sl_prev; \
    VRD(0); SBAR(); float sacc=(P0[0]+P0[1]); \
    GAPA(C0=__builtin_amdgcn_mfma_f32_32x32x16_bf16(kf[0],qr[0],C0,0,0,0), P0[2],P0[3],P0[4],P0[5],     pw0[0]=PKW(P0,0), pw0[1]=PKW(P0,2), pw0); \
    VRD(4); SBAR(); GAPA(C1=__builtin_amdgcn_mfma_f32_32x32x16_bf16(kf[1],qr[0],C1,0,0,0), P0[6],P0[7],P0[8],P0[9],     pw0[2]=PKW(P0,4), pw0[3]=PKW(P0,6), pw0); \
    VRD(1); SBAR(); GAPA(C0=__builtin_amdgcn_mfma_f32_32x32x16_bf16(kf[2],qr[1],C0,0,0,0),   P0[10],P0[11],P0[12],P0[13], pw1[0]=PKW(P0,8), pw1[1]=PKW(P0,10), pw1); \
    VRD(5); SBAR(); GAPA(C1=__builtin_amdgcn_mfma_f32_32x32x16_bf16(kf[3],qr[1],C1,0,0,0),   P0[14],P0[15],P1[0],P1[1],   pw1[2]=PKW(P0,12),pw1[3]=PKW(P0,14), pw1); \
    VRD(2); SBAR(); GAPA(C0=__builtin_amdgcn_mfma_f32_32x32x16_bf16(kf[4],qr[2],C0,0,0,0),   P1[2],P1[3],P1[4],P1[5],     pw2[0]=PKW(P1,0), pw2[1]=PKW(P1,2), pw2); \
    VRD(6); SBAR(); GAPA(C1=__builtin_amdgcn_mfma_f32_32x32x16_bf16(kf[5],qr[2],C1,0,0,0),   P1[6],P1[7],P1[8],P1[9],     pw2[2]=PKW(P1,4), pw2[3]=PKW(P1,6), pw2); \
    VRD(3); SBAR(); GAPA(C0=__builtin_amdgcn_mfma_f32_32x32x16_bf16(kf[6],qr[3],C0,0,0,0),   P1[10],P1[11],P1[12],P1[13], pw3[0]=PKW(P1,8), pw3[1]=PKW(P1,10), pw3); \
    VRD(7); SBAR(); GAPA(C1=__builtin_amdgcn_mfma_f32_32x32x16_bf16(kf[7],qr[3],C1,0,0,0),   P1[14],P1[15],0.f,0.f,       pw3[2]=PKW(P1,12),pw3[3]=PKW(P1,14), pw3); \
    l_reg+=sacc; \
    if(GK){DMA_K((t)+3,sl_cur);} if(GV){DMA_V((t)+1,sl_next);} \
    CMASK(C0,C1,t); \
    { float a=MX3(C0[0],C0[1],C1[0]),b=MX3(C0[2],C0[3],C1[1]); a=MX3(a,C1[2],C1[3]); \
      _Pragma("unroll") for(int r=4;r<16;r+=4){a=MX3(a,C0[r],C0[r+1]);b=MX3(b,C0[r+2],C0[r+3]);a=MX3(a,C1[r],C1[r+1]);b=MX3(b,C1[r+2],C1[r+3]);} \
      float rm=__builtin_fmaxf(a,b); { auto rr=__builtin_amdgcn_permlane32_swap(__float_as_uint(rm),__float_as_uint(rm),false,false); rm=__builtin_fmaxf(__uint_as_float(rr[0]),__uint_as_float(rr[1])); } \
      resc=false; \
      if(__builtin_expect(__any(rm>(float)THRL),0)){ const float dl=__builtin_fmaxf(rm,0.f); mhat+=dl; \
        _Pragma("unroll") for(int r=0;r<16;++r){C0[r]-=dl;C1[r]-=dl;} \
        const float f=__builtin_amdgcn_exp2f(-dl); l_reg*=f; if(hi==0)wsf[r32]=f; resc=true; } } \
    SBAR(); \
    GAPB(o[0]=__builtin_amdgcn_mfma_f32_32x32x16_bf16(PAF(0),VFR(0),o[0],0,0,0), C0,0); \
    GAPB(o[1]=__builtin_amdgcn_mfma_f32_32x32x16_bf16(PAF(0),VFR(4),o[1],0,0,0), C0,4); \
    KRD(GL,0); GAPB(o[0]=__builtin_amdgcn_mfma_f32_32x32x16_bf16(PAF(1),VFR(1),o[0],0,0,0), C0,8); \
    KRD(GL,1); GAPB(o[1]=__builtin_amdgcn_mfma_f32_32x32x16_bf16(PAF(1),VFR(5),o[1],0,0,0), C0,12); \
    KRD(GL,2); GAPB(o[0]=__builtin_amdgcn_mfma_f32_32x32x16_bf16(PAF(2),VFR(2),o[0],0,0,0), C1,0); \
    KRD(GL,3); GAPB(o[1]=__builtin_amdgcn_mfma_f32_32x32x16_bf16(PAF(2),VFR(6),o[1],0,0,0), C1,4); \
    GAPB(o[0]=__builtin_amdgcn_mfma_f32_32x32x16_bf16(PAF(3),VFR(3),o[0],0,0,0), C1,8); \
    GAPB(o[1]=__builtin_amdgcn_mfma_f32_32x32x16_bf16(PAF(3),VFR(7),o[1],0,0,0), C1,12); \
    }while(0)
  int t=1;
  #undef CMASK
  #define CMASK(P0,P1,t) do{}while(0)
  for(;t+5<NT;t+=2){
    STEP(pB0,pB1,pA0,pA1,t,true,true,true);     WAIT_BAR(2); RESC(); ROT();
    STEP(pA0,pA1,pB0,pB1,t+1,true,true,true);   WAIT_BAR(2); RESC(); ROT();
  }
  #undef CMASK
  #define CMASK(P0,P1,t) do{int jb_=(t)-(NT-4); if(jb_>=0)cmask(P0,P1,jb_,qrel,hi);}while(0)
  #define ENDW(tt) do{ if((tt)+3<NT){WAIT_BAR(2);} else if((tt)+2<NT){WAIT_BAR(1);} else {WAIT_BAR(0);} }while(0)
  for(;t+1<NT;t+=2){
    STEP(pB0,pB1,pA0,pA1,t,(t+3<NT),(t+1<NT),(t+1<NT));       ENDW(t);   RESC(); ROT();
    STEP(pA0,pA1,pB0,pB1,t+1,(t+4<NT),(t+2<NT),(t+2<NT));     ENDW(t+1); RESC(); ROT();
  }
  STEP(pB0,pB1,pA0,pA1,NT-1,false,false,false); RESC();
  { float sacc=pB0[0]+pB0[1]; _Pragma("unroll") for(int r=2;r<16;++r)sacc+=pB0[r]; _Pragma("unroll") for(int r=0;r<16;++r)sacc+=pB1[r]; l_reg+=sacc;
    pw0=(u32x4){PKW(pB0,0),PKW(pB0,2),PKW(pB0,4),PKW(pB0,6)};pw1=(u32x4){PKW(pB0,8),PKW(pB0,10),PKW(pB0,12),PKW(pB0,14)};pw2=(u32x4){PKW(pB1,0),PKW(pB1,2),PKW(pB1,4),PKW(pB1,6)};pw3=(u32x4){PKW(pB1,8),PKW(pB1,10),PKW(pB1,12),PKW(pB1,14)};
    SBAR(); pv(o,vb0+sl_cur,PAF(0),PAF(1),PAF(2),PAF(3)); }
  #undef PKW
  #undef PAF
  #undef VFR
  #undef PIN
  #undef MX3
  #undef GAPA
  #undef GAPB
  #undef EX
  #undef VRD
  #undef KRD
  #undef STEP
  #undef ENDW
  {auto rr=__builtin_amdgcn_permlane32_swap(__float_as_uint(l_reg),__float_as_uint(l_reg),false,false);l_reg=__uint_as_float(rr[0])+__uint_as_float(rr[1]);}
  if(hi==0)wsf[32+r32]=l_reg;asm volatile("s_waitcnt lgkmcnt(0)":::"memory");
  float rli[16];
  #pragma unroll
  for(int r=0;r<16;++r)rli[r]=__builtin_amdgcn_rcpf(wsf[32+crow(r,hi)]);
  bf16*Ow=O+(rowbase+q0+wid*QBLK)*DM+h*D;
  { bf16*stg=(bf16*)(shm+LDS_OST)+wid*2048;
    #pragma unroll
    for(int r=0;r<16;++r){const int orow=crow(r,hi);
      #pragma unroll
      for(int d0=0;d0<2;++d0)stg[orow*64+d0*32+r32]=__float2bfloat16(o[d0][r]*rli[r]);}
    asm volatile("s_waitcnt lgkmcnt(0)":::"memory");
    #pragma unroll
    for(int i=0;i<4;++i){const int row=i*8+(lane>>3),ch=lane&7; const u32x4 v=*(const u32x4*)(stg+row*64+ch*8); ATTN_STORE16(Ow+(long)row*DM+ch*8,v);} }
  asm volatile("s_waitcnt lgkmcnt(0)\n\ts_barrier":::"memory");
  #undef DMA_K
  #undef DMA_V
  #undef CMASK
  #undef START
  #undef RESC
  #undef ROT
  #undef BIASFILL
}
constexpr int ATTN_LDS_BYTES=LDS_BYTES;
#undef SBAR
#undef WAIT_BAR
}

constexpr size_t MiB = 1u << 20;
constexpr size_t WS_CTL = 0, CTL_BYTES = 1 * MiB;
constexpr int CW_QCTR = 0;
constexpr int CW_CNT = 1024;
constexpr int CW_KMEAN = 4096;
constexpr size_t WS_W = 1 * MiB;
constexpr size_t W_IN = 0, W_G = W_IN + (size_t)NQKV * 1024, W_PA = W_G + (size_t)NG * 1024, W_PB = W_PA + 1024 * 384, W_PC = W_PB + 1024 * 256,
                 W_O = W_PC + 1024 * 384, W_GU = W_O + 1024 * 1024, W_D = W_GU + (size_t)2 * DFF * 1024, W_LAYER = W_D + (size_t)1024 * DFF;
static_assert(WS_W + 2 * W_LAYER * 2 <= 69 * MiB, "weights");
constexpr size_t WS_ROPE = 69 * MiB;
constexpr size_t WS_LF = 70 * MiB;
constexpr size_t WS_CUM = 71 * MiB;
constexpr size_t WS_LSEB = 72 * MiB;
constexpr size_t WS_XB = 76 * MiB;
constexpr size_t WS_QA = 140 * MiB, WS_KA = 164 * MiB, WS_VA = 188 * MiB, WS_QB = 212 * MiB, WS_KB = 260 * MiB, WS_VB = 276 * MiB,
                 WS_QC = 292 * MiB, WS_KC = 316 * MiB, WS_VC = 340 * MiB;
constexpr size_t WS_H = 140 * MiB;
constexpr size_t WS_PO = 364 * MiB;
constexpr size_t WS_PLSE = 460 * MiB;
constexpr size_t WS_LIST = 463 * MiB;
constexpr size_t WS_GS = 364 * MiB;
constexpr size_t WS_MG = 428 * MiB;
constexpr size_t WS_END = 492 * MiB;
constexpr int LIST_PER_BH = 256 * 2016;
__device__ __forceinline__ int list_off(int bh, int n) { return bh * LIST_PER_BH + 256 * (63 * n - (n * (n - 1)) / 2); }

constexpr int LDS_QW = 150 * 1024;
constexpr int LDS_BYTES = 152 * 1024;
static_assert(attn_body::ATTN_LDS_BYTES <= LDS_QW && pg8::STAGE_BYTES <= LDS_QW, "lds");

__constant__ double ROPE_FR[8] = {0.15915494309189535, 0.03086376340470123, 0.005985185712713705, 0.0011606636412400608,
                                  0.00022507907903927653, 4.364795279280289e-05, 8.464330808241401e-06, 1.6414262627950345e-06};

struct Args { const float* in[16]; float* out; unsigned char* ws; };
typedef const __attribute__((address_space(4))) Args* CArgs;

__device__ __forceinline__ float wave_sum(float v) {
#pragma unroll
    for (int o = 1; o < 64; o <<= 1) v += __shfl_xor(v, o);
    return v;
}
__device__ __forceinline__ unsigned f2bf(float f) { unsigned u = __builtin_bit_cast(unsigned, f); return (u + 0x7fffu + ((u >> 16) & 1u)) >> 16; }
__device__ __forceinline__ unsigned pk2(float lo, float hi) { return f2bf(lo) | (f2bf(hi) << 16); }

__device__ __forceinline__ void transpose_item(const float* Wsrc, int ldw, bf16_t* dst, int ldk, LAS float* scr, int lane) {
#pragma unroll 8
    for (int i = 0; i < 32; ++i) { const int kk = 2 * i + (lane >> 5); scr[kk * 33 + (lane & 31)] = Wsrc[(size_t)kk * ldw + (lane & 31)]; }
    asm volatile("s_waitcnt lgkmcnt(0)" ::: "memory");
    const int c = lane & 7;
#pragma unroll
    for (int j = 0; j < 4; ++j) { const int n = (lane >> 3) + 8 * j; const LAS float* s = scr + (8 * c) * 33 + n;
        u32x4 o; o.x = pk2(s[0 * 33], s[1 * 33]); o.y = pk2(s[2 * 33], s[3 * 33]); o.z = pk2(s[4 * 33], s[5 * 33]); o.w = pk2(s[6 * 33], s[7 * 33]);
        *(u32x4*)(dst + (size_t)(n) * ldk + 8 * c) = o; }
    asm volatile("s_waitcnt lgkmcnt(0)" ::: "memory");
}
constexpr int IT_IN = 16 * 112, IT_G = 16 * 96, IT_PA = 6 * 32, IT_PB = 4 * 32, IT_PC = 6 * 32, IT_O = 16 * 32, IT_GU = 16 * 176, IT_D = 44 * 32;
constexpr int IT_LAYER = IT_IN + IT_G + IT_PA + IT_PB + IT_PC + IT_O + IT_GU + IT_D;
__device__ __forceinline__ void prologue_item(CArgs a, int it, LAS float* scr, int lane) {
    const int l = it / IT_LAYER; int r = it % IT_LAYER;
    bf16_t* WL = (bf16_t*)(a->ws + WS_W) + (size_t)l * W_LAYER;
    if (r < IT_IN) { const int kb = r / 112, nb = r % 112, k0 = 64 * kb, n0 = 32 * nb, c0 = n0 < 1152 ? n0 : n0 + 6;
        transpose_item(a->in[3] + (size_t)l * 1024 * DIN + (size_t)k0 * DIN + c0, DIN, WL + W_IN + (size_t)n0 * 1024 + k0, 1024, scr, lane); return; } r -= IT_IN;
    if (r < IT_G) { const int kb = r / 96, nb = r % 96, k0 = 64 * kb, n0 = 32 * nb, c0 = 3590 + n0;
        transpose_item(a->in[3] + (size_t)l * 1024 * DIN + (size_t)k0 * DIN + c0, DIN, WL + W_G + (size_t)n0 * 1024 + k0, 1024, scr, lane); return; } r -= IT_G;
    if (r < IT_PA) { const int kb = r / 32, nb = r % 32, k0 = 64 * kb, n0 = 32 * nb;
        transpose_item(a->in[5] + (size_t)l * 384 * 1024 + (size_t)k0 * 1024 + n0, 1024, WL + W_PA + (size_t)n0 * 384 + k0, 384, scr, lane); return; } r -= IT_PA;
    if (r < IT_PB) { const int kb = r / 32, nb = r % 32, k0 = 64 * kb, n0 = 32 * nb;
        transpose_item(a->in[6] + (size_t)l * 256 * 1024 + (size_t)k0 * 1024 + n0, 1024, WL + W_PB + (size_t)n0 * 256 + k0, 256, scr, lane); return; } r -= IT_PB;
    if (r < IT_PC) { const int kb = r / 32, nb = r % 32, k0 = 64 * kb, n0 = 32 * nb;
        transpose_item(a->in[7] + (size_t)l * 384 * 1024 + (size_t)k0 * 1024 + n0, 1024, WL + W_PC + (size_t)n0 * 384 + k0, 384, scr, lane); return; } r -= IT_PC;
    if (r < IT_O) { const int kb = r / 32, nb = r % 32, k0 = 64 * kb, n0 = 32 * nb;
        transpose_item(a->in[8] + (size_t)l * 1024 * 1024 + (size_t)k0 * 1024 + n0, 1024, WL + W_O + (size_t)n0 * 1024 + k0, 1024, scr, lane); return; } r -= IT_O;
    if (r < IT_GU) { const int kb = r / 176, nb = r % 176, k0 = 64 * kb, n0 = 32 * nb, pn = n0 >> 8, w = n0 & 255;
        const float* src = (w < 128) ? (a->in[11] + (size_t)l * 1024 * DFF + (size_t)k0 * DFF + 128 * pn + w) : (a->in[12] + (size_t)l * 1024 * DFF + (size_t)k0 * DFF + 128 * pn + (w - 128));
        transpose_item(src, DFF, WL + W_GU + (size_t)n0 * 1024 + k0, 1024, scr, lane); return; } r -= IT_GU;
    { const int kb = r / 32, nb = r % 32, k0 = 64 * kb, n0 = 32 * nb;
        transpose_item(a->in[13] + (size_t)l * DFF * 1024 + (size_t)k0 * 1024 + n0, 1024, WL + W_D + (size_t)n0 * DFF + k0, DFF, scr, lane); }
}

__device__ __forceinline__ void ln_phase(const float* src, const float* gam, const float* bet, float* XF, bf16_t* XB,
                                         const float* wfa, const float* bfl, float* LF, LAS unsigned char* lds, int tid, int lane, int wave) {
    asm volatile("" : "+v"(tid), "+v"(lane));
    LAS float* wl = (LAS float*)lds;
    if (wfa) { for (int i = tid; i < 6144; i += NWAVES * 64) { const int h = i % 6, k = i / 6; wl[h * 1024 + k] = wfa[(size_t)k * DIN + 1152 + h]; } }
    __syncthreads();
    f32x4 g4[4], b4[4];
#pragma unroll
    for (int j = 0; j < 4; ++j) { g4[j] = *(const f32x4*)(gam + 4 * lane + 256 * j); b4[j] = *(const f32x4*)(bet + 4 * lane + 256 * j); }
    for (int row = blockIdx.x * NWAVES + wave; row < T; row += gridDim.x * NWAVES) {
        const f32x4* xr = (const f32x4*)(src + (size_t)row * DM) + lane;
        f32x4 v[4]; float s = 0.f;
#pragma unroll
        for (int j = 0; j < 4; ++j) { v[j] = xr[64 * j]; s += (v[j].x + v[j].y) + (v[j].z + v[j].w); }
        const float mean = wave_sum(s) * (1.f / DM); float s2 = 0.f;
#pragma unroll
        for (int j = 0; j < 4; ++j) { v[j] = v[j] - mean; s2 += (v[j].x * v[j].x + v[j].y * v[j].y) + (v[j].z * v[j].z + v[j].w * v[j].w); }
        const float rstd = 1.f / sqrtf(wave_sum(s2) * (1.f / DM) + LN_EPS);
        f32x4* of = (f32x4*)(XF + (size_t)row * DM) + lane; u32x2* ob = (u32x2*)(XB + (size_t)row * DM) + lane;
#pragma unroll
        for (int j = 0; j < 4; ++j) { v[j] = v[j] * rstd * g4[j] + b4[j]; of[64 * j] = v[j]; u32x2 w; w.x = cvt_pk_bf16(v[j].x, v[j].y); w.y = cvt_pk_bf16(v[j].z, v[j].w); ob[64 * j] = w; }
        if (wfa) {
            float d[6];
#pragma unroll
            for (int h = 0; h < 6; ++h) { float acc = 0.f;
#pragma unroll
                for (int j = 0; j < 4; ++j) { const f32x4 w = *(const LAS f32x4*)(wl + h * 1024 + 4 * lane + 256 * j); acc += (v[j].x * w.x + v[j].y * w.y) + (v[j].z * w.z + v[j].w * w.w); }
                d[h] = wave_sum(acc); }
            if (lane < 6) { float z = d[0];
#pragma unroll
                for (int h = 1; h < 6; ++h) z = (lane == h) ? d[h] : z;
                z += bfl[lane];
                const float ls = fminf(z, 0.f) - log1pf(expf(-fabsf(z)));
                const int b = row / SEQ, sidx = row % SEQ; LF[(size_t)(b * 6 + lane) * SEQ + sidx] = ls; }
        }
    }
    __syncthreads();
}

__device__ __forceinline__ void scan_bh(const float* lf, float* cum, LAS unsigned char* lds, int tid, int lane, int wave) {
    asm volatile("" : "+v"(tid), "+v"(lane));
    LAS float* ws = (LAS float*)lds;
    f32x4 v[8]; const f32x4* p = (const f32x4*)(lf + tid * 32);
#pragma unroll
    for (int j = 0; j < 8; ++j) v[j] = p[j];
    float run = 0.f;
#pragma unroll
    for (int j = 0; j < 8; ++j) { run += v[j].x; v[j].x = run; run += v[j].y; v[j].y = run; run += v[j].z; v[j].z = run; run += v[j].w; v[j].w = run; }
    float inc = run;
#pragma unroll
    for (int o = 1; o < 64; o <<= 1) { const float t = __shfl_up(inc, o); if (lane >= o) inc += t; }
    if (lane == 63) ws[wave] = inc;
    __syncthreads();
    float base = inc - run;
    for (int w = 0; w < wave; ++w) base += ws[w];
    f32x4* q = (f32x4*)(cum + tid * 32);
#pragma unroll
    for (int j = 0; j < 8; ++j) q[j] = v[j] + base;
    __syncthreads();
}

__device__ __forceinline__ float sigmoidf_(float x) { return __builtin_amdgcn_rcpf(1.f + __builtin_amdgcn_exp2f(-x * LOG2E)); }

struct EpiInproj {
    static constexpr bool PERM = true;
    unsigned char* ws; const f32x2* rope; int* kmean;
    __device__ __forceinline__ void operator()(const f32x4 (&acc)[2][2][4][2], const pg8::Unit& u, int wr, int wc, int fr, int fq) const {
        const int row0 = u.pm * 256 + wr * 64 + fr;
#pragma unroll
        for (int bj = 0; bj < 2; ++bj) {
            const int cb = 2 * u.pn + bj;
            size_t base; int pitch, c0; bool rope_on = false, km = false; float sc = 1.f;
            if (cb < 3) { base = WS_QA; pitch = 384; c0 = cb * 128; sc = C2; }
            else if (cb < 6) { base = WS_KA; pitch = 384; c0 = (cb - 3) * 128; }
            else if (cb < 9) { base = WS_VA; pitch = 384; c0 = (cb - 6) * 128; }
            else if (cb < 15) { base = WS_QB; pitch = 768; c0 = (cb - 9) * 128; rope_on = true; sc = C2; }
            else if (cb < 17) { base = WS_KB; pitch = 256; c0 = (cb - 15) * 128; rope_on = true; }
            else if (cb < 19) { base = WS_VB; pitch = 256; c0 = (cb - 17) * 128; }
            else if (cb < 22) { base = WS_QC; pitch = 384; c0 = (cb - 19) * 128; rope_on = true; sc = C2; }
            else if (cb < 25) { base = WS_KC; pitch = 384; c0 = (cb - 22) * 128; rope_on = true; km = true; }
            else { base = WS_VC; pitch = 384; c0 = (cb - 25) * 128; }
            bf16_t* dst = (bf16_t*)(ws + base);
            const int colw = c0 + wc * 32 + 8 * fq;
            const bool rl = rope_on && ((wc & 1) == 0) && (fq < 2);
            float ks[8];
#pragma unroll
            for (int i = 0; i < 8; ++i) ks[i] = 0.f;
#pragma unroll
            for (int ai = 0; ai < 2; ++ai)
#pragma unroll
                for (int m = 0; m < 4; ++m) {
                    const int row = row0 + ai * 128 + m * 16;
                    f32x4 v0 = acc[ai][bj][m][0], v1 = acc[ai][bj][m][1];
                    if (rope_on) {
                        float own[8] = {v0.x, v0.y, v0.z, v0.w, v1.x, v1.y, v1.z, v1.w}, oth[8];
#pragma unroll
                        for (int i = 0; i < 8; ++i) oth[i] = __shfl_xor(own[i], 16);
                        if (rl) {
                            const f32x2* rp = rope + (size_t)(row % SEQ) * 8;
                            const float sg = (fq == 0) ? -1.f : 1.f;
#pragma unroll
                            for (int i = 0; i < 8; ++i) { const f32x2 cs = rp[i]; own[i] = own[i] * cs.x + sg * oth[i] * cs.y; }
                            v0 = (f32x4){own[0], own[1], own[2], own[3]}; v1 = (f32x4){own[4], own[5], own[6], own[7]};
                        }
                    }
                    if (km) { ks[0] += v0.x; ks[1] += v0.y; ks[2] += v0.z; ks[3] += v0.w; ks[4] += v1.x; ks[5] += v1.y; ks[6] += v1.z; ks[7] += v1.w; }
                    v0 = v0 * sc; v1 = v1 * sc;
                    u32x4 w; w.x = cvt_pk_bf16(v0.x, v0.y); w.y = cvt_pk_bf16(v0.z, v0.w); w.z = cvt_pk_bf16(v1.x, v1.y); w.w = cvt_pk_bf16(v1.z, v1.w);
                    *(u32x4*)(dst + (size_t)row * pitch + colw) = w;
                }
            if (km) {
#pragma unroll
                for (int i = 0; i < 8; ++i) { float s = ks[i]; s += __shfl_xor(s, 1); s += __shfl_xor(s, 2); s += __shfl_xor(s, 4); s += __shfl_xor(s, 8); ks[i] = s; }
                if (fr == 0) { const int b = u.pm >> 6, blk = u.pm & 63;
#pragma unroll
                    for (int i = 0; i < 8; ++i) { const int col = colw + i; atomicAdd(kmean + ((size_t)((b * 6 + (col >> 6)) * 64 + blk)) * 64 + (col & 63), __float2int_rn(ks[i] * 262144.f)); } }
            }
        }
    }
};

struct EpiSwiglu {
    static constexpr bool PERM = true;
    bf16_t* H;
    __device__ __forceinline__ void operator()(const f32x4 (&acc)[2][2][4][2], const pg8::Unit& u, int wr, int wc, int fr, int fq) const {
        const int row0 = u.pm * 256 + wr * 64 + fr, col0 = u.pn * 128 + wc * 32 + 8 * fq;
#pragma unroll
        for (int ai = 0; ai < 2; ++ai)
#pragma unroll
            for (int m = 0; m < 4; ++m) {
                float h[8];
#pragma unroll
                for (int n = 0; n < 2; ++n)
#pragma unroll
                    for (int i = 0; i < 4; ++i) { const float g = acc[ai][0][m][n][i], up = acc[ai][1][m][n][i]; h[4 * n + i] = g * sigmoidf_(g) * up; }
                u32x4 w; w.x = cvt_pk_bf16(h[0], h[1]); w.y = cvt_pk_bf16(h[2], h[3]); w.z = cvt_pk_bf16(h[4], h[5]); w.w = cvt_pk_bf16(h[6], h[7]);
                *(u32x4*)(H + (size_t)(row0 + ai * 128 + m * 16) * DFF + col0) = w;
                asm volatile("" ::: "memory");
            }
    }
};

struct EpiResid {
    static constexpr bool PERM = true;
    float* X;
    __device__ __forceinline__ void operator()(const f32x4 (&acc)[2][2][4][2], const pg8::Unit& u, int wr, int wc, int fr, int fq) const {
        const int row0 = u.pm * 256 + wr * 64 + fr, col0 = u.pn * 256 + wc * 32 + 8 * fq;
#pragma unroll
        for (int ai = 0; ai < 2; ++ai)
#pragma unroll
            for (int m = 0; m < 4; ++m)
#pragma unroll
                for (int bj = 0; bj < 2; ++bj) {
                    float* p = X + (size_t)(row0 + ai * 128 + m * 16) * DM + col0 + bj * 128;
                    const f32x4 a = *(const f32x4*)p, b = *(const f32x4*)(p + 4);
                    *(f32x4*)p = a * DN_ALPHA + acc[ai][bj][m][0]; *(f32x4*)(p + 4) = b * DN_ALPHA + acc[ai][bj][m][1];
                    asm volatile("" ::: "memory");
                }
    }
};

struct EpiGate {
    static constexpr bool PERM = true;
    bf16_t* GS;
    __device__ __forceinline__ void operator()(const f32x4 (&acc)[2][2][4][2], const pg8::Unit& u, int wr, int wc, int fr, int fq) const {
        const int row0 = u.pm * 256 + wr * 64 + fr, col0 = u.pn * 256 + wc * 32 + 8 * fq;
#pragma unroll
        for (int ai = 0; ai < 2; ++ai)
#pragma unroll
            for (int m = 0; m < 4; ++m)
#pragma unroll
                for (int bj = 0; bj < 2; ++bj) {
                    const f32x4 a = acc[ai][bj][m][0], b = acc[ai][bj][m][1];
                    u32x4 w; w.x = cvt_pk_bf16(sigmoidf_(a.x), sigmoidf_(a.y)); w.y = cvt_pk_bf16(sigmoidf_(a.z), sigmoidf_(a.w));
                    w.z = cvt_pk_bf16(sigmoidf_(b.x), sigmoidf_(b.y)); w.w = cvt_pk_bf16(sigmoidf_(b.z), sigmoidf_(b.w));
                    *(u32x4*)(GS + (size_t)(row0 + ai * 128 + m * 16) * DM + col0 + bj * 128) = w;
                }
    }
};

template <int FIRST> struct EpiBranch {
    static constexpr bool PERM = true;
    const bf16_t* GS; bf16_t* MG;
    __device__ __forceinline__ void operator()(const f32x4 (&acc)[2][2][4][2], const pg8::Unit& u, int wr, int wc, int fr, int fq) const {
        const int row0 = u.pm * 256 + wr * 64 + fr, col0 = u.pn * 256 + wc * 32 + 8 * fq;
#pragma unroll
        for (int ai = 0; ai < 2; ++ai)
#pragma unroll
            for (int m = 0; m < 4; ++m)
#pragma unroll
                for (int bj = 0; bj < 2; ++bj) {
                    const size_t off = (size_t)(row0 + ai * 128 + m * 16) * DM + col0 + bj * 128;
                    const u32x4 gw = *(const u32x4*)(GS + off);
                    const f32x4 a = acc[ai][bj][m][0], b = acc[ai][bj][m][1];
                    float r[8] = {bflo(gw.x) * a.x, bfhi(gw.x) * a.y, bflo(gw.y) * a.z, bfhi(gw.y) * a.w, bflo(gw.z) * b.x, bfhi(gw.z) * b.y, bflo(gw.w) * b.z, bfhi(gw.w) * b.w};
                    if (!FIRST) { const u32x4 mw = *(const u32x4*)(MG + off);
                        r[0] += bflo(mw.x); r[1] += bfhi(mw.x); r[2] += bflo(mw.y); r[3] += bfhi(mw.y); r[4] += bflo(mw.z); r[5] += bfhi(mw.z); r[6] += bflo(mw.w); r[7] += bfhi(mw.w); }
                    u32x4 w; w.x = cvt_pk_bf16(r[0], r[1]); w.y = cvt_pk_bf16(r[2], r[3]); w.z = cvt_pk_bf16(r[4], r[5]); w.w = cvt_pk_bf16(r[6], r[7]);
                    *(u32x4*)(MG + off) = w;
                    asm volatile("" ::: "memory");
                }
    }
};

typedef short v4i16_t __attribute__((ext_vector_type(4)));
__device__ __forceinline__ int crow(int r, int hi) { return (r & 3) + 8 * (r >> 2) + 4 * hi; }
__device__ __forceinline__ float half_max(float m) { auto rr = __builtin_amdgcn_permlane32_swap(__float_as_uint(m), __float_as_uint(m), false, false); return fmaxf(__uint_as_float(rr[0]), __uint_as_float(rr[1])); }
__device__ __forceinline__ float half_sum(float m) { auto rr = __builtin_amdgcn_permlane32_swap(__float_as_uint(m), __float_as_uint(m), false, false); return __uint_as_float(rr[0]) + __uint_as_float(rr[1]); }

__device__ __forceinline__ void small_attn(const bf16_t* qrow, int ntiles, const bf16_t* Kb, const bf16_t* Vb, int pitch,
                                           int kc0, int kstride, int koff, int qc, int span, LAS unsigned char* vscr, int lane,
                                           f32x16 (&o)[2], float& lse2, const float* cumb = nullptr) {
    asm volatile("" : "+v"(lane));
    const int r32 = lane & 31, hi = lane >> 5;
    bf16x8 qr[4];
#pragma unroll
    for (int d0 = 0; d0 < 4; ++d0) qr[d0] = *(const bf16x8*)(qrow + d0 * 16 + hi * 8);
    o[0] = f32x16{}; o[1] = f32x16{};
    float m = -1e30f, l = 0.f;
    const int vr = lane >> 1, vh = lane & 1;
    LAS unsigned char* vw = vscr + vr * 144 + vh * 64;
    const LAS unsigned char* vt = vscr + (4 * hi + ((lane & 15) >> 2)) * 144 + (16 * ((lane >> 4) & 1) + 4 * (lane & 3)) * 2;
    bf16x8 kf[4], vv[4], kfn[4], vvn[4];
    { const int kk = kc0 + r32; const int tokk = (kk < 0 ? 0 : kk) * kstride + koff; const bf16_t* kp = Kb + (size_t)tokk * pitch + 8 * hi;
      const int kv = kc0 + vr; const int tokv = (kv < 0 ? 0 : kv) * kstride + koff; const bf16_t* vp = Vb + (size_t)tokv * pitch + 32 * vh;
#pragma unroll
      for (int i = 0; i < 4; ++i) { kf[i] = *(const bf16x8*)(kp + 16 * i); vv[i] = *(const bf16x8*)(vp + 8 * i); } }
    for (int t = 0; t < ntiles; ++t) {
        if (t + 1 < ntiles) {
            const int kk = kc0 + 32 * (t + 1) + r32; const int tokk = (kk < 0 ? 0 : kk) * kstride + koff; const bf16_t* kp = Kb + (size_t)tokk * pitch + 8 * hi;
            const int kv = kc0 + 32 * (t + 1) + vr; const int tokv = (kv < 0 ? 0 : kv) * kstride + koff; const bf16_t* vp = Vb + (size_t)tokv * pitch + 32 * vh;
#pragma unroll
            for (int i = 0; i < 4; ++i) { kfn[i] = *(const bf16x8*)(kp + 16 * i); vvn[i] = *(const bf16x8*)(vp + 8 * i); }
        }
#pragma unroll
        for (int i = 0; i < 4; ++i) *(LAS bf16x8*)(vw + 16 * i) = vv[i];
        asm volatile("s_waitcnt lgkmcnt(0)" ::: "memory");
        f32x16 p = f32x16{};
#pragma unroll
        for (int d0 = 0; d0 < 4; ++d0) p = __builtin_amdgcn_mfma_f32_32x32x16_bf16(kf[d0], qr[d0], p, 0, 0, 0);
        const int kcb = kc0 + 32 * t;
        float rm = -INFINITY;
#pragma unroll
        for (int r = 0; r < 16; ++r) { const int kc = kcb + crow(r, hi); const bool ok = (kc >= 0) && (kc <= qc) && (qc - kc <= span);
            if (cumb) p[r] -= cumb[kc < 0 ? 0 : kc] * LOG2E;
            p[r] = ok ? p[r] : -INFINITY; rm = fmaxf(rm, p[r]); }
        rm = half_max(rm);
        const float mn = fmaxf(m, rm);
        const float f = __builtin_amdgcn_exp2f(m - mn);
        m = mn;
        float ls = 0.f;
#pragma unroll
        for (int r = 0; r < 16; ++r) { p[r] = __builtin_amdgcn_exp2f(p[r] - mn); ls += p[r]; }
        l = l * f + ls;
#pragma unroll
        for (int r = 0; r < 16; ++r) { o[0][r] *= f; o[1][r] *= f; }
        u32x4 pw0, pw1;
        pw0.x = cvt_pk_bf16(p[0], p[1]); pw0.y = cvt_pk_bf16(p[2], p[3]); pw0.z = cvt_pk_bf16(p[4], p[5]); pw0.w = cvt_pk_bf16(p[6], p[7]);
        pw1.x = cvt_pk_bf16(p[8], p[9]); pw1.y = cvt_pk_bf16(p[10], p[11]); pw1.z = cvt_pk_bf16(p[12], p[13]); pw1.w = cvt_pk_bf16(p[14], p[15]);
        const bf16x8 pb0 = __builtin_bit_cast(bf16x8, pw0), pb1 = __builtin_bit_cast(bf16x8, pw1);
#pragma unroll
        for (int d0 = 0; d0 < 2; ++d0) {
#pragma unroll
            for (int s = 0; s < 2; ++s) {
                const v4i16_t lo = __builtin_amdgcn_ds_read_tr16_b64_v4i16((LAS v4i16_t*)(vt + (16 * s) * 144 + d0 * 64));
                const v4i16_t hh = __builtin_amdgcn_ds_read_tr16_b64_v4i16((LAS v4i16_t*)(vt + (16 * s + 8) * 144 + d0 * 64));
                const bf16x8 vf = (bf16x8){lo[0], lo[1], lo[2], lo[3], hh[0], hh[1], hh[2], hh[3]};
                o[d0] = __builtin_amdgcn_mfma_f32_32x32x16_bf16(vf, s == 0 ? pb0 : pb1, o[d0], 0, 0, 0);
            }
        }
#pragma unroll
        for (int i = 0; i < 4; ++i) { kf[i] = kfn[i]; vv[i] = vvn[i]; }
    }
    l = half_sum(l);
    const float rl = 1.f / l;
#pragma unroll
    for (int r = 0; r < 16; ++r) { o[0][r] *= rl; o[1][r] *= rl; }
    lse2 = m + __builtin_amdgcn_logf(l);
}
__device__ __forceinline__ void small_store(bf16_t* orow, const f32x16 (&o)[2], int hi) {
#pragma unroll
    for (int d0 = 0; d0 < 2; ++d0)
#pragma unroll
        for (int g = 0; g < 4; ++g) { u32x2 w; w.x = cvt_pk_bf16(o[d0][4 * g], o[d0][4 * g + 1]); w.y = cvt_pk_bf16(o[d0][4 * g + 2], o[d0][4 * g + 3]);
            *(u32x2*)(orow + 32 * d0 + 8 * g + 4 * hi) = w; }
}

__device__ __forceinline__ void gating_phase(CArgs a, int layer, LAS unsigned char* lds, int tid) {
    asm volatile("" : "+v"(tid));
    unsigned* ctl = (unsigned*)(a->ws + WS_CTL);
    const int* kmean = (const int*)(ctl + CW_KMEAN + 49152 * layer);
    unsigned* cnt = ctl + CW_CNT + 1024 * layer;
    unsigned* list = (unsigned*)(a->ws + WS_LIST);
    const bf16_t* QC = (const bf16_t*)(a->ws + WS_QC);
    const int half = tid >> 8, ht = tid & 255;
    LAS float* km = (LAS float*)(lds + half * 16384);
    for (int u0 = 0; u0 < 768; u0 += 2 * (int)gridDim.x) {
        const int u = u0 + 2 * (int)blockIdx.x + half; const bool active = u < 768;
        const int bh = active ? (u >> 6) : 0, ob = active ? (u & 63) : 0;
        for (int i = ht; i < ob * 64; i += 256) km[i] = (float)kmean[bh * 4096 + i] * (1.f / 262144.f);
        __syncthreads();
        if (active && ob > 0) {
            const int b = bh / 6, h = bh % 6, t = ob * 256 + ht;
            const u32x4* qp = (const u32x4*)(QC + ((size_t)(b * SEQ + t)) * 384 + h * 64);
            float q[64];
#pragma unroll
            for (int i = 0; i < 8; ++i) { const u32x4 w = qp[i]; q[8 * i] = bflo(w.x); q[8 * i + 1] = bfhi(w.x); q[8 * i + 2] = bflo(w.y); q[8 * i + 3] = bfhi(w.y);
                q[8 * i + 4] = bflo(w.z); q[8 * i + 5] = bfhi(w.z); q[8 * i + 6] = bflo(w.w); q[8 * i + 7] = bfhi(w.w); }
            float v0 = -INFINITY, v1 = -INFINITY, v2 = -INFINITY; int i0 = 0, i1 = 0, i2 = 0;
            for (int n = 0; n < ob; ++n) {
                float d0 = 0.f, d1 = 0.f;
#pragma unroll
                for (int j = 0; j < 16; j += 2) { const f32x4 ka = *(const LAS f32x4*)(km + n * 64 + 4 * j), kb = *(const LAS f32x4*)(km + n * 64 + 4 * j + 4);
                    d0 += (q[4 * j] * ka.x + q[4 * j + 1] * ka.y) + (q[4 * j + 2] * ka.z + q[4 * j + 3] * ka.w);
                    d1 += (q[4 * j + 4] * kb.x + q[4 * j + 5] * kb.y) + (q[4 * j + 6] * kb.z + q[4 * j + 7] * kb.w); }
                const float dot = d0 + d1;
                if (dot > v2) {
                    if (dot > v1) { v2 = v1; i2 = i1; if (dot > v0) { v1 = v0; i1 = i0; v0 = dot; i0 = n; } else { v1 = dot; i1 = n; } }
                    else { v2 = dot; i2 = n; }
                }
            }
            const int nsel = ob < 3 ? ob : 3;
#pragma unroll
            for (int j = 0; j < 3; ++j) if (j < nsel) { const int n = (j == 0) ? i0 : (j == 1) ? i1 : i2;
                const unsigned pos = atomicAdd(cnt + bh * 64 + n, 1u);
                list[list_off(bh, n) + pos] = ((unsigned)t << 2) | (unsigned)j; }
        }
        __syncthreads();
    }
}

constexpr int NU_FOX = 768, NU_SEL = 768, NU_OWN = 384, NU_DIL = 1536, NU_TOTAL = NU_FOX + NU_SEL + NU_OWN + NU_DIL;
__device__ __forceinline__ void attention_phase(CArgs a, int layer, LAS unsigned char* lds, char* lds_gen, int tid, int lane, int wave) {
    asm volatile("" : "+v"(tid), "+v"(lane));
    unsigned* ctl = (unsigned*)(a->ws + WS_CTL);
    unsigned* qctr = ctl + CW_QCTR + 64 * layer;
    const unsigned* cnt = ctl + CW_CNT + 1024 * layer;
    const unsigned* list = (const unsigned*)(a->ws + WS_LIST);
    volatile LAS unsigned* qw = (volatile LAS unsigned*)(lds + LDS_QW);
    LAS unsigned char* vscr = lds + wave * 4608;
    bf16_t* QCp = (bf16_t*)(a->ws + WS_QC); const bf16_t* KCp = (const bf16_t*)(a->ws + WS_KC); const bf16_t* VCp = (const bf16_t*)(a->ws + WS_VC);
    bf16_t* PO = (bf16_t*)(a->ws + WS_PO); float* PLSE = (float*)(a->ws + WS_PLSE);
    for (;;) {
        __syncthreads();
        if (tid == 0) *qw = atomicAdd(qctr, 1u);
        __syncthreads();
        const int u = (int)*qw;
        if (u >= NU_TOTAL) break;
        int lane_ = lane; asm volatile("" : "+v"(lane_)); const int r32 = lane_ & 31, hi = lane_ >> 5;
        if (u < NU_FOX) {
            const int qb = 63 - u / 12, bh = u % 12, b = bh / 6, h = bh % 6;
#ifdef FOX_SIMPLE
            {   const int t = 256 * qb + 32 * wave + r32; const size_t tok = (size_t)(b * SEQ + t);
                bf16_t* qrow = (bf16_t*)(a->ws + WS_QA) + tok * 384 + h * 64;
                const bf16_t* Kb = (const bf16_t*)(a->ws + WS_KA) + (size_t)(b * SEQ) * 384 + h * 64; const bf16_t* Vb = (const bf16_t*)(a->ws + WS_VA) + (size_t)(b * SEQ) * 384 + h * 64;
                f32x16 o[2]; float lse2;
                small_attn(qrow, 8 * qb + wave + 1, Kb, Vb, 384, 0, 1, 0, t, 1 << 29, vscr, lane, o, lse2, (const float*)(a->ws + WS_CUM) + (size_t)bh * SEQ);
                small_store(qrow, o, hi); }
#elif !defined(NO_FOX)
            attn_body::attn_unit<8>(b, h, qb, (const attn_body::bf16*)(a->ws + WS_QA), (const attn_body::bf16*)(a->ws + WS_KA), (const attn_body::bf16*)(a->ws + WS_VA),
                                    (attn_body::bf16*)(a->ws + WS_QA), (const float*)(a->ws + WS_CUM) + (size_t)bh * SEQ, lds_gen);
#endif
        } else if (u < NU_FOX + NU_SEL) {
            const int v = u - NU_FOX, n = v / 12, bh = v % 12, b = bh / 6, h = bh % 6;
            int cn = (int)cnt[bh * 64 + n]; const int cap = (63 - n) * 256; cn = cn < cap ? cn : cap;
            const unsigned* lp = list + list_off(bh, n);
            const bf16_t* Kb = KCp + (size_t)(b * SEQ) * 384 + h * 64; const bf16_t* Vb = VCp + (size_t)(b * SEQ) * 384 + h * 64;
            for (int c = wave; c * 32 < cn; c += NWAVES) {
                const int e = c * 32 + r32; const bool valid = e < cn;
                const unsigned ent = lp[valid ? e : 0];
                const int t = (int)(ent >> 2), slot = (int)(ent & 3);
                const size_t tok = (size_t)(b * SEQ + t);
                f32x16 o[2]; float lse2;
                small_attn(QCp + tok * 384 + h * 64, 8, Kb, Vb, 384, 0, 1, 256 * n, 1 << 28, 1 << 29, vscr, lane, o, lse2);
                if (valid) { small_store(PO + ((tok * 6 + h) * 4 + slot) * 64, o, hi); if (hi == 0) PLSE[(tok * 6 + h) * 4 + slot] = lse2; }
            }
        } else if (u < NU_FOX + NU_SEL + NU_OWN) {
            const int v = u - NU_FOX - NU_SEL, bh = v / 32, pr = v % 32, b = bh / 6, h = bh % 6;
            const bf16_t* Kb = KCp + (size_t)(b * SEQ) * 384 + h * 64; const bf16_t* Vb = VCp + (size_t)(b * SEQ) * 384 + h * 64;
            for (int s = 0; s < 2; ++s) {
                const int blk = 2 * pr + s, ch = s == 0 ? wave : 7 - wave;
                const int t = 256 * blk + 32 * ch + r32; const size_t tok = (size_t)(b * SEQ + t);
                f32x16 o[2]; float lse2;
                small_attn(QCp + tok * 384 + h * 64, ch + 1, Kb, Vb, 384, 0, 1, 256 * blk, 32 * ch + r32, 1 << 29, vscr, lane, o, lse2);
                small_store(PO + ((tok * 6 + h) * 4 + 3) * 64, o, hi); if (hi == 0) PLSE[(tok * 6 + h) * 4 + 3] = lse2;
            }
        } else {
            const int v = u - NU_FOX - NU_SEL - NU_OWN, wu = v * NWAVES + wave;
            const int c512 = wu & 511, rest = wu >> 9, kvh = rest & 3, g = (rest >> 2) % 3, b = rest / 12;
            const int dil = g == 0 ? 1 : (g == 1 ? 4 : 16), cpc = 512 / dil;
            const int res = c512 / cpc, cidx = c512 % cpc, qc0 = 32 * cidx, qc = qc0 + r32, tq = qc * dil + res;
            const size_t tok = (size_t)(b * SEQ + tq);
            bf16_t* qrow = (bf16_t*)(a->ws + WS_QB) + tok * 768 + (g * 4 + kvh) * 64;
            const bf16_t* Kb = (const bf16_t*)(a->ws + WS_KB) + (size_t)(b * SEQ) * 256 + kvh * 64; const bf16_t* Vb = (const bf16_t*)(a->ws + WS_VB) + (size_t)(b * SEQ) * 256 + kvh * 64;
            f32x16 o[2]; float lse2;
            small_attn(qrow, 5, Kb, Vb, 256, qc0 - 128, dil, res, qc, 128, vscr, lane, o, lse2);
            small_store(qrow, o, hi);
            if (hi == 0) ((float*)(a->ws + WS_LSEB))[((size_t)g * T + tok) * 4 + kvh] = lse2;
        }
    }
}

__device__ __forceinline__ void combine_phase(CArgs a, int tid) {
    asm volatile("" : "+v"(tid));
    const size_t gt = (size_t)blockIdx.x * (NWAVES * 64) + tid, gs = (size_t)gridDim.x * (NWAVES * 64);
    bf16_t* QBp = (bf16_t*)(a->ws + WS_QB); const float* LSEB = (const float*)(a->ws + WS_LSEB);
    for (size_t i = gt; i < (size_t)T * 32; i += gs) {
        const int ch = (int)(i & 7), kvh = (int)((i >> 3) & 3); const size_t tok = i >> 5;
        float l[3], w[3];
#pragma unroll
        for (int g = 0; g < 3; ++g) l[g] = LSEB[((size_t)g * T + tok) * 4 + kvh];
        const float mx = fmaxf(l[0], fmaxf(l[1], l[2]));
        float ws_ = 0.f;
#pragma unroll
        for (int g = 0; g < 3; ++g) { w[g] = __builtin_amdgcn_exp2f(l[g] - mx); ws_ += w[g]; }
        const float inv = 1.f / ws_;
        float y[8] = {0.f, 0.f, 0.f, 0.f, 0.f, 0.f, 0.f, 0.f};
#pragma unroll
        for (int g = 0; g < 3; ++g) { const u32x4 ow = *(const u32x4*)(QBp + tok * 768 + (g * 4 + kvh) * 64 + ch * 8); const float wg = w[g] * inv;
            y[0] += wg * bflo(ow.x); y[1] += wg * bfhi(ow.x); y[2] += wg * bflo(ow.y); y[3] += wg * bfhi(ow.y); y[4] += wg * bflo(ow.z); y[5] += wg * bfhi(ow.z); y[6] += wg * bflo(ow.w); y[7] += wg * bfhi(ow.w); }
        u32x4 r; r.x = cvt_pk_bf16(y[0], y[1]); r.y = cvt_pk_bf16(y[2], y[3]); r.z = cvt_pk_bf16(y[4], y[5]); r.w = cvt_pk_bf16(y[6], y[7]);
        *(u32x4*)(QBp + tok * 768 + kvh * 64 + ch * 8) = r;
    }
    bf16_t* QCp = (bf16_t*)(a->ws + WS_QC); const bf16_t* PO = (const bf16_t*)(a->ws + WS_PO); const float* PLSE = (const float*)(a->ws + WS_PLSE);
    for (size_t i = gt; i < (size_t)T * 48; i += gs) {
        const int ch = (int)(i & 7); const size_t th = i >> 3; const int h = (int)(th % 6); const size_t tok = th / 6;
        const int ob = (int)((tok % SEQ) >> 8), nsel = ob < 3 ? ob : 3;
        float l[4], w[4];
#pragma unroll
        for (int j = 0; j < 4; ++j) l[j] = (j == 3 || j < nsel) ? PLSE[th * 4 + j] : -INFINITY;
        const float mx = fmaxf(fmaxf(l[0], l[1]), fmaxf(l[2], l[3]));
        float ws_ = 0.f;
#pragma unroll
        for (int j = 0; j < 4; ++j) { w[j] = __builtin_amdgcn_exp2f(l[j] - mx); ws_ += w[j]; }
        const float inv = 1.f / ws_;
        float y[8] = {0.f, 0.f, 0.f, 0.f, 0.f, 0.f, 0.f, 0.f};
#pragma unroll
        for (int j = 0; j < 4; ++j) if (j == 3 || j < nsel) { const u32x4 ow = *(const u32x4*)(PO + (th * 4 + j) * 64 + ch * 8); const float wg = w[j] * inv;
            y[0] += wg * bflo(ow.x); y[1] += wg * bfhi(ow.x); y[2] += wg * bflo(ow.y); y[3] += wg * bfhi(ow.y); y[4] += wg * bflo(ow.z); y[5] += wg * bfhi(ow.z); y[6] += wg * bflo(ow.w); y[7] += wg * bfhi(ow.w); }
        u32x4 r; r.x = cvt_pk_bf16(y[0], y[1]); r.y = cvt_pk_bf16(y[2], y[3]); r.z = cvt_pk_bf16(y[4], y[5]); r.w = cvt_pk_bf16(y[6], y[7]);
        *(u32x4*)(QCp + tok * 384 + h * 64 + ch * 8) = r;
    }
}

#ifndef MIXER_ON
#define MIXER_ON 1
#endif
#define GBX() int G = gridDim.x, bx = blockIdx.x; asm volatile("" : "+s"(G), "+s"(bx))
#define AP() ({ CArgs p_ = kp; asm volatile("" : "+s"(p_)); p_; }); GBX()
#define TIDS() int tid_ = threadIdx.x; asm volatile("" : "+v"(tid_)); const int tid = tid_, lane = tid & 63, wave = __builtin_amdgcn_readfirstlane(tid >> 6); (void)lane; (void)wave
#define XBP(a) ((bf16_t*)((a)->ws + WS_XB))
#define LFP(a) ((float*)((a)->ws + WS_LF))
#define WLP(a) ((const bf16_t*)((a)->ws + WS_W) + (size_t)layer * W_LAYER)
template <int layer> __device__ __forceinline__ void layer_body(const CArgs kp, LAS unsigned char* lds, unsigned char* lds_raw, cg::grid_group& grid) {
#if MIXER_ON
        { const CArgs a = AP(); TIDS(); if (bx < 12) scan_bh(LFP(a) + (size_t)bx * SEQ, (float*)(a->ws + WS_CUM) + (size_t)bx * SEQ, lds, tid, lane, wave); }
#ifndef NO_INPROJ
        { const CArgs a = AP(); pg8::StaticOrder S; pg8::Gemm g{XBP(a), WLP(a) + W_IN, 1024, 1024, 1024}; S.init(T, NQKV, G, bx);
          EpiInproj E{a->ws, (const f32x2*)(a->ws + WS_ROPE), (int*)((unsigned*)(a->ws + WS_CTL) + CW_KMEAN + 49152 * layer)};
          pg8::gemm_phase<EpiInproj, true>(lds, g, S, E); }
#endif
        grid.sync();
#ifndef NO_GATING
        { const CArgs a = AP(); TIDS(); gating_phase(a, layer, lds, tid); }
#endif
        grid.sync();
        { const CArgs a = AP(); TIDS(); attention_phase(a, layer, lds, (char*)lds_raw, tid, lane, wave); }
        grid.sync();
        { const CArgs a = AP(); TIDS(); combine_phase(a, tid); }
        grid.sync();
        {
            pg8::StaticOrder S; { GBX(); S.init(T, 1024, G, bx); }
            { const CArgs a = AP(); pg8::Gemm g{XBP(a), WLP(a) + W_G, 1024, 1024, 1024}; EpiGate E{(bf16_t*)(a->ws + WS_GS)}; pg8::gemm_phase<EpiGate, true>(lds, g, S, E); }
            { const CArgs a = AP(); pg8::Gemm g{(const bf16_t*)(a->ws + WS_QA), WLP(a) + W_PA, 384, 384, 384}; EpiBranch<1> E{(const bf16_t*)(a->ws + WS_GS), (bf16_t*)(a->ws + WS_MG)}; pg8::gemm_phase<EpiBranch<1>, true>(lds, g, S, E); }
#ifndef ONLY_A
            { const CArgs a = AP(); pg8::Gemm g{XBP(a), WLP(a) + W_G + (size_t)1024 * 1024, 1024, 1024, 1024}; EpiGate E{(bf16_t*)(a->ws + WS_GS)}; pg8::gemm_phase<EpiGate, true>(lds, g, S, E); }
            { const CArgs a = AP(); pg8::Gemm g{(const bf16_t*)(a->ws + WS_QB), WLP(a) + W_PB, 768, 256, 256}; EpiBranch<0> E{(const bf16_t*)(a->ws + WS_GS), (bf16_t*)(a->ws + WS_MG)}; pg8::gemm_phase<EpiBranch<0>, true>(lds, g, S, E); }
            { const CArgs a = AP(); pg8::Gemm g{XBP(a), WLP(a) + W_G + (size_t)2048 * 1024, 1024, 1024, 1024}; EpiGate E{(bf16_t*)(a->ws + WS_GS)}; pg8::gemm_phase<EpiGate, true>(lds, g, S, E); }
            { const CArgs a = AP(); pg8::Gemm g{(const bf16_t*)(a->ws + WS_QC), WLP(a) + W_PC, 384, 384, 384}; EpiBranch<0> E{(const bf16_t*)(a->ws + WS_GS), (bf16_t*)(a->ws + WS_MG)}; pg8::gemm_phase<EpiBranch<0>, true>(lds, g, S, E); }
#endif
        }
        grid.sync();
        { const CArgs a = AP(); pg8::StaticOrder S; pg8::Gemm g{(const bf16_t*)(a->ws + WS_MG), WLP(a) + W_O, 1024, 1024, 1024}; S.init(T, 1024, G, bx); EpiResid E{a->out}; pg8::gemm_phase<EpiResid, true>(lds, g, S, E); }
        grid.sync();
#else
        {
            const CArgs a = AP(); TIDS();
            for (size_t i = (size_t)bx * 512 + tid; i < (size_t)T * DM / 4; i += (size_t)G * 512) { f32x4* p = (f32x4*)a->out + i; *p = *p * DN_ALPHA; }
        }
        grid.sync();
#endif
        { const CArgs a = AP(); TIDS(); ln_phase(a->out, a->in[9] + layer * DM, a->in[10] + layer * DM, a->out, XBP(a), nullptr, nullptr, nullptr, lds, tid, lane, wave); }
        grid.sync();
#ifndef NO_P8
        { const CArgs a = AP(); pg8::StaticOrder S; pg8::Gemm g{XBP(a), WLP(a) + W_GU, 1024, 1024, 1024}; S.init(T, 2 * DFF, G, bx); EpiSwiglu E{(bf16_t*)(a->ws + WS_H)}; pg8::gemm_phase<EpiSwiglu, true>(lds, g, S, E); }
#endif
        grid.sync();
#ifndef NO_P9
        { const CArgs a = AP(); pg8::StaticOrder S; pg8::Gemm g{(const bf16_t*)(a->ws + WS_H), WLP(a) + W_D, DFF, DFF, DFF}; S.init(T, 1024, G, bx); EpiResid E{a->out}; pg8::gemm_phase<EpiResid, true>(lds, g, S, E); }
#endif
        grid.sync();
        if (layer + 1 < DEPTH) {
            { const CArgs a = AP(); TIDS(); ln_phase(a->out, a->in[14] + layer * DM, a->in[15] + layer * DM, a->out, XBP(a), a->in[3] + (size_t)(layer + 1) * 1024 * DIN, a->in[4] + (layer + 1) * 6, LFP(a), lds, tid, lane, wave); }
            grid.sync();
        } else {
            const CArgs a = AP(); TIDS(); ln_phase(a->out, a->in[14] + layer * DM, a->in[15] + layer * DM, a->out, XBP(a), nullptr, nullptr, nullptr, lds, tid, lane, wave);
        }
}

__global__ void __launch_bounds__(NWAVES * 64, 2) fwd_kernel(Args a_unused) {
    extern __shared__ __attribute__((aligned(16))) unsigned char lds_raw[];
    cg::grid_group grid = cg::this_grid();
    LAS unsigned char* lds = (LAS unsigned char*)lds_raw;
    const CArgs kp = (CArgs)__builtin_amdgcn_kernarg_segment_ptr();

    {
        const CArgs a = AP(); TIDS();
        LAS float* scr = (LAS float*)(lds + wave * 16384);
        for (int it = bx * NWAVES + wave; it < 2 * IT_LAYER; it += G * NWAVES) prologue_item(a, it, scr, lane);
        f32x2* rope = (f32x2*)(a->ws + WS_ROPE);
        for (int i = bx * (NWAVES * 64) + tid; i < SEQ * 8; i += G * NWAVES * 64) {
            const int pos = i >> 3, fi = i & 7; double t = (double)pos * ROPE_FR[fi]; t -= floor(t); const float fr = (float)t;
            rope[i] = (f32x2){__builtin_amdgcn_cosf(fr), __builtin_amdgcn_sinf(fr)};
        }
        __syncthreads();
        ln_phase(a->in[0], a->in[1], a->in[2], a->out, XBP(a), a->in[3], a->in[4], LFP(a), lds, tid, lane, wave);
    }
    grid.sync();

    layer_body<0>(kp, lds, lds_raw, grid);
    layer_body<1>(kp, lds, lds_raw, grid);
}

extern "C" void kernel_launch(void* const* d_in, const int* in_sizes, int n_in, void* d_out, int out_size, void* d_ws, size_t ws_size, hipStream_t stream) {
    static int grid = 0;
    if (grid == 0) {
        if (n_in != 16 || in_sizes[0] != T * DM || out_size != T * DM || ws_size < WS_END) {
            fprintf(stderr, "kernel_launch: unexpected problem geometry (n_in %d, in0 %d, out %d, ws %zu)\n", n_in, n_in > 0 ? in_sizes[0] : -1, out_size, ws_size); grid = -1; return; }
        int dev = 0, cus = 0, per_cu = 0;
        (void)hipGetDevice(&dev); (void)hipDeviceGetAttribute(&cus, hipDeviceAttributeMultiprocessorCount, dev);
        if (hipFuncSetAttribute((const void*)fwd_kernel, hipFuncAttributeMaxDynamicSharedMemorySize, LDS_BYTES) != hipSuccess) { fprintf(stderr, "kernel_launch: hipFuncSetAttribute failed\n"); grid = -1; return; }
        if (hipOccupancyMaxActiveBlocksPerMultiprocessor(&per_cu, (const void*)fwd_kernel, NWAVES * 64, LDS_BYTES) != hipSuccess || per_cu < 1) { fprintf(stderr, "kernel_launch: occupancy query says %d\n", per_cu); per_cu = 1; }
        (void)hipGetLastError();
        grid = cus * 1;
        if (grid % 8 != 0 || grid <= 0) grid = 256;
    }
    if (grid < 0) return;
    (void)hipMemsetAsync((char*)d_ws + WS_CTL, 0, CTL_BYTES, stream);
    Args a{};
    for (int i = 0; i < 16; ++i) a.in[i] = (const float*)d_in[i];
    a.out = (float*)d_out; a.ws = (unsigned char*)d_ws;
    void* args[] = {&a};
    const hipError_t e = hipLaunchCooperativeKernel((const void*)fwd_kernel, dim3(grid), dim3(NWAVES * 64), args, LDS_BYTES, stream);
    if (e != hipSuccess) fprintf(stderr, "kernel_launch: cooperative launch failed: %s (grid %d)\n", hipGetErrorString(e), grid);
}
```

```cpp
#include <hip/hip_runtime.h>
#include <hip/hip_cooperative_groups.h>
#include <hip/hip_bf16.h>
#include <cstdio>
#include <cstdint>
#include <cmath>
namespace cg = cooperative_groups;

#define LAS __attribute__((address_space(3)))
typedef unsigned short bf16_t;
typedef short bf16x8 __attribute__((ext_vector_type(8)));
typedef short s16x4 __attribute__((ext_vector_type(4)));
typedef float f32x2 __attribute__((ext_vector_type(2)));
typedef float f32x4 __attribute__((ext_vector_type(4)));
typedef float f32x16 __attribute__((ext_vector_type(16)));
typedef unsigned u32x4 __attribute__((ext_vector_type(4)));
typedef unsigned u32x2 __attribute__((ext_vector_type(2)));

constexpr int BATCH = 2, SEQ = 16384, DM = 1024, T = BATCH * SEQ, DEPTH = 2, DFF = 2816, DIN = 6662;
constexpr int NQKV = 3584, NG = 3072;
constexpr float LN_EPS = 1e-5f;
constexpr float DN_ALPHA = 1.4142135623730951f;
constexpr float LOG2E = 1.4426950408889634f;
constexpr float C2 = 0.125f * LOG2E;
constexpr int NWAVES = 8;

typedef __bf16 bf16x2_t __attribute__((ext_vector_type(2)));
__device__ __forceinline__ unsigned cvt_pk_bf16(float lo, float hi) { f32x2 v = {lo, hi}; bf16x2_t b = __builtin_convertvector(v, bf16x2_t); return __builtin_bit_cast(unsigned, b); }
__device__ __forceinline__ float bf2f(unsigned short b) { return __uint_as_float(((unsigned)b) << 16); }
__device__ __forceinline__ float bflo(unsigned w) { return __uint_as_float(w << 16); }
__device__ __forceinline__ float bfhi(unsigned w) { return __uint_as_float(w & 0xffff0000u); }

namespace pg8 {
constexpr int BM = 256, BK = 64, HALF = 128, HTB = HALF * BK * 2, STAGE_BYTES = 8 * HTB, NXCD = 8, WGM = 8;
__host__ __device__ __forceinline__ int lds_byte(int r, int c) { const int st = (r >> 4) * 2 + (c >> 5), rr = r & 15, cc = c & 31, ob = rr * 64 + cc * 2; return st * 1024 + (ob ^ (((ob >> 9) & 1) << 5)); }
__host__ __device__ __forceinline__ void stage_rc(int b, int& R, int& C) { const int st = b / 1024, sb = b % 1024, swz = sb ^ (((sb >> 9) & 1) << 5); R = (st >> 1) * 16 + swz / 64; C = (st & 1) * 32 + (swz % 64) / 2; }
__host__ __device__ __forceinline__ int perm32(int rho) { const int n = rho >> 4, i = rho & 15; return 8 * (i >> 2) + 4 * n + (i & 3); }

struct Unit { int pm, pn; };
struct Gemm { const bf16_t* A; const bf16_t* Bt; int lda, ldb, K; };

struct StaticOrder {
    int nM, nN, nwg, G, c;
    __host__ __device__ void init(int M, int N, int G_, int c_) { nM = M / BM; nN = N / BM; nwg = nM * nN; G = G_; c = c_; }
    __host__ __device__ bool next(int i, Unit& u) const {
        const long L = (long)i * G + c; if (L >= nwg) return false;
        int wgid = (int)L; { const int q = nwg / NXCD, r = nwg % NXCD, xcd = wgid % NXCD, off = wgid / NXCD; wgid = (xcd < r ? xcd * (q + 1) : r * (q + 1) + (xcd - r) * q) + off; }
        const int nig = WGM * nN, gid = wgid / nig, fm = gid * WGM, gsz = (nM - fm) < WGM ? (nM - fm) : WGM;
        u.pm = fm + ((wgid % nig) % gsz); u.pn = (wgid % nig) / gsz; return true;
    }
};

template <class Epi, bool ALIGN_EPI>
__device__ __forceinline__ void gemm_phase(LAS unsigned char* lds, const Gemm g, const StaticOrder& S, const Epi& E) {
    int tid_ = threadIdx.x; asm volatile("" : "+v"(tid_));
    const int tid = tid_, wid = __builtin_amdgcn_readfirstlane(tid >> 6), lane = tid & 63, wr = wid >> 2, wc = wid & 3, fr = lane & 15, fq = lane >> 4;
    const int nt = g.K / BK;
    unsigned voffA[2], voffB[2];
#pragma unroll
    for (int i = 0; i < 2; ++i) { int R, C; stage_rc(tid * 16 + i * 8192, R, C); const int Rb = (R & ~31) + perm32(R & 31);
        voffA[i] = (unsigned)(R * g.lda + C) * 2u; voffB[i] = (unsigned)(Rb * g.ldb + C) * 2u; }
    const size_t kstep = (size_t)(BK * 2);
    const size_t hA = (size_t)HALF * g.lda * 2, hB = (size_t)HALF * g.ldb * 2;
    const size_t tA = 2 * hA, tB = 2 * hB;
    const unsigned ldsw = (unsigned)wid * 1024u;
    const int aoff = lds_byte(wr * 64 + fr, fq * 8), boff = lds_byte(wc * 32 + fr, fq * 8);
#define PG8_SA(b, h) (((b) * 2 + (h)) * HTB)
#define PG8_SB(b, h) ((4 + (b) * 2 + (h)) * HTB)
#define PG8_STAGE(bufoff, gbase, voff) do { _Pragma("unroll") for (int _i = 0; _i < 2; ++_i) \
        __builtin_amdgcn_global_load_lds((const unsigned*)((const char*)(gbase) + (voff)[_i]), (LAS unsigned*)(lds + (bufoff) + ldsw + _i * 8192), 16, 0, 0); } while (0)
#define PG8_LDA(dst, b, h) do { _Pragma("unroll") for (int m = 0; m < 4; ++m) _Pragma("unroll") for (int k = 0; k < 2; ++k) dst[m][k] = *(const LAS bf16x8*)(lds + PG8_SA(b, h) + aoff + m * 2048 + k * 1024); } while (0)
#define PG8_LDB(dst, b, h) do { _Pragma("unroll") for (int n = 0; n < 2; ++n) _Pragma("unroll") for (int k = 0; k < 2; ++k) dst[n][k] = *(const LAS bf16x8*)(lds + PG8_SB(b, h) + boff + n * 2048 + k * 1024); } while (0)
#define PG8_MMA(ai, bj, At, Bt) do { __builtin_amdgcn_s_setprio(1); _Pragma("unroll") for (int m = 0; m < 4; ++m) _Pragma("unroll") for (int n = 0; n < 2; ++n) _Pragma("unroll") for (int k = 0; k < 2; ++k) \
        acc[ai][bj][m][n] = __builtin_amdgcn_mfma_f32_16x16x32_bf16(Bt[n][k], At[m][k], acc[ai][bj][m][n], 0, 0, 0); __builtin_amdgcn_s_setprio(0); } while (0)
#define PG8_WAIT_V(n) asm volatile("s_waitcnt vmcnt(" #n ")" ::: "memory")
#define PG8_WAIT_L(n) asm volatile("s_waitcnt lgkmcnt(" #n ")" ::: "memory")
#define PG8_BAR __builtin_amdgcn_s_barrier()
#define PG8_SCHED __builtin_amdgcn_sched_barrier(0)
    Unit cur, nxt; int ui = 0;
    if (!S.next(0, cur)) return;
    f32x4 acc[2][2][4][2];
#pragma unroll
    for (int a = 0; a < 2; ++a)
#pragma unroll
        for (int b = 0; b < 2; ++b)
#pragma unroll
            for (int m = 0; m < 4; ++m)
#pragma unroll
                for (int n = 0; n < 2; ++n) acc[a][b][m][n] = (f32x4){0.f, 0.f, 0.f, 0.f};
    bf16x8 At[4][2], B0[2][2], B1[2][2];
    const char* cA = (const char*)g.A + (size_t)cur.pm * tA; const char* cB = (const char*)g.Bt + (size_t)cur.pn * tB;
    PG8_STAGE(PG8_SB(0, 0), cB, voffB); PG8_STAGE(PG8_SB(0, 1), cB + hB, voffB); PG8_STAGE(PG8_SA(0, 0), cA, voffA); PG8_STAGE(PG8_SA(0, 1), cA + hA, voffA);
    if (wr == 1) PG8_BAR;
    PG8_WAIT_V(2); PG8_BAR;
    PG8_STAGE(PG8_SB(1, 0), cB + kstep, voffB); PG8_STAGE(PG8_SA(1, 0), cA + kstep, voffA); PG8_STAGE(PG8_SB(1, 1), cB + hB + kstep, voffB);
    PG8_WAIT_V(6); PG8_BAR;
    for (;;) {
        const bool has_next = S.next(ui + 1, nxt);
        const char* nA = has_next ? (const char*)g.A + (size_t)nxt.pm * tA : cA; const char* nB = has_next ? (const char*)g.Bt + (size_t)nxt.pn * tB : cB;
        for (int t = 0; t < nt; t += 2) {
            const bool last = (t == nt - 2);
            const char* a1 = cA + (size_t)(t + 1) * kstep;
            const char* a2 = last ? nA : cA + (size_t)(t + 2) * kstep; const char* b2 = last ? nB : cB + (size_t)(t + 2) * kstep;
            const char* a3 = a2 + kstep; const char* b3 = b2 + kstep;
            PG8_LDB(B0, 0, 0); PG8_LDB(B1, 0, 1); PG8_SCHED; PG8_LDA(At, 0, 0); PG8_STAGE(PG8_SA(1, 1), a1 + hA, voffA);
            PG8_WAIT_V(8); PG8_WAIT_L(0); PG8_BAR; PG8_MMA(0, 0, At, B0); PG8_MMA(0, 1, At, B1); PG8_BAR; PG8_SCHED;
            PG8_LDA(At, 0, 1); PG8_STAGE(PG8_SB(0, 0), b2, voffB); PG8_STAGE(PG8_SB(0, 1), b2 + hB, voffB); PG8_STAGE(PG8_SA(0, 0), a2, voffA);
            PG8_WAIT_V(8); PG8_WAIT_L(0); PG8_BAR; PG8_MMA(1, 0, At, B0); PG8_MMA(1, 1, At, B1); PG8_BAR; PG8_SCHED;
            PG8_LDB(B0, 1, 0); PG8_LDB(B1, 1, 1); PG8_SCHED; PG8_LDA(At, 1, 0); PG8_STAGE(PG8_SA(0, 1), a2 + hA, voffA);
            PG8_WAIT_V(8); PG8_WAIT_L(0); PG8_BAR; PG8_MMA(0, 0, At, B0); PG8_MMA(0, 1, At, B1); PG8_BAR; PG8_SCHED;
            PG8_LDA(At, 1, 1); PG8_STAGE(PG8_SB(1, 0), b3, voffB); PG8_STAGE(PG8_SB(1, 1), b3 + hB, voffB); PG8_STAGE(PG8_SA(1, 0), a3, voffA);
            PG8_WAIT_V(8); PG8_WAIT_L(0); PG8_BAR; PG8_MMA(1, 0, At, B0); PG8_MMA(1, 1, At, B1); PG8_BAR; PG8_SCHED;
        }
        if constexpr (ALIGN_EPI) { if (wr == 0) PG8_BAR; }
        E(acc, cur, wr, wc, fr, fq);
        if (!has_next) break;
#pragma unroll
        for (int a = 0; a < 2; ++a)
#pragma unroll
            for (int b = 0; b < 2; ++b)
#pragma unroll
                for (int m = 0; m < 4; ++m)
#pragma unroll
                    for (int n = 0; n < 2; ++n) acc[a][b][m][n] = (f32x4){0.f, 0.f, 0.f, 0.f};
        cur = nxt; cA = nA; cB = nB; ++ui;
        if constexpr (ALIGN_EPI) { if (wr == 1) PG8_BAR; }
    }
    PG8_WAIT_V(0);
    if constexpr (!ALIGN_EPI) { if (wr == 0) PG8_BAR; }
    PG8_BAR;
#undef PG8_SA
#undef PG8_SB
#undef PG8_STAGE
#undef PG8_LDA
#undef PG8_LDB
#undef PG8_MMA
#undef PG8_WAIT_V
#undef PG8_WAIT_L
#undef PG8_BAR
#undef PG8_SCHED
}
}
namespace attn_body {
using bf16=__hip_bfloat16;
using bf16x8=__attribute__((ext_vector_type(8)))short;
using s16x4=__attribute__((ext_vector_type(4)))short;
using f32x16=__attribute__((ext_vector_type(16)))float;
using u32x4=__attribute__((ext_vector_type(4)))unsigned;
using f32x4v=__attribute__((ext_vector_type(4)))float;
constexpr int BATCH=2,NHEAD=6,SEQ=16384,D=64,DM=NHEAD*D;
constexpr int NW=8,QBLK=32,QB=QBLK*NW,KVBLK=64,NQB=SEQ/QB;
constexpr int ATTN_PITCH=DM, ATTN_UNIT_ROWS=QB;
__device__ __forceinline__ int crow(int r,int hi){return (r&3)+8*(r>>2)+4*hi;}
#define SBAR() __builtin_amdgcn_sched_barrier(0)
__device__ __forceinline__ void cmask(f32x16&p0,f32x16&p1,int jb,int qrel,int hi){
  const float NEG=-INFINITY; int kb=64*jb+4*hi;
  #pragma unroll
  for(int r=0;r<16;++r){int kv=kb+(r&3)+8*(r>>2); if(kv>qrel)p0[r]=NEG; if(kv+32>qrel)p1[r]=NEG;}
}

constexpr int NSLOT=3, SLOTB=8192;
constexpr int LDS_K=0, LDS_V=NSLOT*SLOTB, LDS_WS=2*NSLOT*SLOTB, LDS_OST=LDS_WS+NW*64*4, LDS_BIAS=LDS_OST+NW*4096, LDS_BYTES=LDS_BIAS+SEQ*4;
constexpr float C2=0.125f*1.4426950408889634f;
__device__ __forceinline__ void glds16(const void*gsrc,unsigned lds_dst){unsigned keep;
  asm volatile("s_mov_b32 %0, m0\n\ts_mov_b32 m0, %2\n\ts_nop 0\n\tglobal_load_lds_dwordx4 %1, off\n\ts_mov_b32 m0, %0":"=&s"(keep):"v"(gsrc),"s"(lds_dst):"memory");}
__device__ __forceinline__ float max3f(float a,float b,float c){float r;asm("v_max3_f32 %0, %1, %2, %3":"=v"(r):"v"(a),"v"(b),"v"(c));return r;}
__device__ __forceinline__ float max2f(float a,float b){float r;asm("v_max_f32_e32 %0, %1, %2":"=v"(r):"v"(a),"v"(b));return r;}
__device__ __forceinline__ float fadd_s(float a,float b){float r;asm("v_add_f32_e32 %0, %1, %2":"=v"(r):"v"(a),"v"(b));return r;}
__device__ __forceinline__ float fsub_s(float a,float b){float r;asm("v_sub_f32_e32 %0, %1, %2":"=v"(r):"v"(a),"v"(b));return r;}
typedef float f32x2_t __attribute__((ext_vector_type(2))); typedef __bf16 bf16x2_t __attribute__((ext_vector_type(2)));
__device__ __forceinline__ unsigned cvtpk_s(float lo,float hi){f32x2_t v={lo,hi};bf16x2_t b=__builtin_convertvector(v,bf16x2_t);return __builtin_bit_cast(unsigned,b);}
#define WAIT_BAR(N) asm volatile("s_waitcnt vmcnt(" #N ") lgkmcnt(0)\n\ts_barrier":::"memory")

__device__ __forceinline__ void qkt(f32x16&p0,f32x16&p1,const char*Kslot,const bf16x8*qr,int r32,int hi){
  const char*kb=Kslot+hi*1024+r32*16;
  #pragma unroll
  for(int d0=0;d0<4;++d0){
    const bf16x8 b0=*reinterpret_cast<const bf16x8*>(kb+d0*2048);
    const bf16x8 b1=*reinterpret_cast<const bf16x8*>(kb+d0*2048+512);
    {p0=__builtin_amdgcn_mfma_f32_32x32x16_bf16(b0,qr[d0],p0,0,0,0);p1=__builtin_amdgcn_mfma_f32_32x32x16_bf16(b1,qr[d0],p1,0,0,0);}}
}
typedef __attribute__((address_space(3))) const char* lds_cptr;
typedef short v4i16_t __attribute__((ext_vector_type(4)));
__device__ __forceinline__ void kload8(bf16x8*kf,lds_cptr kp){
  kf[0]=*(const __attribute__((address_space(3))) bf16x8*)(kp);      kf[1]=*(const __attribute__((address_space(3))) bf16x8*)(kp+512);
  kf[2]=*(const __attribute__((address_space(3))) bf16x8*)(kp+2048); kf[3]=*(const __attribute__((address_space(3))) bf16x8*)(kp+2560);
  kf[4]=*(const __attribute__((address_space(3))) bf16x8*)(kp+4096); kf[5]=*(const __attribute__((address_space(3))) bf16x8*)(kp+4608);
  kf[6]=*(const __attribute__((address_space(3))) bf16x8*)(kp+6144); kf[7]=*(const __attribute__((address_space(3))) bf16x8*)(kp+6656);
}
__device__ __forceinline__ void kload2(bf16x8*kf,lds_cptr kp,int j){ kf[2*j]=*(const __attribute__((address_space(3))) bf16x8*)(kp+j*2048); kf[2*j+1]=*(const __attribute__((address_space(3))) bf16x8*)(kp+j*2048+512); }
__device__ __forceinline__ s16x4 vtr(lds_cptr p){ return __builtin_bit_cast(s16x4,__builtin_amdgcn_ds_read_tr16_b64_v4i16((__attribute__((address_space(3))) v4i16_t*)p)); }
__device__ __forceinline__ float rowmax(const f32x16&p0,const f32x16&p1){
  float a=max3f(p0[0],p0[1],p1[0]),b=max3f(p0[2],p0[3],p1[1]);a=max3f(a,p1[2],p1[3]);
  #pragma unroll
  for(int r=4;r<16;r+=4){a=max3f(a,p0[r],p0[r+1]);b=max3f(b,p0[r+2],p0[r+3]);a=max3f(a,p1[r],p1[r+1]);b=max3f(b,p1[r+2],p1[r+3]);}
  const float m=max2f(a,b);
  auto rr=__builtin_amdgcn_permlane32_swap(__float_as_uint(m),__float_as_uint(m),false,false);
  return max2f(__uint_as_float(rr[0]),__uint_as_float(rr[1]));
}
__device__ __forceinline__ void pv(f32x16*o,int vb,bf16x8 pa0,bf16x8 pa1,bf16x8 pa2,bf16x8 pa3){
  #pragma unroll
  for(int d0=0;d0<2;++d0){s16x4 lo[4],hi[4];
    #pragma unroll
    for(int ks=0;ks<4;++ks){
      asm volatile("ds_read_b64_tr_b16 %0,%1 offset:%c2":"=&v"(lo[ks]):"v"(vb),"i"(d0*4096+ks*1024):"memory");
      asm volatile("ds_read_b64_tr_b16 %0,%1 offset:%c2":"=&v"(hi[ks]):"v"(vb),"i"(d0*4096+ks*1024+512):"memory");}
    asm volatile("s_waitcnt lgkmcnt(0)":::"memory");SBAR();
    #define PK(k) (bf16x8){lo[k][0],lo[k][1],lo[k][2],lo[k][3],hi[k][0],hi[k][1],hi[k][2],hi[k][3]}
    o[d0]=__builtin_amdgcn_mfma_f32_32x32x16_bf16(pa0,PK(0),o[d0],0,0,0);
    o[d0]=__builtin_amdgcn_mfma_f32_32x32x16_bf16(pa1,PK(1),o[d0],0,0,0);
    o[d0]=__builtin_amdgcn_mfma_f32_32x32x16_bf16(pa2,PK(2),o[d0],0,0,0);
    o[d0]=__builtin_amdgcn_mfma_f32_32x32x16_bf16(pa3,PK(3),o[d0],0,0,0);
    #undef PK
  }
}

#ifndef ATTN_STORE16
#define ATTN_STORE16(p,v) (*(u32x4*)(p)=(v))
#endif
template<int THRL> __device__ __forceinline__ void attn_unit(int b,int h,int qb,const bf16*Q,const bf16*__restrict__ K,const bf16*__restrict__ V,bf16*O,const float*__restrict__ cum,char*shm){
  int tid_=threadIdx.x; asm volatile("":"+v"(tid_)); const int tid=tid_,lane=tid&63,r32=lane&31,hi=lane>>5; const int wid=__builtin_amdgcn_readfirstlane(tid>>6);
  const long rowbase=(long)b*SEQ; const int q0=qb*QB;
  const bf16*Qw=Q+(rowbase+q0+wid*QBLK)*DM+h*D;
  const bf16*Kh=K+rowbase*DM+h*D,*Vh=V+rowbase*DM+h*D;
  const unsigned lds0=(unsigned)(uintptr_t)shm;
  float*wsf=(float*)(shm+LDS_WS)+wid*64;
  const bf16*ksrc=Kh+(long)lane*DM+wid*8;
  const bf16*vsrc=Vh+(long)(16*(wid&3)+(lane>>2))*DM+(wid>>2)*32+(lane&3)*8;
  const unsigned kdst=lds0+LDS_K+wid*1024, vdst=lds0+LDS_V+wid*1024;
  #define DMA_K(t,slot) glds16(ksrc+(long)(t)*KVBLK*DM,(unsigned)__builtin_amdgcn_readfirstlane(kdst+(slot)))
  #define DMA_V(t,slot) glds16(vsrc+(long)(t)*KVBLK*DM,(unsigned)__builtin_amdgcn_readfirstlane(vdst+(slot)))
  const int vb0=(int)(lds0+LDS_V)+((lane>>4)&1)*32+(lane&3)*8+(4*hi+((lane&15)>>2))*64;
  const char*Kbase=shm+LDS_K; bf16x8 kf[8];
  const lds_cptr shm3=(lds_cptr)shm; const lds_cptr kp0=shm3+LDS_K+hi*1024+r32*16; const lds_cptr vp0=shm3+LDS_V+((lane>>4)&1)*32+(lane&3)*8+(4*hi+((lane&15)>>2))*64;
  const int NT=(q0+QB)/KVBLK;
  const __attribute__((address_space(3))) float* biasl=(const __attribute__((address_space(3))) float*)(shm3+LDS_BIAS);
  { __attribute__((address_space(3))) float* bw=(__attribute__((address_space(3))) float*)(shm3+LDS_BIAS);
    for(int i=tid*4;i<q0+QB;i+=NW*64*4){ f32x4v v=*reinterpret_cast<const f32x4v*>(cum+i); v=v*(-1.4426950408889634f); *(__attribute__((address_space(3))) f32x4v*)(bw+i)=v; }
    asm volatile("s_waitcnt vmcnt(0) lgkmcnt(0)\n\ts_barrier":::"memory"); }
  DMA_K(0,0);DMA_V(0,0);DMA_K(1,SLOTB);
  bf16x8 qr[4];
  #pragma unroll
  for(int d0=0;d0<4;++d0)qr[d0]=*reinterpret_cast<const bf16x8*>(&Qw[(long)r32*DM+d0*16+hi*8]);
  float mhat=0.f,l_reg=0.f;f32x16 o[2];o[0]=f32x16{};o[1]=f32x16{};
  #define BIASFILL(C0,C1,t) do{ const __attribute__((address_space(3))) float* bp_=biasl+64*(t)+4*hi; \
    _Pragma("unroll") for(int g_=0;g_<4;++g_){ const f32x4v v_=*(const __attribute__((address_space(3))) f32x4v*)(bp_+8*g_); const f32x4v w_=*(const __attribute__((address_space(3))) f32x4v*)(bp_+32+8*g_); \
      _Pragma("unroll") for(int i_=0;i_<4;++i_){ C0[4*g_+i_]=v_[i_]-mhat; C1[4*g_+i_]=w_[i_]-mhat; } } }while(0)
  const int qrel=wid*QBLK+r32;
  #define CMASK(P0,P1,t) do{int jb_=(t)-(NT-4); if(jb_>=0)cmask(P0,P1,jb_,qrel,hi);}while(0)
  bool resc=false;
  #define START(P0,P1) do{ const float rm=rowmax(P0,P1); resc=false; \
    { const float dl=rm; mhat=fadd_s(mhat,dl); \
      _Pragma("unroll") for(int r=0;r<16;++r){P0[r]=fsub_s(P0[r],dl);P1[r]=fsub_s(P1[r],dl);} \
      } \
    _Pragma("unroll") for(int r=0;r<16;++r)P0[r]=__builtin_amdgcn_exp2f(P0[r]); }while(0)
  #define RESC() do{ if(resc){ asm volatile("s_waitcnt lgkmcnt(0)":::"memory"); \
      _Pragma("unroll") for(int d_=0;d_<2;++d_) _Pragma("unroll") for(int r=0;r<16;++r)o[d_][r]*=wsf[crow(r,hi)]; } }while(0)
  f32x16 pA0,pA1,pB0,pB1;
  int sl_prev=0,sl_cur=0,sl_next=SLOTB;
  #define ROT() do{sl_prev=sl_cur;sl_cur=sl_next;sl_next=(sl_next==(NSLOT-1)*SLOTB)?0:sl_next+SLOTB;}while(0)
  DMA_K(2,2*SLOTB);
  WAIT_BAR(3);
  BIASFILL(pA0,pA1,0); qkt(pA0,pA1,Kbase,qr,r32,hi);asm volatile("s_nop 15\n\ts_nop 7":"+v"(pA0),"+v"(pA1));CMASK(pA0,pA1,0);
  START(pA0,pA1);
  _Pragma("unroll") for(int r=0;r<16;++r)pA1[r]=__builtin_amdgcn_exp2f(pA1[r]);
  WAIT_BAR(0);
  DMA_K(3,0);DMA_V(1,SLOTB);
  ROT();
  kload8(kf,kp0+sl_cur);
  WAIT_BAR(2);
  s16x4 vlo[8],vhi[8]; u32x4 pw0,pw1,pw2,pw3;
  #define PKW(P,B) cvtpk_s(P[B],P[B+1])
  #define PAF(k) __builtin_bit_cast(bf16x8,pw##k)
  #define VFR(i) (bf16x8){vlo[i][0],vlo[i][1],vlo[i][2],vlo[i][3],vhi[i][0],vhi[i][1],vhi[i][2],vhi[i][3]}
  #define PIN(x) asm volatile("":"+v"(x))
  #define MX3(a,b,c) __builtin_fmaxf(__builtin_fmaxf((a),(b)),(c))
  #define GAPA(MF,A0,A1,A2,A3,W0,W1,PW) do{ MF; sacc+=A0; sacc+=A1; sacc+=A2; sacc+=A3; PIN(sacc); W0; W1; PIN(PW); SBAR(); }while(0)
  #define EX(v) __builtin_amdgcn_exp2f(v)
  #define GAPB(MF,X,B) do{ MF; X[B]=EX(X[B]); X[B+1]=EX(X[B+1]); X[B+2]=EX(X[B+2]); X[B+3]=EX(X[B+3]); PIN(X); SBAR(); }while(0)
  #define VRD(i) do{ vlo[i]=vtr(vp_+(((i)>>2)*4096+((i)&3)*1024)); vhi[i]=vtr(vp_+(((i)>>2)*4096+((i)&3)*1024+512)); }while(0)
  #define KRD(G,j) do{ if(G){ kload2(kf,kp0+sl_next,j); SBAR(); } }while(0)
  #define STEP(C0,C1,P0,P1,t,GK,GV,GL) do{ SBAR(); \
    BIASFILL(C0,C1,t); SBAR(); \
    const lds_cptr vp_=vp0+sl_prev; \
    VRD(0); SBAR(); float sacc=(P0[0]+P0[1]); \
    GAPA(C0=__builtin_amdgcn_mfma_f32_32x32x16_bf16(kf[0],qr[0],C0,0,0,0), P0[2],P0[3],P0[4],P0[5],     pw0[0]=PKW(P0,0), pw0[1]=PKW(P0,2), pw0); \
    VRD(4); SBAR(); GAPA(C1=__builtin_amdgcn_mfma_f32_32x32x16_bf16(kf[1],qr[0],C1,0,0,0), P0[6],P0[7],P0[8],P0[9],     pw0[2]=PKW(P0,4), pw0[3]=PKW(P0,6), pw0); \
    VRD(1); SBAR(); GAPA(C0=__builtin_amdgcn_mfma_f32_32x32x16_bf16(kf[2],qr[1],C0,0,0,0),   P0[10],P0[11],P0[12],P0[13], pw1[0]=PKW(P0,8), pw1[1]=PKW(P0,10), pw1); \
    VRD(5); SBAR(); GAPA(C1=__builtin_amdgcn_mfma_f32_32x32x16_bf16(kf[3],qr[1],C1,0,0,0),   P0[14],P0[15],P1[0],P1[1],   pw1[2]=PKW(P0,12),pw1[3]=PKW(P0,14), pw1); \
    VRD(2); SBAR(); GAPA(C0=__builtin_amdgcn_mfma_f32_32x32x16_bf16(kf[4],qr[2],C0,0,0,0),   P1[2],P1[3],P1[4],P1[5],     pw2[0]=PKW(P1,0), pw2[1]=PKW(P1,2), pw2); \
    VRD(6); SBAR(); GAPA(C1=__builtin_amdgcn_mfma_f32_32x32x16_bf16(kf[5],qr[2],C1,0,0,0),   P1[6],P1[7],P1[8],P1[9],     pw2[2]=PKW(P1,4), pw2[3]=PKW(P1,6), pw2); \
    VRD(3); SBAR(); GAPA(C0=__builtin_amdgcn_mfma_f32_32x32x16_bf16(kf[6],qr[3],C0,0,0,0),   P1[10],P1[11],P1[12],P1[13], pw3[0]=PKW(P1,8), pw3[1]=PKW(P1,10), pw3); \
    VRD(7); SBAR(); GAPA(C1=__builtin_amdgcn_mfma_f32_32x32x16_bf16(kf[7],qr[3],C1,0,0,0),   P1[14],P1[15],0.f,0.f,       pw3[2]=PKW(P1,12),pw3[3]=PKW(P1,14), pw3); \
    l_reg+=sacc; \
    if(GK){DMA_K((t)+3,sl_cur);} if(GV){DMA_V((t)+1,sl_next);} \
    CMASK(C0,C1,t); \
    { float a=MX3(C0[0],C0[1],C1[0]),b=MX3(C0[2],C0[3],C1[1]); a=MX3(a,C1[2],C1[3]); \
      _Pragma("unroll") for(int r=4;r<16;r+=4){a=MX3(a,C0[r],C0[r+1]);b=MX3(b,C0[r+2],C0[r+3]);a=MX3(a,C1[r],C1[r+1]);b=MX3(b,C1[r+2],C1[r+3]);} \
      float rm=__builtin_fmaxf(a,b); { auto rr=__builtin_amdgcn_permlane32_swap(__float_as_uint(rm),__float_as_uint(rm),false,false); rm=__builtin_fmaxf(__uint_as_float(rr[0]),__uint_as_float(rr[1])); } \
      resc=false; \
      if(__builtin_expect(__any(rm>(float)THRL),0)){ const float dl=__builtin_fmaxf(rm,0.f); mhat+=dl; \
        _Pragma("unroll") for(int r=0;r<16;++r){C0[r]-=dl;C1[r]-=dl;} \
        const float f=__builtin_amdgcn_exp2f(-dl); l_reg*=f; if(hi==0)wsf[r32]=f; resc=true; } } \
    SBAR(); \
    GAPB(o[0]=__builtin_amdgcn_mfma_f32_32x32x16_bf16(PAF(0),VFR(0),o[0],0,0,0), C0,0); \
    GAPB(o[1]=__builtin_amdgcn_mfma_f32_32x32x16_bf16(PAF(0),VFR(4),o[1],0,0,0), C0,4); \
    KRD(GL,0); GAPB(o[0]=__builtin_amdgcn_mfma_f32_32x32x16_bf16(PAF(1),VFR(1),o[0],0,0,0), C0,8); \
    KRD(GL,1); GAPB(o[1]=__builtin_amdgcn_mfma_f32_32x32x16_bf16(PAF(1),VFR(5),o[1],0,0,0), C0,12); \
    KRD(GL,2); GAPB(o[0]=__builtin_amdgcn_mfma_f32_32x32x16_bf16(PAF(2),VFR(2),o[0],0,0,0), C1,0); \
    KRD(GL,3); GAPB(o[1]=__builtin_amdgcn_mfma_f32_32x32x16_bf16(PAF(2),VFR(6),o[1],0,0,0), C1,4); \
    GAPB(o[0]=__builtin_amdgcn_mfma_f32_32x32x16_bf16(PAF(3),VFR(3),o[0],0,0,0), C1,8); \
    GAPB(o[1]=__builtin_amdgcn_mfma_f32_32x32x16_bf16(PAF(3),VFR(7),o[1],0,0,0), C1,12); \
    }while(0)
  int t=1;
  #undef CMASK
  #define CMASK(P0,P1,t) do{}while(0)
  for(;t+5<NT;t+=2){
    STEP(pB0,pB1,pA0,pA1,t,true,true,true);     WAIT_BAR(2); RESC(); ROT();
    STEP(pA0,pA1,pB0,pB1,t+1,true,true,true);   WAIT_BAR(2); RESC(); ROT();
  }
  #undef CMASK
  #define CMASK(P0,P1,t) do{int jb_=(t)-(NT-4); if(jb_>=0)cmask(P0,P1,jb_,qrel,hi);}while(0)
  #define ENDW(tt) do{ if((tt)+3<NT){WAIT_BAR(2);} else if((tt)+2<NT){WAIT_BAR(1);} else {WAIT_BAR(0);} }while(0)
  for(;t+1<NT;t+=2){
    STEP(pB0,pB1,pA0,pA1,t,(t+3<NT),(t+1<NT),(t+1<NT));       ENDW(t);   RESC(); ROT();
    STEP(pA0,pA1,pB0,pB1,t+1,(t+4<NT),(t+2<NT),(t+2<NT));     ENDW(t+1); RESC(); ROT();
  }
  STEP(pB0,pB1,pA0,pA1,NT-1,false,false,false); RESC();
  { float sacc=pB0[0]+pB0[1]; _Pragma("unroll") for(int r=2;r<16;++r)sacc+=pB0[r]; _Pragma("unroll") for(int r=0;r<16;++r)sacc+=pB1[r]; l_reg+=sacc;
    pw0=(u32x4){PKW(pB0,0),PKW(pB0,2),PKW(pB0,4),PKW(pB0,6)};pw1=(u32x4){PKW(pB0,8),PKW(pB0,10),PKW(pB0,12),PKW(pB0,14)};pw2=(u32x4){PKW(pB1,0),PKW(pB1,2),PKW(pB1,4),PKW(pB1,6)};pw3=(u32x4){PKW(pB1,8),PKW(pB1,10),PKW(pB1,12),PKW(pB1,14)};
    SBAR(); pv(o,vb0+sl_cur,PAF(0),PAF(1),PAF(2),PAF(3)); }
  #undef PKW
  #undef PAF
  #undef VFR
  #undef PIN
  #undef MX3
  #undef GAPA
  #undef GAPB
  #undef EX
  #undef VRD
  #undef KRD
  #undef STEP
  #undef ENDW
  {auto rr=__builtin_amdgcn_permlane32_swap(__float_as_uint(l_reg),__float_as_uint(l_reg),false,false);l_reg=__uint_as_float(rr[0])+__uint_as_float(rr[1]);}
  if(hi==0)wsf[32+r32]=l_reg;asm volatile("s_waitcnt lgkmcnt(0)":::"memory");
  float rli[16];
  #pragma unroll
  for(int r=0;r<16;++r)rli[r]=__builtin_amdgcn_rcpf(wsf[32+crow(r,hi)]);
  bf16*Ow=O+(rowbase+q0+wid*QBLK)*DM+h*D;
  { bf16*stg=(bf16*)(shm+LDS_OST)+wid*2048;
    #pragma unroll
    for(int r=0;r<16;++r){const int orow=crow(r,hi);
      #pragma unroll
      for(int d0=0;d0<2;++d0)stg[orow*64+d0*32+r32]=__float2bfloat16(o[d0][r]*rli[r]);}
    asm volatile("s_waitcnt lgkmcnt(0)":::"memory");
    #pragma unroll
    for(int i=0;i<4;++i){const int row=i*8+(lane>>3),ch=lane&7; const u32x4 v=*(const u32x4*)(stg+row*64+ch*8); ATTN_STORE16(Ow+(long)row*DM+ch*8,v);} }
  asm volatile("s_waitcnt lgkmcnt(0)\n\ts_barrier":::"memory");
  #undef DMA_K
  #undef DMA_V
  #undef CMASK
  #undef START
  #undef RESC
  #undef ROT
  #undef BIASFILL
}
constexpr int ATTN_LDS_BYTES=LDS_BYTES;
#undef SBAR
#undef WAIT_BAR
}

constexpr size_t MiB = 1u << 20;
constexpr size_t WS_CTL = 0, CTL_BYTES = 1 * MiB;
constexpr int CW_QCTR = 0;
constexpr int CW_CNT = 1024;
constexpr int CW_KMEAN = 4096;
constexpr size_t WS_W = 1 * MiB;
constexpr size_t W_IN = 0, W_G = W_IN + (size_t)NQKV * 1024, W_PA = W_G + (size_t)NG * 1024, W_PB = W_PA + 1024 * 384, W_PC = W_PB + 1024 * 256,
                 W_O = W_PC + 1024 * 384, W_GU = W_O + 1024 * 1024, W_D = W_GU + (size_t)2 * DFF * 1024, W_LAYER = W_D + (size_t)1024 * DFF;
static_assert(WS_W + 2 * W_LAYER * 2 <= 69 * MiB, "weights");
constexpr size_t WS_ROPE = 69 * MiB;
constexpr size_t WS_LF = 70 * MiB;
constexpr size_t WS_CUM = 71 * MiB;
constexpr size_t WS_LSEB = 72 * MiB;
constexpr size_t WS_XB = 76 * MiB;
constexpr size_t WS_QA = 140 * MiB, WS_KA = 164 * MiB, WS_VA = 188 * MiB, WS_QB = 212 * MiB, WS_KB = 260 * MiB, WS_VB = 276 * MiB,
                 WS_QC = 292 * MiB, WS_KC = 316 * MiB, WS_VC = 340 * MiB;
constexpr size_t WS_H = 140 * MiB;
constexpr size_t WS_PO = 364 * MiB;
constexpr size_t WS_PLSE = 460 * MiB;
constexpr size_t WS_LIST = 463 * MiB;
constexpr size_t WS_GS = 364 * MiB;
constexpr size_t WS_MG = 428 * MiB;
constexpr size_t WS_END = 492 * MiB;
constexpr int LIST_PER_BH = 256 * 2016;
__device__ __forceinline__ int list_off(int bh, int n) { return bh * LIST_PER_BH + 256 * (63 * n - (n * (n - 1)) / 2); }

constexpr int LDS_QW = 150 * 1024;
constexpr int LDS_BYTES = 152 * 1024;
static_assert(attn_body::ATTN_LDS_BYTES <= LDS_QW && pg8::STAGE_BYTES <= LDS_QW, "lds");

__constant__ double ROPE_FR[8] = {0.15915494309189535, 0.03086376340470123, 0.005985185712713705, 0.0011606636412400608,
                                  0.00022507907903927653, 4.364795279280289e-05, 8.464330808241401e-06, 1.6414262627950345e-06};

struct Args { const float* in[16]; float* out; unsigned char* ws; };
typedef const __attribute__((address_space(4))) Args* CArgs;

__device__ __forceinline__ float wave_sum(float v) {
#pragma unroll
    for (int o = 1; o < 64; o <<= 1) v += __shfl_xor(v, o);
    return v;
}
__device__ __forceinline__ unsigned f2bf(float f) { unsigned u = __builtin_bit_cast(unsigned, f); return (u + 0x7fffu + ((u >> 16) & 1u)) >> 16; }
__device__ __forceinline__ unsigned pk2(float lo, float hi) { return f2bf(lo) | (f2bf(hi) << 16); }

__device__ __forceinline__ void transpose_item(const float* Wsrc, int ldw, bf16_t* dst, int ldk, LAS float* scr, int lane) {
#pragma unroll 8
    for (int i = 0; i < 32; ++i) { const int kk = 2 * i + (lane >> 5); scr[kk * 33 + (lane & 31)] = Wsrc[(size_t)kk * ldw + (lane & 31)]; }
    asm volatile("s_waitcnt lgkmcnt(0)" ::: "memory");
    const int c = lane & 7;
#pragma unroll
    for (int j = 0; j < 4; ++j) { const int n = (lane >> 3) + 8 * j; const LAS float* s = scr + (8 * c) * 33 + n;
        u32x4 o; o.x = pk2(s[0 * 33], s[1 * 33]); o.y = pk2(s[2 * 33], s[3 * 33]); o.z = pk2(s[4 * 33], s[5 * 33]); o.w = pk2(s[6 * 33], s[7 * 33]);
        *(u32x4*)(dst + (size_t)(n) * ldk + 8 * c) = o; }
    asm volatile("s_waitcnt lgkmcnt(0)" ::: "memory");
}
constexpr int IT_IN = 16 * 112, IT_G = 16 * 96, IT_PA = 6 * 32, IT_PB = 4 * 32, IT_PC = 6 * 32, IT_O = 16 * 32, IT_GU = 16 * 176, IT_D = 44 * 32;
constexpr int IT_LAYER = IT_IN + IT_G + IT_PA + IT_PB + IT_PC + IT_O + IT_GU + IT_D;
__device__ __forceinline__ void prologue_item(CArgs a, int it, LAS float* scr, int lane) {
    const int l = it / IT_LAYER; int r = it % IT_LAYER;
    bf16_t* WL = (bf16_t*)(a->ws + WS_W) + (size_t)l * W_LAYER;
    if (r < IT_IN) { const int kb = r / 112, nb = r % 112, k0 = 64 * kb, n0 = 32 * nb, c0 = n0 < 1152 ? n0 : n0 + 6;
        transpose_item(a->in[3] + (size_t)l * 1024 * DIN + (size_t)k0 * DIN + c0, DIN, WL + W_IN + (size_t)n0 * 1024 + k0, 1024, scr, lane); return; } r -= IT_IN;
    if (r < IT_G) { const int kb = r / 96, nb = r % 96, k0 = 64 * kb, n0 = 32 * nb, c0 = 3590 + n0;
        transpose_item(a->in[3] + (size_t)l * 1024 * DIN + (size_t)k0 * DIN + c0, DIN, WL + W_G + (size_t)n0 * 1024 + k0, 1024, scr, lane); return; } r -= IT_G;
    if (r < IT_PA) { const int kb = r / 32, nb = r % 32, k0 = 64 * kb, n0 = 32 * nb;
        transpose_item(a->in[5] + (size_t)l * 384 * 1024 + (size_t)k0 * 1024 + n0, 1024, WL + W_PA + (size_t)n0 * 384 + k0, 384, scr, lane); return; } r -= IT_PA;
    if (r < IT_PB) { const int kb = r / 32, nb = r % 32, k0 = 64 * kb, n0 = 32 * nb;
        transpose_item(a->in[6] + (size_t)l * 256 * 1024 + (size_t)k0 * 1024 + n0, 1024, WL + W_PB + (size_t)n0 * 256 + k0, 256, scr, lane); return; } r -= IT_PB;
    if (r < IT_PC) { const int kb = r / 32, nb = r % 32, k0 = 64 * kb, n0 = 32 * nb;
        transpose_item(a->in[7] + (size_t)l * 384 * 1024 + (size_t)k0 * 1024 + n0, 1024, WL + W_PC + (size_t)n0 * 384 + k0, 384, scr, lane); return; } r -= IT_PC;
    if (r < IT_O) { const int kb = r / 32, nb = r % 32, k0 = 64 * kb, n0 = 32 * nb;
        transpose_item(a->in[8] + (size_t)l * 1024 * 1024 + (size_t)k0 * 1024 + n0, 1024, WL + W_O + (size_t)n0 * 1024 + k0, 1024, scr, lane); return; } r -= IT_O;
    if (r < IT_GU) { const int kb = r / 176, nb = r % 176, k0 = 64 * kb, n0 = 32 * nb, pn = n0 >> 8, w = n0 & 255;
        const float* src = (w < 128) ? (a->in[11] + (size_t)l * 1024 * DFF + (size_t)k0 * DFF + 128 * pn + w) : (a->in[12] + (size_t)l * 1024 * DFF + (size_t)k0 * DFF + 128 * pn + (w - 128));
        transpose_item(src, DFF, WL + W_GU + (size_t)n0 * 1024 + k0, 1024, scr, lane); return; } r -= IT_GU;
    { const int kb = r / 32, nb = r % 32, k0 = 64 * kb, n0 = 32 * nb;
        transpose_item(a->in[13] + (size_t)l * DFF * 1024 + (size_t)k0 * 1024 + n0, 1024, WL + W_D + (size_t)n0 * DFF + k0, DFF, scr, lane); }
}

__device__ __forceinline__ void ln_phase(const float* src, const float* gam, const float* bet, float* XF, bf16_t* XB,
                                         const float* wfa, const float* bfl, float* LF, LAS unsigned char* lds, int tid, int lane, int wave) {
    asm volatile("" : "+v"(tid), "+v"(lane));
    LAS float* wl = (LAS float*)lds;
    if (wfa) { for (int i = tid; i < 6144; i += NWAVES * 64) { const int h = i % 6, k = i / 6; wl[h * 1024 + k] = wfa[(size_t)k * DIN + 1152 + h]; } }
    __syncthreads();
    f32x4 g4[4], b4[4];
#pragma unroll
    for (int j = 0; j < 4; ++j) { g4[j] = *(const f32x4*)(gam + 4 * lane + 256 * j); b4[j] = *(const f32x4*)(bet + 4 * lane + 256 * j); }
    for (int row = blockIdx.x * NWAVES + wave; row < T; row += gridDim.x * NWAVES) {
        const f32x4* xr = (const f32x4*)(src + (size_t)row * DM) + lane;
        f32x4 v[4]; float s = 0.f;
#pragma unroll
        for (int j = 0; j < 4; ++j) { v[j] = xr[64 * j]; s += (v[j].x + v[j].y) + (v[j].z + v[j].w); }
        const float mean = wave_sum(s) * (1.f / DM); float s2 = 0.f;
#pragma unroll
        for (int j = 0; j < 4; ++j) { v[j] = v[j] - mean; s2 += (v[j].x * v[j].x + v[j].y * v[j].y) + (v[j].z * v[j].z + v[j].w * v[j].w); }
        const float rstd = 1.f / sqrtf(wave_sum(s2) * (1.f / DM) + LN_EPS);
        f32x4* of = (f32x4*)(XF + (size_t)row * DM) + lane; u32x2* ob = (u32x2*)(XB + (size_t)row * DM) + lane;
#pragma unroll
        for (int j = 0; j < 4; ++j) { v[j] = v[j] * rstd * g4[j] + b4[j]; of[64 * j] = v[j]; u32x2 w; w.x = cvt_pk_bf16(v[j].x, v[j].y); w.y = cvt_pk_bf16(v[j].z, v[j].w); ob[64 * j] = w; }
        if (wfa) {
            float d[6];
#pragma unroll
            for (int h = 0; h < 6; ++h) { float acc = 0.f;
#pragma unroll
                for (int j = 0; j < 4; ++j) { const f32x4 w = *(const LAS f32x4*)(wl + h * 1024 + 4 * lane + 256 * j); acc += (v[j].x * w.x + v[j].y * w.y) + (v[j].z * w.z + v[j].w * w.w); }
                d[h] = wave_sum(acc); }
            if (lane < 6) { float z = d[0];
#pragma unroll
                for (int h = 1; h < 6; ++h) z = (lane == h) ? d[h] : z;
                z += bfl[lane];
                const float ls = fminf(z, 0.f) - log1pf(expf(-fabsf(z)));
                const int b = row / SEQ, sidx = row % SEQ; LF[(size_t)(b * 6 + lane) * SEQ + sidx] = ls; }
        }
    }
    __syncthreads();
}

__device__ __forceinline__ void scan_bh(const float* lf, float* cum, LAS unsigned char* lds, int tid, int lane, int wave) {
    asm volatile("" : "+v"(tid), "+v"(lane));
    LAS float* ws = (LAS float*)lds;
    f32x4 v[8]; const f32x4* p = (const f32x4*)(lf + tid * 32);
#pragma unroll
    for (int j = 0; j < 8; ++j) v[j] = p[j];
    float run = 0.f;
#pragma unroll
    for (int j = 0; j < 8; ++j) { run += v[j].x; v[j].x = run; run += v[j].y; v[j].y = run; run += v[j].z; v[j].z = run; run += v[j].w; v[j].w = run; }
    float inc = run;
#pragma unroll
    for (int o = 1; o < 64; o <<= 1) { const float t = __shfl_up(inc, o); if (lane >= o) inc += t; }
    if (lane == 63) ws[wave] = inc;
    __syncthreads();
    float base = inc - run;
    for (int w = 0; w < wave; ++w) base += ws[w];
    f32x4* q = (f32x4*)(cum + tid * 32);
#pragma unroll
    for (int j = 0; j < 8; ++j) q[j] = v[j] + base;
    __syncthreads();
}

__device__ __forceinline__ float sigmoidf_(float x) { return __builtin_amdgcn_rcpf(1.f + __builtin_amdgcn_exp2f(-x * LOG2E)); }

struct EpiInproj {
    static constexpr bool PERM = true;
    unsigned char* ws; const f32x2* rope; int* kmean;
    __device__ __forceinline__ void operator()(const f32x4 (&acc)[2][2][4][2], const pg8::Unit& u, int wr, int wc, int fr, int fq) const {
        const int row0 = u.pm * 256 + wr * 64 + fr;
#pragma unroll
        for (int bj = 0; bj < 2; ++bj) {
            const int cb = 2 * u.pn + bj;
            size_t base; int pitch, c0; bool rope_on = false, km = false; float sc = 1.f;
            if (cb < 3) { base = WS_QA; pitch = 384; c0 = cb * 128; sc = C2; }
            else if (cb < 6) { base = WS_KA; pitch = 384; c0 = (cb - 3) * 128; }
            else if (cb < 9) { base = WS_VA; pitch = 384; c0 = (cb - 6) * 128; }
            else if (cb < 15) { base = WS_QB; pitch = 768; c0 = (cb - 9) * 128; rope_on = true; sc = C2; }
            else if (cb < 17) { base = WS_KB; pitch = 256; c0 = (cb - 15) * 128; rope_on = true; }
            else if (cb < 19) { base = WS_VB; pitch = 256; c0 = (cb - 17) * 128; }
            else if (cb < 22) { base = WS_QC; pitch = 384; c0 = (cb - 19) * 128; rope_on = true; sc = C2; }
            else if (cb < 25) { base = WS_KC; pitch = 384; c0 = (cb - 22) * 128; rope_on = true; km = true; }
            else { base = WS_VC; pitch = 384; c0 = (cb - 25) * 128; }
            bf16_t* dst = (bf16_t*)(ws + base);
            const int colw = c0 + wc * 32 + 8 * fq;
            const bool rl = rope_on && ((wc & 1) == 0) && (fq < 2);
            float ks[8];
#pragma unroll
            for (int i = 0; i < 8; ++i) ks[i] = 0.f;
#pragma unroll
            for (int ai = 0; ai < 2; ++ai)
#pragma unroll
                for (int m = 0; m < 4; ++m) {
                    const int row = row0 + ai * 128 + m * 16;
                    f32x4 v0 = acc[ai][bj][m][0], v1 = acc[ai][bj][m][1];
                    if (rope_on) {
                        float own[8] = {v0.x, v0.y, v0.z, v0.w, v1.x, v1.y, v1.z, v1.w}, oth[8];
#pragma unroll
                        for (int i = 0; i < 8; ++i) oth[i] = __shfl_xor(own[i], 16);
                        if (rl) {
                            const f32x2* rp = rope + (size_t)(row % SEQ) * 8;
                            const float sg = (fq == 0) ? -1.f : 1.f;
#pragma unroll
                            for (int i = 0; i < 8; ++i) { const f32x2 cs = rp[i]; own[i] = own[i] * cs.x + sg * oth[i] * cs.y; }
                            v0 = (f32x4){own[0], own[1], own[2], own[3]}; v1 = (f32x4){own[4], own[5], own[6], own[7]};
                        }
                    }
                    if (km) { ks[0] += v0.x; ks[1] += v0.y; ks[2] += v0.z; ks[3] += v0.w; ks[4] += v1.x; ks[5] += v1.y; ks[6] += v1.z; ks[7] += v1.w; }
                    v0 = v0 * sc; v1 = v1 * sc;
                    u32x4 w; w.x = cvt_pk_bf16(v0.x, v0.y); w.y = cvt_pk_bf16(v0.z, v0.w); w.z = cvt_pk_bf16(v1.x, v1.y); w.w = cvt_pk_bf16(v1.z, v1.w);
                    *(u32x4*)(dst + (size_t)row * pitch + colw) = w;
                }
            if (km) {
#pragma unroll
                for (int i = 0; i < 8; ++i) { float s = ks[i]; s += __shfl_xor(s, 1); s += __shfl_xor(s, 2); s += __shfl_xor(s, 4); s += __shfl_xor(s, 8); ks[i] = s; }
                if (fr == 0) { const int b = u.pm >> 6, blk = u.pm & 63;
#pragma unroll
                    for (int i = 0; i < 8; ++i) { const int col = colw + i; atomicAdd(kmean + ((size_t)((b * 6 + (col >> 6)) * 64 + blk)) * 64 + (col & 63), __float2int_rn(ks[i] * 262144.f)); } }
            }
        }
    }
};

struct EpiSwiglu {
    static constexpr bool PERM = true;
    bf16_t* H;
    __device__ __forceinline__ void operator()(const f32x4 (&acc)[2][2][4][2], const pg8::Unit& u, int wr, int wc, int fr, int fq) const {
        const int row0 = u.pm * 256 + wr * 64 + fr, col0 = u.pn * 128 + wc * 32 + 8 * fq;
#pragma unroll
        for (int ai = 0; ai < 2; ++ai)
#pragma unroll
            for (int m = 0; m < 4; ++m) {
                float h[8];
#pragma unroll
                for (int n = 0; n < 2; ++n)
#pragma unroll
                    for (int i = 0; i < 4; ++i) { const float g = acc[ai][0][m][n][i], up = acc[ai][1][m][n][i]; h[4 * n + i] = g * sigmoidf_(g) * up; }
                u32x4 w; w.x = cvt_pk_bf16(h[0], h[1]); w.y = cvt_pk_bf16(h[2], h[3]); w.z = cvt_pk_bf16(h[4], h[5]); w.w = cvt_pk_bf16(h[6], h[7]);
                *(u32x4*)(H + (size_t)(row0 + ai * 128 + m * 16) * DFF + col0) = w;
                asm volatile("" ::: "memory");
            }
    }
};

struct EpiResid {
    static constexpr bool PERM = true;
    float* X;
    __device__ __forceinline__ void operator()(const f32x4 (&acc)[2][2][4][2], const pg8::Unit& u, int wr, int wc, int fr, int fq) const {
        const int row0 = u.pm * 256 + wr * 64 + fr, col0 = u.pn * 256 + wc * 32 + 8 * fq;
#pragma unroll
        for (int ai = 0; ai < 2; ++ai)
#pragma unroll
            for (int m = 0; m < 4; ++m)
#pragma unroll
                for (int bj = 0; bj < 2; ++bj) {
                    float* p = X + (size_t)(row0 + ai * 128 + m * 16) * DM + col0 + bj * 128;
                    const f32x4 a = *(const f32x4*)p, b = *(const f32x4*)(p + 4);
                    *(f32x4*)p = a * DN_ALPHA + acc[ai][bj][m][0]; *(f32x4*)(p + 4) = b * DN_ALPHA + acc[ai][bj][m][1];
                    asm volatile("" ::: "memory");
                }
    }
};

struct EpiGate {
    static constexpr bool PERM = true;
    bf16_t* GS;
    __device__ __forceinline__ void operator()(const f32x4 (&acc)[2][2][4][2], const pg8::Unit& u, int wr, int wc, int fr, int fq) const {
        const int row0 = u.pm * 256 + wr * 64 + fr, col0 = u.pn * 256 + wc * 32 + 8 * fq;
#pragma unroll
        for (int ai = 0; ai < 2; ++ai)
#pragma unroll
            for (int m = 0; m < 4; ++m)
#pragma unroll
                for (int bj = 0; bj < 2; ++bj) {
                    const f32x4 a = acc[ai][bj][m][0], b = acc[ai][bj][m][1];
                    u32x4 w; w.x = cvt_pk_bf16(sigmoidf_(a.x), sigmoidf_(a.y)); w.y = cvt_pk_bf16(sigmoidf_(a.z), sigmoidf_(a.w));
                    w.z = cvt_pk_bf16(sigmoidf_(b.x), sigmoidf_(b.y)); w.w = cvt_pk_bf16(sigmoidf_(b.z), sigmoidf_(b.w));
                    *(u32x4*)(GS + (size_t)(row0 + ai * 128 + m * 16) * DM + col0 + bj * 128) = w;
                }
    }
};

template <int FIRST> struct EpiBranch {
    static constexpr bool PERM = true;
    const bf16_t* GS; bf16_t* MG;
    __device__ __forceinline__ void operator()(const f32x4 (&acc)[2][2][4][2], const pg8::Unit& u, int wr, int wc, int fr, int fq) const {
        const int row0 = u.pm * 256 + wr * 64 + fr, col0 = u.pn * 256 + wc * 32 + 8 * fq;
#pragma unroll
        for (int ai = 0; ai < 2; ++ai)
#pragma unroll
            for (int m = 0; m < 4; ++m)
#pragma unroll
                for (int bj = 0; bj < 2; ++bj) {
                    const size_t off = (size_t)(row0 + ai * 128 + m * 16) * DM + col0 + bj * 128;
                    const u32x4 gw = *(const u32x4*)(GS + off);
                    const f32x4 a = acc[ai][bj][m][0], b = acc[ai][bj][m][1];
                    float r[8] = {bflo(gw.x) * a.x, bfhi(gw.x) * a.y, bflo(gw.y) * a.z, bfhi(gw.y) * a.w, bflo(gw.z) * b.x, bfhi(gw.z) * b.y, bflo(gw.w) * b.z, bfhi(gw.w) * b.w};
                    if (!FIRST) { const u32x4 mw = *(const u32x4*)(MG + off);
                        r[0] += bflo(mw.x); r[1] += bfhi(mw.x); r[2] += bflo(mw.y); r[3] += bfhi(mw.y); r[4] += bflo(mw.z); r[5] += bfhi(mw.z); r[6] += bflo(mw.w); r[7] += bfhi(mw.w); }
                    u32x4 w; w.x = cvt_pk_bf16(r[0], r[1]); w.y = cvt_pk_bf16(r[2], r[3]); w.z = cvt_pk_bf16(r[4], r[5]); w.w = cvt_pk_bf16(r[6], r[7]);
                    *(u32x4*)(MG + off) = w;
                    asm volatile("" ::: "memory");
                }
    }
};

typedef short v4i16_t __attribute__((ext_vector_type(4)));
__device__ __forceinline__ int crow(int r, int hi) { return (r & 3) + 8 * (r >> 2) + 4 * hi; }
__device__ __forceinline__ float half_max(float m) { auto rr = __builtin_amdgcn_permlane32_swap(__float_as_uint(m), __float_as_uint(m), false, false); return fmaxf(__uint_as_float(rr[0]), __uint_as_float(rr[1])); }
__device__ __forceinline__ float half_sum(float m) { auto rr = __builtin_amdgcn_permlane32_swap(__float_as_uint(m), __float_as_uint(m), false, false); return __uint_as_float(rr[0]) + __uint_as_float(rr[1]); }

__device__ __forceinline__ void small_attn(const bf16_t* qrow, int ntiles, const bf16_t* Kb, const bf16_t* Vb, int pitch,
                                           int kc0, int kstride, int koff, int qc, int span, LAS unsigned char* vscr, int lane,
                                           f32x16 (&o)[2], float& lse2, const float* cumb = nullptr) {
    asm volatile("" : "+v"(lane));
    const int r32 = lane & 31, hi = lane >> 5;
    bf16x8 qr[4];
#pragma unroll
    for (int d0 = 0; d0 < 4; ++d0) qr[d0] = *(const bf16x8*)(qrow + d0 * 16 + hi * 8);
    o[0] = f32x16{}; o[1] = f32x16{};
    float m = -1e30f, l = 0.f;
    const int vr = lane >> 1, vh = lane & 1;
    LAS unsigned char* vw = vscr + vr * 144 + vh * 64;
    const LAS unsigned char* vt = vscr + (4 * hi + ((lane & 15) >> 2)) * 144 + (16 * ((lane >> 4) & 1) + 4 * (lane & 3)) * 2;
#define SA_LOAD(KF, VV, tt) do { const int t_ = (tt) < ntiles ? (tt) : ntiles - 1; \
        const int kk_ = kc0 + 32 * t_ + r32; const int tokk_ = (kk_ < 0 ? 0 : kk_) * kstride + koff; const bf16_t* kp_ = Kb + (size_t)tokk_ * pitch + 8 * hi; \
        const int kv_ = kc0 + 32 * t_ + vr; const int tokv_ = (kv_ < 0 ? 0 : kv_) * kstride + koff; const bf16_t* vp_ = Vb + (size_t)tokv_ * pitch + 32 * vh; \
        _Pragma("unroll") for (int i_ = 0; i_ < 4; ++i_) { KF[i_] = *(const bf16x8*)(kp_ + 16 * i_); VV[i_] = *(const bf16x8*)(vp_ + 8 * i_); } \
        __builtin_amdgcn_sched_barrier(0); } while (0)
#define SA_COMPUTE(KF, VV, tt) do { \
        _Pragma("unroll") for (int i_ = 0; i_ < 4; ++i_) *(LAS bf16x8*)(vw + 16 * i_) = VV[i_]; \
        f32x16 p = f32x16{}; \
        _Pragma("unroll") for (int d0 = 0; d0 < 4; ++d0) p = __builtin_amdgcn_mfma_f32_32x32x16_bf16(KF[d0], qr[d0], p, 0, 0, 0); \
        const int kcb = kc0 + 32 * (tt); float rm = -INFINITY; \
        _Pragma("unroll") for (int r = 0; r < 16; ++r) { const int kc = kcb + crow(r, hi); const bool ok = (kc >= 0) && (kc <= qc) && (qc - kc <= span); \
            if (cumb) p[r] -= cumb[kc < 0 ? 0 : kc] * LOG2E; \
            p[r] = ok ? p[r] : -INFINITY; rm = fmaxf(rm, p[r]); } \
        rm = half_max(rm); \
        const float mn = fmaxf(m, rm); const float f = __builtin_amdgcn_exp2f(m - mn); m = mn; \
        float ls = 0.f; \
        _Pragma("unroll") for (int r = 0; r < 16; ++r) { p[r] = __builtin_amdgcn_exp2f(p[r] - mn); ls += p[r]; } \
        l = l * f + ls; \
        _Pragma("unroll") for (int r = 0; r < 16; ++r) { o[0][r] *= f; o[1][r] *= f; } \
        u32x4 pw0, pw1; \
        pw0.x = cvt_pk_bf16(p[0], p[1]); pw0.y = cvt_pk_bf16(p[2], p[3]); pw0.z = cvt_pk_bf16(p[4], p[5]); pw0.w = cvt_pk_bf16(p[6], p[7]); \
        pw1.x = cvt_pk_bf16(p[8], p[9]); pw1.y = cvt_pk_bf16(p[10], p[11]); pw1.z = cvt_pk_bf16(p[12], p[13]); pw1.w = cvt_pk_bf16(p[14], p[15]); \
        const bf16x8 pb0 = __builtin_bit_cast(bf16x8, pw0), pb1 = __builtin_bit_cast(bf16x8, pw1); \
        _Pragma("unroll") for (int d0 = 0; d0 < 2; ++d0) { \
            _Pragma("unroll") for (int s_ = 0; s_ < 2; ++s_) { \
                const v4i16_t lo = __builtin_amdgcn_ds_read_tr16_b64_v4i16((LAS v4i16_t*)(vt + (16 * s_) * 144 + d0 * 64)); \
                const v4i16_t hh = __builtin_amdgcn_ds_read_tr16_b64_v4i16((LAS v4i16_t*)(vt + (16 * s_ + 8) * 144 + d0 * 64)); \
                const bf16x8 vf = (bf16x8){lo[0], lo[1], lo[2], lo[3], hh[0], hh[1], hh[2], hh[3]}; \
                o[d0] = __builtin_amdgcn_mfma_f32_32x32x16_bf16(vf, s_ == 0 ? pb0 : pb1, o[d0], 0, 0, 0); } } \
    } while (0)
    bf16x8 kA[4], vA[4], kB[4], vB[4], kC[4], vC[4];
    SA_LOAD(kA, vA, 0); SA_LOAD(kB, vB, 1);
    for (int t = 0; t < ntiles; t += 3) {
        SA_LOAD(kC, vC, t + 2); SA_COMPUTE(kA, vA, t);
        if (t + 1 >= ntiles) break;
        SA_LOAD(kA, vA, t + 3); SA_COMPUTE(kB, vB, t + 1);
        if (t + 2 >= ntiles) break;
        SA_LOAD(kB, vB, t + 4); SA_COMPUTE(kC, vC, t + 2);
    }
#undef SA_LOAD
#undef SA_COMPUTE
    l = half_sum(l);
    const float rl = 1.f / l;
#pragma unroll
    for (int r = 0; r < 16; ++r) { o[0][r] *= rl; o[1][r] *= rl; }
    lse2 = m + __builtin_amdgcn_logf(l);
}
__device__ __forceinline__ void small_store(bf16_t* orow, const f32x16 (&o)[2], int hi) {
#pragma unroll
    for (int d0 = 0; d0 < 2; ++d0)
#pragma unroll
        for (int g = 0; g < 4; ++g) { u32x2 w; w.x = cvt_pk_bf16(o[d0][4 * g], o[d0][4 * g + 1]); w.y = cvt_pk_bf16(o[d0][4 * g + 2], o[d0][4 * g + 3]);
            *(u32x2*)(orow + 32 * d0 + 8 * g + 4 * hi) = w; }
}

__device__ __forceinline__ void gating_phase(CArgs a, int layer, LAS unsigned char* lds, int tid) {
    asm volatile("" : "+v"(tid));
    unsigned* ctl = (unsigned*)(a->ws + WS_CTL);
    const int* kmean = (const int*)(ctl + CW_KMEAN + 49152 * layer);
    unsigned* cnt = ctl + CW_CNT + 1024 * layer;
    unsigned* list = (unsigned*)(a->ws + WS_LIST);
    const bf16_t* QC = (const bf16_t*)(a->ws + WS_QC);
    const int half = tid >> 8, ht = tid & 255;
    LAS float* km = (LAS float*)(lds + half * 16384);
    for (int u0 = 0; u0 < 768; u0 += 2 * (int)gridDim.x) {
        const int u = u0 + 2 * (int)blockIdx.x + half; const bool active = u < 768;
        const int bh = active ? (u >> 6) : 0, ob = active ? (u & 63) : 0;
        for (int i = ht; i < ob * 64; i += 256) km[i] = (float)kmean[bh * 4096 + i] * (1.f / 262144.f);
        __syncthreads();
        if (active && ob > 0) {
            const int b = bh / 6, h = bh % 6, t = ob * 256 + ht;
            const u32x4* qp = (const u32x4*)(QC + ((size_t)(b * SEQ + t)) * 384 + h * 64);
            float q[64];
#pragma unroll
            for (int i = 0; i < 8; ++i) { const u32x4 w = qp[i]; q[8 * i] = bflo(w.x); q[8 * i + 1] = bfhi(w.x); q[8 * i + 2] = bflo(w.y); q[8 * i + 3] = bfhi(w.y);
                q[8 * i + 4] = bflo(w.z); q[8 * i + 5] = bfhi(w.z); q[8 * i + 6] = bflo(w.w); q[8 * i + 7] = bfhi(w.w); }
            float v0 = -INFINITY, v1 = -INFINITY, v2 = -INFINITY; int i0 = 0, i1 = 0, i2 = 0;
            for (int n = 0; n < ob; ++n) {
                float d0 = 0.f, d1 = 0.f;
#pragma unroll
                for (int j = 0; j < 16; j += 2) { const f32x4 ka = *(const LAS f32x4*)(km + n * 64 + 4 * j), kb = *(const LAS f32x4*)(km + n * 64 + 4 * j + 4);
                    d0 += (q[4 * j] * ka.x + q[4 * j + 1] * ka.y) + (q[4 * j + 2] * ka.z + q[4 * j + 3] * ka.w);
                    d1 += (q[4 * j + 4] * kb.x + q[4 * j + 5] * kb.y) + (q[4 * j + 6] * kb.z + q[4 * j + 7] * kb.w); }
                const float dot = d0 + d1;
                if (dot > v2) {
                    if (dot > v1) { v2 = v1; i2 = i1; if (dot > v0) { v1 = v0; i1 = i0; v0 = dot; i0 = n; } else { v1 = dot; i1 = n; } }
                    else { v2 = dot; i2 = n; }
                }
            }
            const int nsel = ob < 3 ? ob : 3;
#pragma unroll
            for (int j = 0; j < 3; ++j) if (j < nsel) { const int n = (j == 0) ? i0 : (j == 1) ? i1 : i2;
                const unsigned pos = atomicAdd(cnt + bh * 64 + n, 1u);
                list[list_off(bh, n) + pos] = ((unsigned)t << 2) | (unsigned)j; }
        }
        __syncthreads();
    }
}

constexpr int NU_FOX = 768, NU_SEL = 768, NU_OWN = 384, NU_DIL = 1536, NU_TOTAL = NU_FOX + NU_SEL + NU_OWN + NU_DIL;
__device__ __forceinline__ void attention_phase(CArgs a, int layer, LAS unsigned char* lds, char* lds_gen, int tid, int lane, int wave) {
    asm volatile("" : "+v"(tid), "+v"(lane));
    unsigned* ctl = (unsigned*)(a->ws + WS_CTL);
    unsigned* qctr = ctl + CW_QCTR + 64 * layer;
    const unsigned* cnt = ctl + CW_CNT + 1024 * layer;
    const unsigned* list = (const unsigned*)(a->ws + WS_LIST);
    volatile LAS unsigned* qw = (volatile LAS unsigned*)(lds + LDS_QW);
    LAS unsigned char* vscr = lds + wave * 4608;
    bf16_t* QCp = (bf16_t*)(a->ws + WS_QC); const bf16_t* KCp = (const bf16_t*)(a->ws + WS_KC); const bf16_t* VCp = (const bf16_t*)(a->ws + WS_VC);
    bf16_t* PO = (bf16_t*)(a->ws + WS_PO); float* PLSE = (float*)(a->ws + WS_PLSE);
    for (;;) {
        __syncthreads();
        if (tid == 0) *qw = atomicAdd(qctr, 1u);
        __syncthreads();
        const int u = (int)*qw;
        if (u >= NU_TOTAL) break;
        int lane_ = lane; asm volatile("" : "+v"(lane_)); const int r32 = lane_ & 31, hi = lane_ >> 5;
        if (u < NU_FOX) {
            const int qb = 63 - u / 12, bh = u % 12, b = bh / 6, h = bh % 6;
#ifdef FOX_SIMPLE
            {   const int t = 256 * qb + 32 * wave + r32; const size_t tok = (size_t)(b * SEQ + t);
                bf16_t* qrow = (bf16_t*)(a->ws + WS_QA) + tok * 384 + h * 64;
                const bf16_t* Kb = (const bf16_t*)(a->ws + WS_KA) + (size_t)(b * SEQ) * 384 + h * 64; const bf16_t* Vb = (const bf16_t*)(a->ws + WS_VA) + (size_t)(b * SEQ) * 384 + h * 64;
                f32x16 o[2]; float lse2;
                small_attn(qrow, 8 * qb + wave + 1, Kb, Vb, 384, 0, 1, 0, t, 1 << 29, vscr, lane, o, lse2, (const float*)(a->ws + WS_CUM) + (size_t)bh * SEQ);
                small_store(qrow, o, hi); }
#elif !defined(NO_FOX)
            attn_body::attn_unit<8>(b, h, qb, (const attn_body::bf16*)(a->ws + WS_QA), (const attn_body::bf16*)(a->ws + WS_KA), (const attn_body::bf16*)(a->ws + WS_VA),
                                    (attn_body::bf16*)(a->ws + WS_QA), (const float*)(a->ws + WS_CUM) + (size_t)bh * SEQ, lds_gen);
#endif
        } else if (u < NU_FOX + NU_SEL) {
            const int v = u - NU_FOX, n = v / 12, bh = v % 12, b = bh / 6, h = bh % 6;
            int cn = (int)cnt[bh * 64 + n]; const int cap = (63 - n) * 256; cn = cn < cap ? cn : cap;
            const unsigned* lp = list + list_off(bh, n);
            const bf16_t* Kb = KCp + (size_t)(b * SEQ) * 384 + h * 64; const bf16_t* Vb = VCp + (size_t)(b * SEQ) * 384 + h * 64;
            for (int c = wave; c * 32 < cn; c += NWAVES) {
                const int e = c * 32 + r32; const bool valid = e < cn;
                const unsigned ent = lp[valid ? e : 0];
                const int t = (int)(ent >> 2), slot = (int)(ent & 3);
                const size_t tok = (size_t)(b * SEQ + t);
                f32x16 o[2]; float lse2;
                small_attn(QCp + tok * 384 + h * 64, 8, Kb, Vb, 384, 0, 1, 256 * n, 1 << 28, 1 << 29, vscr, lane, o, lse2);
                if (valid) { small_store(PO + ((tok * 6 + h) * 4 + slot) * 64, o, hi); if (hi == 0) PLSE[(tok * 6 + h) * 4 + slot] = lse2; }
            }
        } else if (u < NU_FOX + NU_SEL + NU_OWN) {
            const int v = u - NU_FOX - NU_SEL, bh = v / 32, pr = v % 32, b = bh / 6, h = bh % 6;
            const bf16_t* Kb = KCp + (size_t)(b * SEQ) * 384 + h * 64; const bf16_t* Vb = VCp + (size_t)(b * SEQ) * 384 + h * 64;
            for (int s = 0; s < 2; ++s) {
                const int blk = 2 * pr + s, ch = s == 0 ? wave : 7 - wave;
                const int t = 256 * blk + 32 * ch + r32; const size_t tok = (size_t)(b * SEQ + t);
                f32x16 o[2]; float lse2;
                small_attn(QCp + tok * 384 + h * 64, ch + 1, Kb, Vb, 384, 0, 1, 256 * blk, 32 * ch + r32, 1 << 29, vscr, lane, o, lse2);
                small_store(PO + ((tok * 6 + h) * 4 + 3) * 64, o, hi); if (hi == 0) PLSE[(tok * 6 + h) * 4 + 3] = lse2;
            }
        } else {
            const int v = u - NU_FOX - NU_SEL - NU_OWN, wu = v * NWAVES + wave;
            const int c512 = wu & 511, rest = wu >> 9, kvh = rest & 3, g = (rest >> 2) % 3, b = rest / 12;
            const int dil = g == 0 ? 1 : (g == 1 ? 4 : 16), cpc = 512 / dil;
            const int res = c512 / cpc, cidx = c512 % cpc, qc0 = 32 * cidx, qc = qc0 + r32, tq = qc * dil + res;
            const size_t tok = (size_t)(b * SEQ + tq);
            bf16_t* qrow = (bf16_t*)(a->ws + WS_QB) + tok * 768 + (g * 4 + kvh) * 64;
            const bf16_t* Kb = (const bf16_t*)(a->ws + WS_KB) + (size_t)(b * SEQ) * 256 + kvh * 64; const bf16_t* Vb = (const bf16_t*)(a->ws + WS_VB) + (size_t)(b * SEQ) * 256 + kvh * 64;
            f32x16 o[2]; float lse2;
            small_attn(qrow, 5, Kb, Vb, 256, qc0 - 128, dil, res, qc, 128, vscr, lane, o, lse2);
            small_store(qrow, o, hi);
            if (hi == 0) ((float*)(a->ws + WS_LSEB))[((size_t)g * T + tok) * 4 + kvh] = lse2;
        }
    }
}

__device__ __forceinline__ void combine_phase(CArgs a, int tid) {
    asm volatile("" : "+v"(tid));
    const size_t gt = (size_t)blockIdx.x * (NWAVES * 64) + tid, gs = (size_t)gridDim.x * (NWAVES * 64);
    bf16_t* QBp = (bf16_t*)(a->ws + WS_QB); const float* LSEB = (const float*)(a->ws + WS_LSEB);
    for (size_t i = gt; i < (size_t)T * 32; i += gs) {
        const int ch = (int)(i & 7), kvh = (int)((i >> 3) & 3); const size_t tok = i >> 5;
        float l[3], w[3];
#pragma unroll
        for (int g = 0; g < 3; ++g) l[g] = LSEB[((size_t)g * T + tok) * 4 + kvh];
        const float mx = fmaxf(l[0], fmaxf(l[1], l[2]));
        float ws_ = 0.f;
#pragma unroll
        for (int g = 0; g < 3; ++g) { w[g] = __builtin_amdgcn_exp2f(l[g] - mx); ws_ += w[g]; }
        const float inv = 1.f / ws_;
        float y[8] = {0.f, 0.f, 0.f, 0.f, 0.f, 0.f, 0.f, 0.f};
#pragma unroll
        for (int g = 0; g < 3; ++g) { const u32x4 ow = *(const u32x4*)(QBp + tok * 768 + (g * 4 + kvh) * 64 + ch * 8); const float wg = w[g] * inv;
            y[0] += wg * bflo(ow.x); y[1] += wg * bfhi(ow.x); y[2] += wg * bflo(ow.y); y[3] += wg * bfhi(ow.y); y[4] += wg * bflo(ow.z); y[5] += wg * bfhi(ow.z); y[6] += wg * bflo(ow.w); y[7] += wg * bfhi(ow.w); }
        u32x4 r; r.x = cvt_pk_bf16(y[0], y[1]); r.y = cvt_pk_bf16(y[2], y[3]); r.z = cvt_pk_bf16(y[4], y[5]); r.w = cvt_pk_bf16(y[6], y[7]);
        *(u32x4*)(QBp + tok * 768 + kvh * 64 + ch * 8) = r;
    }
    bf16_t* QCp = (bf16_t*)(a->ws + WS_QC); const bf16_t* PO = (const bf16_t*)(a->ws + WS_PO); const float* PLSE = (const float*)(a->ws + WS_PLSE);
    for (size_t i = gt; i < (size_t)T * 48; i += gs) {
        const int ch = (int)(i & 7); const size_t th = i >> 3; const int h = (int)(th % 6); const size_t tok = th / 6;
        const int ob = (int)((tok % SEQ) >> 8), nsel = ob < 3 ? ob : 3;
        float l[4], w[4];
#pragma unroll
        for (int j = 0; j < 4; ++j) l[j] = (j == 3 || j < nsel) ? PLSE[th * 4 + j] : -INFINITY;
        const float mx = fmaxf(fmaxf(l[0], l[1]), fmaxf(l[2], l[3]));
        float ws_ = 0.f;
#pragma unroll
        for (int j = 0; j < 4; ++j) { w[j] = __builtin_amdgcn_exp2f(l[j] - mx); ws_ += w[j]; }
        const float inv = 1.f / ws_;
        float y[8] = {0.f, 0.f, 0.f, 0.f, 0.f, 0.f, 0.f, 0.f};
#pragma unroll
        for (int j = 0; j < 4; ++j) if (j == 3 || j < nsel) { const u32x4 ow = *(const u32x4*)(PO + (th * 4 + j) * 64 + ch * 8); const float wg = w[j] * inv;
            y[0] += wg * bflo(ow.x); y[1] += wg * bfhi(ow.x); y[2] += wg * bflo(ow.y); y[3] += wg * bfhi(ow.y); y[4] += wg * bflo(ow.z); y[5] += wg * bfhi(ow.z); y[6] += wg * bflo(ow.w); y[7] += wg * bfhi(ow.w); }
        u32x4 r; r.x = cvt_pk_bf16(y[0], y[1]); r.y = cvt_pk_bf16(y[2], y[3]); r.z = cvt_pk_bf16(y[4], y[5]); r.w = cvt_pk_bf16(y[6], y[7]);
        *(u32x4*)(QCp + tok * 384 + h * 64 + ch * 8) = r;
    }
}

#ifndef MIXER_ON
#define MIXER_ON 1
#endif
#define XB_TMO      128
#define XB_XCNT(j)  (256  + 64 * (j))
#define XB_XSUB(j)  (1280 + 64 * (j))
#define XB_XGEN(j)  (2304 + 64 * (j))
#define XB_TOP      3328
#define XB_TOPGEN   3392
#define XCD_BAR_WORDS 3456
#define XB_SPIN_CAP (1u << 18)

__device__ __forceinline__ unsigned xb_ld(unsigned* p)              { return __hip_atomic_load(p, __ATOMIC_RELAXED, __HIP_MEMORY_SCOPE_AGENT); }
__device__ __forceinline__ unsigned xb_add(unsigned* p, unsigned v) { return __hip_atomic_fetch_add(p, v, __ATOMIC_RELAXED, __HIP_MEMORY_SCOPE_AGENT); }
__device__ __forceinline__ unsigned xb_xcc_id() { return (unsigned)__builtin_amdgcn_s_getreg((3 << 11) | 20) & 0xFu; }
#define XB_SPIN(cond, bar) do { unsigned _sp = 0; while (cond) { __builtin_amdgcn_s_sleep(1); \
    if ((++_sp & 255u) == 0u) { if (xb_ld(&(bar)[XB_TMO])) break; if (_sp > XB_SPIN_CAP) { atomicAdd(&(bar)[XB_TMO], 1u); break; } } } } while (0)

struct XcdBarrier {
    unsigned* bar; unsigned x;
    volatile LAS unsigned* st;
};

__device__ __forceinline__ XcdBarrier xcd_barrier_post(unsigned* bar, volatile LAS unsigned* st) {
    XcdBarrier b; b.bar = bar; b.x = xb_xcc_id(); b.st = st;
    if (threadIdx.x == 0) (void)xb_add(&bar[XB_XCNT(b.x)], 1u);
    return b;
}
__device__ __forceinline__ void xcd_barrier_complete(unsigned* bar, unsigned x, unsigned& nloc, unsigned& nx) {
    const unsigned G = gridDim.x * gridDim.y * gridDim.z;
    unsigned sum, cnt, mine, sp = 0u;
    for (;;) {
        sum = 0u; cnt = 0u; mine = 0u;
#pragma unroll
        for (unsigned j = 0; j < 16; ++j) { const unsigned c = xb_ld(&bar[XB_XCNT(j)]); sum += c; cnt += (c > 0u) ? 1u : 0u; mine = (j == x) ? c : mine; }
        if (sum == G) break;
        __builtin_amdgcn_s_sleep(1);
        if ((++sp & 255u) == 0u) { if (xb_ld(&bar[XB_TMO])) break; if (sp > XB_SPIN_CAP) { atomicAdd(&bar[XB_TMO], 1u); break; } }
    }
    nloc = mine > 0u ? mine : 1u; nx = cnt > 0u ? cnt : 1u;
}

__device__ __forceinline__ void xcd_barrier(const XcdBarrier& b) {
    asm volatile("s_waitcnt vmcnt(0)" ::: "memory");
    __syncthreads();
    if (threadIdx.x == 0) {
        unsigned* bar = b.bar;
        __builtin_amdgcn_s_waitcnt(0);
        unsigned nloc = b.st[0], nx = b.st[1];
        if (nloc == 0u) { xcd_barrier_complete(bar, b.x, nloc, nx); b.st[0] = nloc; b.st[1] = nx; }
        const unsigned old = xb_add(&bar[XB_XSUB(b.x)], 1u);
        const unsigned gen = old / nloc;
        if (old + 1u == (gen + 1u) * nloc) {
            __builtin_amdgcn_fence(__ATOMIC_RELEASE, "agent");
            asm volatile("s_waitcnt vmcnt(0)" ::: "memory");
            const unsigned og = xb_add(&bar[XB_TOP], 1u);
            const unsigned tg = og / nx;
            if (og + 1u == (tg + 1u) * nx) xb_add(&bar[XB_TOPGEN], 1u);
            else XB_SPIN(xb_ld(&bar[XB_TOPGEN]) == tg, bar);
            __builtin_amdgcn_fence(__ATOMIC_ACQUIRE, "agent");
            xb_add(&bar[XB_XGEN(b.x)], 1u);
            asm volatile("s_waitcnt vmcnt(0)" ::: "memory");
        } else {
            XB_SPIN(xb_ld(&bar[XB_XGEN(b.x)]) == gen, bar);
            __builtin_amdgcn_fence(__ATOMIC_ACQUIRE, "agent");
            asm volatile("s_waitcnt vmcnt(0)" ::: "memory");
        }
    }
    __syncthreads();
}

constexpr int CW_BAR = 110016;
static_assert((CW_BAR + XCD_BAR_WORDS) * 4 <= (int)CTL_BYTES, "ctl");
#define GBX() int G = gridDim.x, bx = blockIdx.x; asm volatile("" : "+s"(G), "+s"(bx))
#define AP() ({ CArgs p_ = kp; asm volatile("" : "+s"(p_)); p_; }); GBX()
#define TIDS() int tid_ = threadIdx.x; asm volatile("" : "+v"(tid_)); const int tid = tid_, lane = tid & 63, wave = __builtin_amdgcn_readfirstlane(tid >> 6); (void)lane; (void)wave
#define XBP(a) ((bf16_t*)((a)->ws + WS_XB))
#define LFP(a) ((float*)((a)->ws + WS_LF))
#define WLP(a) ((const bf16_t*)((a)->ws + WS_W) + (size_t)layer * W_LAYER)
template <int layer> __device__ __forceinline__ void layer_body(const CArgs kp, LAS unsigned char* lds, unsigned char* lds_raw, const XcdBarrier& bar) {
#if MIXER_ON
        { const CArgs a = AP(); TIDS(); if (bx < 12) scan_bh(LFP(a) + (size_t)bx * SEQ, (float*)(a->ws + WS_CUM) + (size_t)bx * SEQ, lds, tid, lane, wave); }
#ifndef NO_INPROJ
        { const CArgs a = AP(); pg8::StaticOrder S; pg8::Gemm g{XBP(a), WLP(a) + W_IN, 1024, 1024, 1024}; S.init(T, NQKV, G, bx);
          EpiInproj E{a->ws, (const f32x2*)(a->ws + WS_ROPE), (int*)((unsigned*)(a->ws + WS_CTL) + CW_KMEAN + 49152 * layer)};
          pg8::gemm_phase<EpiInproj, true>(lds, g, S, E); }
#endif
        xcd_barrier(bar);
#ifndef NO_GATING
        { const CArgs a = AP(); TIDS(); gating_phase(a, layer, lds, tid); }
#endif
        xcd_barrier(bar);
        { const CArgs a = AP(); TIDS(); attention_phase(a, layer, lds, (char*)lds_raw, tid, lane, wave); }
        xcd_barrier(bar);
        { const CArgs a = AP(); TIDS(); combine_phase(a, tid); }
        xcd_barrier(bar);
        {
            pg8::StaticOrder S; { GBX(); S.init(T, 1024, G, bx); }
            { const CArgs a = AP(); pg8::Gemm g{XBP(a), WLP(a) + W_G, 1024, 1024, 1024}; EpiGate E{(bf16_t*)(a->ws + WS_GS)}; pg8::gemm_phase<EpiGate, true>(lds, g, S, E); }
            { const CArgs a = AP(); pg8::Gemm g{(const bf16_t*)(a->ws + WS_QA), WLP(a) + W_PA, 384, 384, 384}; EpiBranch<1> E{(const bf16_t*)(a->ws + WS_GS), (bf16_t*)(a->ws + WS_MG)}; pg8::gemm_phase<EpiBranch<1>, true>(lds, g, S, E); }
#ifndef ONLY_A
            { const CArgs a = AP(); pg8::Gemm g{XBP(a), WLP(a) + W_G + (size_t)1024 * 1024, 1024, 1024, 1024}; EpiGate E{(bf16_t*)(a->ws + WS_GS)}; pg8::gemm_phase<EpiGate, true>(lds, g, S, E); }
            { const CArgs a = AP(); pg8::Gemm g{(const bf16_t*)(a->ws + WS_QB), WLP(a) + W_PB, 768, 256, 256}; EpiBranch<0> E{(const bf16_t*)(a->ws + WS_GS), (bf16_t*)(a->ws + WS_MG)}; pg8::gemm_phase<EpiBranch<0>, true>(lds, g, S, E); }
            { const CArgs a = AP(); pg8::Gemm g{XBP(a), WLP(a) + W_G + (size_t)2048 * 1024, 1024, 1024, 1024}; EpiGate E{(bf16_t*)(a->ws + WS_GS)}; pg8::gemm_phase<EpiGate, true>(lds, g, S, E); }
            { const CArgs a = AP(); pg8::Gemm g{(const bf16_t*)(a->ws + WS_QC), WLP(a) + W_PC, 384, 384, 384}; EpiBranch<0> E{(const bf16_t*)(a->ws + WS_GS), (bf16_t*)(a->ws + WS_MG)}; pg8::gemm_phase<EpiBranch<0>, true>(lds, g, S, E); }
#endif
        }
        xcd_barrier(bar);
        { const CArgs a = AP(); pg8::StaticOrder S; pg8::Gemm g{(const bf16_t*)(a->ws + WS_MG), WLP(a) + W_O, 1024, 1024, 1024}; S.init(T, 1024, G, bx); EpiResid E{a->out}; pg8::gemm_phase<EpiResid, true>(lds, g, S, E); }
        xcd_barrier(bar);
#else
        {
            const CArgs a = AP(); TIDS();
            for (size_t i = (size_t)bx * 512 + tid; i < (size_t)T * DM / 4; i += (size_t)G * 512) { f32x4* p = (f32x4*)a->out + i; *p = *p * DN_ALPHA; }
        }
        xcd_barrier(bar);
#endif
        { const CArgs a = AP(); TIDS(); ln_phase(a->out, a->in[9] + layer * DM, a->in[10] + layer * DM, a->out, XBP(a), nullptr, nullptr, nullptr, lds, tid, lane, wave); }
        xcd_barrier(bar);
#ifndef NO_P8
        { const CArgs a = AP(); pg8::StaticOrder S; pg8::Gemm g{XBP(a), WLP(a) + W_GU, 1024, 1024, 1024}; S.init(T, 2 * DFF, G, bx); EpiSwiglu E{(bf16_t*)(a->ws + WS_H)}; pg8::gemm_phase<EpiSwiglu, true>(lds, g, S, E); }
#endif
        xcd_barrier(bar);
#ifndef NO_P9
        { const CArgs a = AP(); pg8::StaticOrder S; pg8::Gemm g{(const bf16_t*)(a->ws + WS_H), WLP(a) + W_D, DFF, DFF, DFF}; S.init(T, 1024, G, bx); EpiResid E{a->out}; pg8::gemm_phase<EpiResid, true>(lds, g, S, E); }
#endif
        xcd_barrier(bar);
        if (layer + 1 < DEPTH) {
            { const CArgs a = AP(); TIDS(); ln_phase(a->out, a->in[14] + layer * DM, a->in[15] + layer * DM, a->out, XBP(a), a->in[3] + (size_t)(layer + 1) * 1024 * DIN, a->in[4] + (layer + 1) * 6, LFP(a), lds, tid, lane, wave); }
            xcd_barrier(bar);
        } else {
            const CArgs a = AP(); TIDS(); ln_phase(a->out, a->in[14] + layer * DM, a->in[15] + layer * DM, a->out, XBP(a), nullptr, nullptr, nullptr, lds, tid, lane, wave);
        }
}

__global__ void __launch_bounds__(NWAVES * 64, 2) fwd_kernel(Args a_unused) {
    extern __shared__ __attribute__((aligned(16))) unsigned char lds_raw[];
    cg::grid_group grid = cg::this_grid();
    LAS unsigned char* lds = (LAS unsigned char*)lds_raw;
    const CArgs kp = (CArgs)__builtin_amdgcn_kernarg_segment_ptr();
    if (threadIdx.x < 16) ((LAS unsigned*)(lds + LDS_QW + 64))[threadIdx.x] = 0u;
    __syncthreads();
    const XcdBarrier bar = xcd_barrier_post((unsigned*)(kp->ws + WS_CTL) + CW_BAR, (volatile LAS unsigned*)(lds + LDS_QW + 64));

    {
        const CArgs a = AP(); TIDS();
        LAS float* scr = (LAS float*)(lds + wave * 16384);
        for (int it = bx * NWAVES + wave; it < 2 * IT_LAYER; it += G * NWAVES) prologue_item(a, it, scr, lane);
        f32x2* rope = (f32x2*)(a->ws + WS_ROPE);
        for (int i = bx * (NWAVES * 64) + tid; i < SEQ * 8; i += G * NWAVES * 64) {
            const int pos = i >> 3, fi = i & 7; double t = (double)pos * ROPE_FR[fi]; t -= floor(t); const float fr = (float)t;
            rope[i] = (f32x2){__builtin_amdgcn_cosf(fr), __builtin_amdgcn_sinf(fr)};
        }
        __syncthreads();
        ln_phase(a->in[0], a->in[1], a->in[2], a->out, XBP(a), a->in[3], a->in[4], LFP(a), lds, tid, lane, wave);
    }
    grid.sync();

    layer_body<0>(kp, lds, lds_raw, bar);
    layer_body<1>(kp, lds, lds_raw, bar);
}

extern "C" void kernel_launch(void* const* d_in, const int* in_sizes, int n_in, void* d_out, int out_size, void* d_ws, size_t ws_size, hipStream_t stream) {
    static int grid = 0;
    if (grid == 0) {
        if (n_in != 16 || in_sizes[0] != T * DM || out_size != T * DM || ws_size < WS_END) {
            fprintf(stderr, "kernel_launch: unexpected problem geometry (n_in %d, in0 %d, out %d, ws %zu)\n", n_in, n_in > 0 ? in_sizes[0] : -1, out_size, ws_size); grid = -1; return; }
        int dev = 0, cus = 0, per_cu = 0;
        (void)hipGetDevice(&dev); (void)hipDeviceGetAttribute(&cus, hipDeviceAttributeMultiprocessorCount, dev);
        if (hipFuncSetAttribute((const void*)fwd_kernel, hipFuncAttributeMaxDynamicSharedMemorySize, LDS_BYTES) != hipSuccess) { fprintf(stderr, "kernel_launch: hipFuncSetAttribute failed\n"); grid = -1; return; }
        if (hipOccupancyMaxActiveBlocksPerMultiprocessor(&per_cu, (const void*)fwd_kernel, NWAVES * 64, LDS_BYTES) != hipSuccess || per_cu < 1) { fprintf(stderr, "kernel_launch: occupancy query says %d\n", per_cu); per_cu = 1; }
        (void)hipGetLastError();
        grid = cus * 1;
        if (grid % 8 != 0 || grid <= 0) grid = 256;
    }
    if (grid < 0) return;
    (void)hipMemsetAsync((char*)d_ws + WS_CTL, 0, CTL_BYTES, stream);
    Args a{};
    for (int i = 0; i < 16; ++i) a.in[i] = (const float*)d_in[i];
    a.out = (float*)d_out; a.ws = (unsigned char*)d_ws;
    void* args[] = {&a};
    const hipError_t e = hipLaunchCooperativeKernel((const void*)fwd_kernel, dim3(grid), dim3(NWAVES * 64), args, LDS_BYTES, stream);
    if (e != hipSuccess) fprintf(stderr, "kernel_launch: cooperative launch failed: %s (grid %d)\n", hipGetErrorString(e), grid);
}
```

```cpp
#include <hip/hip_runtime.h>
#include <hip/hip_cooperative_groups.h>
#include <hip/hip_bf16.h>
#include <cstdio>
#include <cstdint>
#include <cmath>
namespace cg = cooperative_groups;

#define LAS __attribute__((address_space(3)))
typedef unsigned short bf16_t;
typedef short bf16x8 __attribute__((ext_vector_type(8)));
typedef short s16x4 __attribute__((ext_vector_type(4)));
typedef float f32x2 __attribute__((ext_vector_type(2)));
typedef float f32x4 __attribute__((ext_vector_type(4)));
typedef float f32x16 __attribute__((ext_vector_type(16)));
typedef unsigned u32x4 __attribute__((ext_vector_type(4)));
typedef unsigned u32x2 __attribute__((ext_vector_type(2)));

constexpr int BATCH = 2, SEQ = 16384, DM = 1024, T = BATCH * SEQ, DEPTH = 2, DFF = 2816, DIN = 6662;
constexpr int NQKV = 3584, NG = 3072;
constexpr float LN_EPS = 1e-5f;
constexpr float DN_ALPHA = 1.4142135623730951f;
constexpr float LOG2E = 1.4426950408889634f;
constexpr float C2 = 0.125f * LOG2E;
constexpr int NWAVES = 8;

typedef __bf16 bf16x2_t __attribute__((ext_vector_type(2)));
__device__ __forceinline__ unsigned cvt_pk_bf16(float lo, float hi) { f32x2 v = {lo, hi}; bf16x2_t b = __builtin_convertvector(v, bf16x2_t); return __builtin_bit_cast(unsigned, b); }
__device__ __forceinline__ float bf2f(unsigned short b) { return __uint_as_float(((unsigned)b) << 16); }
__device__ __forceinline__ float bflo(unsigned w) { return __uint_as_float(w << 16); }
__device__ __forceinline__ float bfhi(unsigned w) { return __uint_as_float(w & 0xffff0000u); }

namespace pg8 {
constexpr int BM = 256, BK = 64, HALF = 128, HTB = HALF * BK * 2, STAGE_BYTES = 8 * HTB, NXCD = 8, WGM = 8;
__host__ __device__ __forceinline__ int lds_byte(int r, int c) { const int st = (r >> 4) * 2 + (c >> 5), rr = r & 15, cc = c & 31, ob = rr * 64 + cc * 2; return st * 1024 + (ob ^ (((ob >> 9) & 1) << 5)); }
__host__ __device__ __forceinline__ void stage_rc(int b, int& R, int& C) { const int st = b / 1024, sb = b % 1024, swz = sb ^ (((sb >> 9) & 1) << 5); R = (st >> 1) * 16 + swz / 64; C = (st & 1) * 32 + (swz % 64) / 2; }
__host__ __device__ __forceinline__ int perm32(int rho) { const int n = rho >> 4, i = rho & 15; return 8 * (i >> 2) + 4 * n + (i & 3); }

struct Unit { int pm, pn; };
struct Gemm { const bf16_t* A; const bf16_t* Bt; int lda, ldb, K; };

struct StaticOrder {
    int nM, nN, nwg, G, c;
    __host__ __device__ void init(int M, int N, int G_, int c_) { nM = M / BM; nN = N / BM; nwg = nM * nN; G = G_; c = c_; }
    __host__ __device__ bool next(int i, Unit& u) const {
        const long L = (long)i * G + c; if (L >= nwg) return false;
        int wgid = (int)L; { const int q = nwg / NXCD, r = nwg % NXCD, xcd = wgid % NXCD, off = wgid / NXCD; wgid = (xcd < r ? xcd * (q + 1) : r * (q + 1) + (xcd - r) * q) + off; }
        const int nig = WGM * nN, gid = wgid / nig, fm = gid * WGM, gsz = (nM - fm) < WGM ? (nM - fm) : WGM;
        u.pm = fm + ((wgid % nig) % gsz); u.pn = (wgid % nig) / gsz; return true;
    }
};

template <class Epi, bool ALIGN_EPI>
__device__ __forceinline__ void gemm_phase(LAS unsigned char* lds, const Gemm g, const StaticOrder& S, const Epi& E) {
    int tid_ = threadIdx.x; asm volatile("" : "+v"(tid_));
    const int tid = tid_, wid = __builtin_amdgcn_readfirstlane(tid >> 6), lane = tid & 63, wr = wid >> 2, wc = wid & 3, fr = lane & 15, fq = lane >> 4;
    const int nt = g.K / BK;
    unsigned voffA[2], voffB[2];
#pragma unroll
    for (int i = 0; i < 2; ++i) { int R, C; stage_rc(tid * 16 + i * 8192, R, C); const int Rb = (R & ~31) + perm32(R & 31);
        voffA[i] = (unsigned)(R * g.lda + C) * 2u; voffB[i] = (unsigned)(Rb * g.ldb + C) * 2u; }
    const size_t kstep = (size_t)(BK * 2);
    const size_t hA = (size_t)HALF * g.lda * 2, hB = (size_t)HALF * g.ldb * 2;
    const size_t tA = 2 * hA, tB = 2 * hB;
    const unsigned ldsw = (unsigned)wid * 1024u;
    const int aoff = lds_byte(wr * 64 + fr, fq * 8), boff = lds_byte(wc * 32 + fr, fq * 8);
#define PG8_SA(b, h) (((b) * 2 + (h)) * HTB)
#define PG8_SB(b, h) ((4 + (b) * 2 + (h)) * HTB)
#define PG8_STAGE(bufoff, gbase, voff) do { _Pragma("unroll") for (int _i = 0; _i < 2; ++_i) \
        __builtin_amdgcn_global_load_lds((const unsigned*)((const char*)(gbase) + (voff)[_i]), (LAS unsigned*)(lds + (bufoff) + ldsw + _i * 8192), 16, 0, 0); } while (0)
#define PG8_LDA(dst, b, h) do { _Pragma("unroll") for (int m = 0; m < 4; ++m) _Pragma("unroll") for (int k = 0; k < 2; ++k) dst[m][k] = *(const LAS bf16x8*)(lds + PG8_SA(b, h) + aoff + m * 2048 + k * 1024); } while (0)
#define PG8_LDB(dst, b, h) do { _Pragma("unroll") for (int n = 0; n < 2; ++n) _Pragma("unroll") for (int k = 0; k < 2; ++k) dst[n][k] = *(const LAS bf16x8*)(lds + PG8_SB(b, h) + boff + n * 2048 + k * 1024); } while (0)
#define PG8_MMA(ai, bj, At, Bt) do { __builtin_amdgcn_s_setprio(1); _Pragma("unroll") for (int m = 0; m < 4; ++m) _Pragma("unroll") for (int n = 0; n < 2; ++n) _Pragma("unroll") for (int k = 0; k < 2; ++k) \
        acc[ai][bj][m][n] = __builtin_amdgcn_mfma_f32_16x16x32_bf16(Bt[n][k], At[m][k], acc[ai][bj][m][n], 0, 0, 0); __builtin_amdgcn_s_setprio(0); } while (0)
#define PG8_WAIT_V(n) asm volatile("s_waitcnt vmcnt(" #n ")" ::: "memory")
#define PG8_WAIT_L(n) asm volatile("s_waitcnt lgkmcnt(" #n ")" ::: "memory")
#define PG8_BAR __builtin_amdgcn_s_barrier()
#define PG8_SCHED __builtin_amdgcn_sched_barrier(0)
    Unit cur, nxt; int ui = 0;
    if (!S.next(0, cur)) return;
    f32x4 acc[2][2][4][2];
#pragma unroll
    for (int a = 0; a < 2; ++a)
#pragma unroll
        for (int b = 0; b < 2; ++b)
#pragma unroll
            for (int m = 0; m < 4; ++m)
#pragma unroll
                for (int n = 0; n < 2; ++n) acc[a][b][m][n] = (f32x4){0.f, 0.f, 0.f, 0.f};
    bf16x8 At[4][2], B0[2][2], B1[2][2];
    const char* cA = (const char*)g.A + (size_t)cur.pm * tA; const char* cB = (const char*)g.Bt + (size_t)cur.pn * tB;
    PG8_STAGE(PG8_SB(0, 0), cB, voffB); PG8_STAGE(PG8_SB(0, 1), cB + hB, voffB); PG8_STAGE(PG8_SA(0, 0), cA, voffA); PG8_STAGE(PG8_SA(0, 1), cA + hA, voffA);
    if (wr == 1) PG8_BAR;
    PG8_WAIT_V(2); PG8_BAR;
    PG8_STAGE(PG8_SB(1, 0), cB + kstep, voffB); PG8_STAGE(PG8_SA(1, 0), cA + kstep, voffA); PG8_STAGE(PG8_SB(1, 1), cB + hB + kstep, voffB);
    PG8_WAIT_V(6); PG8_BAR;
    for (;;) {
        const bool has_next = S.next(ui + 1, nxt);
        const char* nA = has_next ? (const char*)g.A + (size_t)nxt.pm * tA : cA; const char* nB = has_next ? (const char*)g.Bt + (size_t)nxt.pn * tB : cB;
        for (int t = 0; t < nt; t += 2) {
            const bool last = (t == nt - 2);
            const char* a1 = cA + (size_t)(t + 1) * kstep;
            const char* a2 = last ? nA : cA + (size_t)(t + 2) * kstep; const char* b2 = last ? nB : cB + (size_t)(t + 2) * kstep;
            const char* a3 = a2 + kstep; const char* b3 = b2 + kstep;
            PG8_LDB(B0, 0, 0); PG8_LDB(B1, 0, 1); PG8_SCHED; PG8_LDA(At, 0, 0); PG8_STAGE(PG8_SA(1, 1), a1 + hA, voffA);
            PG8_WAIT_V(8); PG8_WAIT_L(0); PG8_BAR; PG8_MMA(0, 0, At, B0); PG8_MMA(0, 1, At, B1); PG8_BAR; PG8_SCHED;
            PG8_LDA(At, 0, 1); PG8_STAGE(PG8_SB(0, 0), b2, voffB); PG8_STAGE(PG8_SB(0, 1), b2 + hB, voffB); PG8_STAGE(PG8_SA(0, 0), a2, voffA);
            PG8_WAIT_V(8); PG8_WAIT_L(0); PG8_BAR; PG8_MMA(1, 0, At, B0); PG8_MMA(1, 1, At, B1); PG8_BAR; PG8_SCHED;
            PG8_LDB(B0, 1, 0); PG8_LDB(B1, 1, 1); PG8_SCHED; PG8_LDA(At, 1, 0); PG8_STAGE(PG8_SA(0, 1), a2 + hA, voffA);
            PG8_WAIT_V(8); PG8_WAIT_L(0); PG8_BAR; PG8_MMA(0, 0, At, B0); PG8_MMA(0, 1, At, B1); PG8_BAR; PG8_SCHED;
            PG8_LDA(At, 1, 1); PG8_STAGE(PG8_SB(1, 0), b3, voffB); PG8_STAGE(PG8_SB(1, 1), b3 + hB, voffB); PG8_STAGE(PG8_SA(1, 0), a3, voffA);
            PG8_WAIT_V(8); PG8_WAIT_L(0); PG8_BAR; PG8_MMA(1, 0, At, B0); PG8_MMA(1, 1, At, B1); PG8_BAR; PG8_SCHED;
        }
        if constexpr (ALIGN_EPI) { if (wr == 0) PG8_BAR; }
        E(acc, cur, wr, wc, fr, fq);
        if (!has_next) break;
#pragma unroll
        for (int a = 0; a < 2; ++a)
#pragma unroll
            for (int b = 0; b < 2; ++b)
#pragma unroll
                for (int m = 0; m < 4; ++m)
#pragma unroll
                    for (int n = 0; n < 2; ++n) acc[a][b][m][n] = (f32x4){0.f, 0.f, 0.f, 0.f};
        cur = nxt; cA = nA; cB = nB; ++ui;
        if constexpr (ALIGN_EPI) { if (wr == 1) PG8_BAR; }
    }
    PG8_WAIT_V(0);
    if constexpr (!ALIGN_EPI) { if (wr == 0) PG8_BAR; }
    PG8_BAR;
#undef PG8_SA
#undef PG8_SB
#undef PG8_STAGE
#undef PG8_LDA
#undef PG8_LDB
#undef PG8_MMA
#undef PG8_WAIT_V
#undef PG8_WAIT_L
#undef PG8_BAR
#undef PG8_SCHED
}
}
namespace attn_body {
using bf16=__hip_bfloat16;
using bf16x8=__attribute__((ext_vector_type(8)))short;
using s16x4=__attribute__((ext_vector_type(4)))short;
using f32x16=__attribute__((ext_vector_type(16)))float;
using u32x4=__attribute__((ext_vector_type(4)))unsigned;
using f32x4v=__attribute__((ext_vector_type(4)))float;
constexpr int BATCH=2,NHEAD=6,SEQ=16384,D=64,DM=NHEAD*D;
constexpr int NW=8,QBLK=32,QB=QBLK*NW,KVBLK=64,NQB=SEQ/QB;
constexpr int ATTN_PITCH=DM, ATTN_UNIT_ROWS=QB;
__device__ __forceinline__ int crow(int r,int hi){return (r&3)+8*(r>>2)+4*hi;}
#define SBAR() __builtin_amdgcn_sched_barrier(0)
__device__ __forceinline__ void cmask(f32x16&p0,f32x16&p1,int jb,int qrel,int hi){
  const float NEG=-INFINITY; int kb=64*jb+4*hi;
  #pragma unroll
  for(int r=0;r<16;++r){int kv=kb+(r&3)+8*(r>>2); if(kv>qrel)p0[r]=NEG; if(kv+32>qrel)p1[r]=NEG;}
}

constexpr int NSLOT=3, SLOTB=8192;
constexpr int LDS_K=0, LDS_V=NSLOT*SLOTB, LDS_WS=2*NSLOT*SLOTB, LDS_OST=LDS_WS+NW*64*4, LDS_BIAS=LDS_OST+NW*4096, LDS_BYTES=LDS_BIAS+SEQ*4;
constexpr float C2=0.125f*1.4426950408889634f;
__device__ __forceinline__ void glds16(const void*gsrc,unsigned lds_dst){unsigned keep;
  asm volatile("s_mov_b32 %0, m0\n\ts_mov_b32 m0, %2\n\ts_nop 0\n\tglobal_load_lds_dwordx4 %1, off\n\ts_mov_b32 m0, %0":"=&s"(keep):"v"(gsrc),"s"(lds_dst):"memory");}
__device__ __forceinline__ float max3f(float a,float b,float c){float r;asm("v_max3_f32 %0, %1, %2, %3":"=v"(r):"v"(a),"v"(b),"v"(c));return r;}
__device__ __forceinline__ float max2f(float a,float b){float r;asm("v_max_f32_e32 %0, %1, %2":"=v"(r):"v"(a),"v"(b));return r;}
__device__ __forceinline__ float fadd_s(float a,float b){float r;asm("v_add_f32_e32 %0, %1, %2":"=v"(r):"v"(a),"v"(b));return r;}
__device__ __forceinline__ float fsub_s(float a,float b){float r;asm("v_sub_f32_e32 %0, %1, %2":"=v"(r):"v"(a),"v"(b));return r;}
typedef float f32x2_t __attribute__((ext_vector_type(2))); typedef __bf16 bf16x2_t __attribute__((ext_vector_type(2)));
__device__ __forceinline__ unsigned cvtpk_s(float lo,float hi){f32x2_t v={lo,hi};bf16x2_t b=__builtin_convertvector(v,bf16x2_t);return __builtin_bit_cast(unsigned,b);}
#define WAIT_BAR(N) asm volatile("s_waitcnt vmcnt(" #N ") lgkmcnt(0)\n\ts_barrier":::"memory")

__device__ __forceinline__ void qkt(f32x16&p0,f32x16&p1,const char*Kslot,const bf16x8*qr,int r32,int hi){
  const char*kb=Kslot+hi*1024+r32*16;
  #pragma unroll
  for(int d0=0;d0<4;++d0){
    const bf16x8 b0=*reinterpret_cast<const bf16x8*>(kb+d0*2048);
    const bf16x8 b1=*reinterpret_cast<const bf16x8*>(kb+d0*2048+512);
    {p0=__builtin_amdgcn_mfma_f32_32x32x16_bf16(b0,qr[d0],p0,0,0,0);p1=__builtin_amdgcn_mfma_f32_32x32x16_bf16(b1,qr[d0],p1,0,0,0);}}
}
typedef __attribute__((address_space(3))) const char* lds_cptr;
typedef short v4i16_t __attribute__((ext_vector_type(4)));
__device__ __forceinline__ void kload8(bf16x8*kf,lds_cptr kp){
  kf[0]=*(const __attribute__((address_space(3))) bf16x8*)(kp);      kf[1]=*(const __attribute__((address_space(3))) bf16x8*)(kp+512);
  kf[2]=*(const __attribute__((address_space(3))) bf16x8*)(kp+2048); kf[3]=*(const __attribute__((address_space(3))) bf16x8*)(kp+2560);
  kf[4]=*(const __attribute__((address_space(3))) bf16x8*)(kp+4096); kf[5]=*(const __attribute__((address_space(3))) bf16x8*)(kp+4608);
  kf[6]=*(const __attribute__((address_space(3))) bf16x8*)(kp+6144); kf[7]=*(const __attribute__((address_space(3))) bf16x8*)(kp+6656);
}
__device__ __forceinline__ void kload2(bf16x8*kf,lds_cptr kp,int j){ kf[2*j]=*(const __attribute__((address_space(3))) bf16x8*)(kp+j*2048); kf[2*j+1]=*(const __attribute__((address_space(3))) bf16x8*)(kp+j*2048+512); }
__device__ __forceinline__ s16x4 vtr(lds_cptr p){ return __builtin_bit_cast(s16x4,__builtin_amdgcn_ds_read_tr16_b64_v4i16((__attribute__((address_space(3))) v4i16_t*)p)); }
__device__ __forceinline__ float rowmax(const f32x16&p0,const f32x16&p1){
  float a=max3f(p0[0],p0[1],p1[0]),b=max3f(p0[2],p0[3],p1[1]);a=max3f(a,p1[2],p1[3]);
  #pragma unroll
  for(int r=4;r<16;r+=4){a=max3f(a,p0[r],p0[r+1]);b=max3f(b,p0[r+2],p0[r+3]);a=max3f(a,p1[r],p1[r+1]);b=max3f(b,p1[r+2],p1[r+3]);}
  const float m=max2f(a,b);
  auto rr=__builtin_amdgcn_permlane32_swap(__float_as_uint(m),__float_as_uint(m),false,false);
  return max2f(__uint_as_float(rr[0]),__uint_as_float(rr[1]));
}
__device__ __forceinline__ void pv(f32x16*o,int vb,bf16x8 pa0,bf16x8 pa1,bf16x8 pa2,bf16x8 pa3){
  #pragma unroll
  for(int d0=0;d0<2;++d0){s16x4 lo[4],hi[4];
    #pragma unroll
    for(int ks=0;ks<4;++ks){
      asm volatile("ds_read_b64_tr_b16 %0,%1 offset:%c2":"=&v"(lo[ks]):"v"(vb),"i"(d0*4096+ks*1024):"memory");
      asm volatile("ds_read_b64_tr_b16 %0,%1 offset:%c2":"=&v"(hi[ks]):"v"(vb),"i"(d0*4096+ks*1024+512):"memory");}
    asm volatile("s_waitcnt lgkmcnt(0)":::"memory");SBAR();
    #define PK(k) (bf16x8){lo[k][0],lo[k][1],lo[k][2],lo[k][3],hi[k][0],hi[k][1],hi[k][2],hi[k][3]}
    o[d0]=__builtin_amdgcn_mfma_f32_32x32x16_bf16(pa0,PK(0),o[d0],0,0,0);
    o[d0]=__builtin_amdgcn_mfma_f32_32x32x16_bf16(pa1,PK(1),o[d0],0,0,0);
    o[d0]=__builtin_amdgcn_mfma_f32_32x32x16_bf16(pa2,PK(2),o[d0],0,0,0);
    o[d0]=__builtin_amdgcn_mfma_f32_32x32x16_bf16(pa3,PK(3),o[d0],0,0,0);
    #undef PK
  }
}

#ifndef ATTN_STORE16
#define ATTN_STORE16(p,v) (*(u32x4*)(p)=(v))
#endif
template<int THRL> __device__ __forceinline__ void attn_unit(int b,int h,int qb,const bf16*Q,const bf16*__restrict__ K,const bf16*__restrict__ V,bf16*O,const float*__restrict__ cum,char*shm){
  int tid_=threadIdx.x; asm volatile("":"+v"(tid_)); const int tid=tid_,lane=tid&63,r32=lane&31,hi=lane>>5; const int wid=__builtin_amdgcn_readfirstlane(tid>>6);
  const long rowbase=(long)b*SEQ; const int q0=qb*QB;
  const bf16*Qw=Q+(rowbase+q0+wid*QBLK)*DM+h*D;
  const bf16*Kh=K+rowbase*DM+h*D,*Vh=V+rowbase*DM+h*D;
  const unsigned lds0=(unsigned)(uintptr_t)shm;
  float*wsf=(float*)(shm+LDS_WS)+wid*64;
  const bf16*ksrc=Kh+(long)lane*DM+wid*8;
  const bf16*vsrc=Vh+(long)(16*(wid&3)+(lane>>2))*DM+(wid>>2)*32+(lane&3)*8;
  const unsigned kdst=lds0+LDS_K+wid*1024, vdst=lds0+LDS_V+wid*1024;
  #define DMA_K(t,slot) glds16(ksrc+(long)(t)*KVBLK*DM,(unsigned)__builtin_amdgcn_readfirstlane(kdst+(slot)))
  #define DMA_V(t,slot) glds16(vsrc+(long)(t)*KVBLK*DM,(unsigned)__builtin_amdgcn_readfirstlane(vdst+(slot)))
  const int vb0=(int)(lds0+LDS_V)+((lane>>4)&1)*32+(lane&3)*8+(4*hi+((lane&15)>>2))*64;
  const char*Kbase=shm+LDS_K; bf16x8 kf[8];
  const lds_cptr shm3=(lds_cptr)shm; const lds_cptr kp0=shm3+LDS_K+hi*1024+r32*16; const lds_cptr vp0=shm3+LDS_V+((lane>>4)&1)*32+(lane&3)*8+(4*hi+((lane&15)>>2))*64;
  const int NT=(q0+QB)/KVBLK;
  const __attribute__((address_space(3))) float* biasl=(const __attribute__((address_space(3))) float*)(shm3+LDS_BIAS);
  { __attribute__((address_space(3))) float* bw=(__attribute__((address_space(3))) float*)(shm3+LDS_BIAS);
    for(int i=tid*4;i<q0+QB;i+=NW*64*4){ f32x4v v=*reinterpret_cast<const f32x4v*>(cum+i); v=v*(-1.4426950408889634f); *(__attribute__((address_space(3))) f32x4v*)(bw+i)=v; }
    asm volatile("s_waitcnt vmcnt(0) lgkmcnt(0)\n\ts_barrier":::"memory"); }
  DMA_K(0,0);DMA_V(0,0);DMA_K(1,SLOTB);
  bf16x8 qr[4];
  #pragma unroll
  for(int d0=0;d0<4;++d0)qr[d0]=*reinterpret_cast<const bf16x8*>(&Qw[(long)r32*DM+d0*16+hi*8]);
  float mhat=0.f,l_reg=0.f;f32x16 o[2];o[0]=f32x16{};o[1]=f32x16{};
  #define BIASFILL(C0,C1,t) do{ const __attribute__((address_space(3))) float* bp_=biasl+64*(t)+4*hi; \
    _Pragma("unroll") for(int g_=0;g_<4;++g_){ const f32x4v v_=*(const __attribute__((address_space(3))) f32x4v*)(bp_+8*g_); const f32x4v w_=*(const __attribute__((address_space(3))) f32x4v*)(bp_+32+8*g_); \
      _Pragma("unroll") for(int i_=0;i_<4;++i_){ C0[4*g_+i_]=v_[i_]-mhat; C1[4*g_+i_]=w_[i_]-mhat; } } }while(0)
  const int qrel=wid*QBLK+r32;
  #define CMASK(P0,P1,t) do{int jb_=(t)-(NT-4); if(jb_>=0)cmask(P0,P1,jb_,qrel,hi);}while(0)
  bool resc=false;
  #define START(P0,P1) do{ const float rm=rowmax(P0,P1); resc=false; \
    { const float dl=rm; mhat=fadd_s(mhat,dl); \
      _Pragma("unroll") for(int r=0;r<16;++r){P0[r]=fsub_s(P0[r],dl);P1[r]=fsub_s(P1[r],dl);} \
      } \
    _Pragma("unroll") for(int r=0;r<16;++r)P0[r]=__builtin_amdgcn_exp2f(P0[r]); }while(0)
  #define RESC() do{ if(resc){ asm volatile("s_waitcnt lgkmcnt(0)":::"memory"); \
      _Pragma("unroll") for(int d_=0;d_<2;++d_) _Pragma("unroll") for(int r=0;r<16;++r)o[d_][r]*=wsf[crow(r,hi)]; } }while(0)
  f32x16 pA0,pA1,pB0,pB1;
  int sl_prev=0,sl_cur=0,sl_next=SLOTB;
  #define ROT() do{sl_prev=sl_cur;sl_cur=sl_next;sl_next=(sl_next==(NSLOT-1)*SLOTB)?0:sl_next+SLOTB;}while(0)
  DMA_K(2,2*SLOTB);
  WAIT_BAR(3);
  BIASFILL(pA0,pA1,0); qkt(pA0,pA1,Kbase,qr,r32,hi);asm volatile("s_nop 15\n\ts_nop 7":"+v"(pA0),"+v"(pA1));CMASK(pA0,pA1,0);
  START(pA0,pA1);
  _Pragma("unroll") for(int r=0;r<16;++r)pA1[r]=__builtin_amdgcn_exp2f(pA1[r]);
  WAIT_BAR(0);
  DMA_K(3,0);DMA_V(1,SLOTB);
  ROT();
  kload8(kf,kp0+sl_cur);
  WAIT_BAR(2);
  s16x4 vlo[8],vhi[8]; u32x4 pw0,pw1,pw2,pw3;
  #define PKW(P,B) cvtpk_s(P[B],P[B+1])
  #define PAF(k) __builtin_bit_cast(bf16x8,pw##k)
  #define VFR(i) (bf16x8){vlo[i][0],vlo[i][1],vlo[i][2],vlo[i][3],vhi[i][0],vhi[i][1],vhi[i][2],vhi[i][3]}
  #define PIN(x) asm volatile("":"+v"(x))
  #define MX3(a,b,c) __builtin_fmaxf(__builtin_fmaxf((a),(b)),(c))
  #define GAPA(MF,A0,A1,A2,A3,W0,W1,PW) do{ MF; sacc+=A0; sacc+=A1; sacc+=A2; sacc+=A3; PIN(sacc); W0; W1; PIN(PW); SBAR(); }while(0)
  #define EX(v) __builtin_amdgcn_exp2f(v)
  #define GAPB(MF,X,B) do{ MF; X[B]=EX(X[B]); X[B+1]=EX(X[B+1]); X[B+2]=EX(X[B+2]); X[B+3]=EX(X[B+3]); PIN(X); SBAR(); }while(0)
  #define VRD(i) do{ vlo[i]=vtr(vp_+(((i)>>2)*4096+((i)&3)*1024)); vhi[i]=vtr(vp_+(((i)>>2)*4096+((i)&3)*1024+512)); }while(0)
  #define KRD(G,j) do{ if(G){ kload2(kf,kp0+sl_next,j); SBAR(); } }while(0)
  #define STEP(C0,C1,P0,P1,t,GK,GV,GL) do{ SBAR(); \
    BIASFILL(C0,C1,t); SBAR(); \
    const lds_cptr vp_=vp0+sl_prev; \
    VRD(0); SBAR(); float sacc=(P0[0]+P0[1]); \
    GAPA(C0=__builtin_amdgcn_mfma_f32_32x32x16_bf16(kf[0],qr[0],C0,0,0,0), P0[2],P0[3],P0[4],P0[5],     pw0[0]=PKW(P0,0), pw0[1]=PKW(P0,2), pw0); \
    VRD(4); SBAR(); GAPA(C1=__builtin_amdgcn_mfma_f32_32x32x16_bf16(kf[1],qr[0],C1,0,0,0), P0[6],P0[7],P0[8],P0[9],     pw0[2]=PKW(P0,4), pw0[3]=PKW(P0,6), pw0); \
    VRD(1); SBAR(); GAPA(C0=__builtin_amdgcn_mfma_f32_32x32x16_bf16(kf[2],qr[1],C0,0,0,0),   P0[10],P0[11],P0[12],P0[13], pw1[0]=PKW(P0,8), pw1[1]=PKW(P0,10), pw1); \
    VRD(5); SBAR(); GAPA(C1=__builtin_amdgcn_mfma_f32_32x32x16_bf16(kf[3],qr[1],C1,0,0,0),   P0[14],P0[15],P1[0],P1[1],   pw1[2]=PKW(P0,12),pw1[3]=PKW(P0,14), pw1); \
    VRD(2); SBAR(); GAPA(C0=__builtin_amdgcn_mfma_f32_32x32x16_bf16(kf[4],qr[2],C0,0,0,0),   P1[2],P1[3],P1[4],P1[5],     pw2[0]=PKW(P1,0), pw2[1]=PKW(P1,2), pw2); \
    VRD(6); SBAR(); GAPA(C1=__builtin_amdgcn_mfma_f32_32x32x16_bf16(kf[5],qr[2],C1,0,0,0),   P1[6],P1[7],P1[8],P1[9],     pw2[2]=PKW(P1,4), pw2[3]=PKW(P1,6), pw2); \
    VRD(3); SBAR(); GAPA(C0=__builtin_amdgcn_mfma_f32_32x32x16_bf16(kf[6],qr[3],C0,0,0,0),   P1[10],P1[11],P1[12],P1[13], pw3[0]=PKW(P1,8), pw3[1]=PKW(P1,10), pw3); \
    VRD(7); SBAR(); GAPA(C1=__builtin_amdgcn_mfma_f32_32x32x16_bf16(kf[7],qr[3],C1,0,0,0),   P1[14],P1[15],0.f,0.f,       pw3[2]=PKW(P1,12),pw3[3]=PKW(P1,14), pw3); \
    l_reg+=sacc; \
    if(GK){DMA_K((t)+3,sl_cur);} if(GV){DMA_V((t)+1,sl_next);} \
    CMASK(C0,C1,t); \
    { float a=MX3(C0[0],C0[1],C1[0]),b=MX3(C0[2],C0[3],C1[1]); a=MX3(a,C1[2],C1[3]); \
      _Pragma("unroll") for(int r=4;r<16;r+=4){a=MX3(a,C0[r],C0[r+1]);b=MX3(b,C0[r+2],C0[r+3]);a=MX3(a,C1[r],C1[r+1]);b=MX3(b,C1[r+2],C1[r+3]);} \
      float rm=__builtin_fmaxf(a,b); { auto rr=__builtin_amdgcn_permlane32_swap(__float_as_uint(rm),__float_as_uint(rm),false,false); rm=__builtin_fmaxf(__uint_as_float(rr[0]),__uint_as_float(rr[1])); } \
      resc=false; \
      if(__builtin_expect(__any(rm>(float)THRL),0)){ const float dl=__builtin_fmaxf(rm,0.f); mhat+=dl; \
        _Pragma("unroll") for(int r=0;r<16;++r){C0[r]-=dl;C1[r]-=dl;} \
        const float f=__builtin_amdgcn_exp2f(-dl); l_reg*=f; if(hi==0)wsf[r32]=f; resc=true; } } \
    SBAR(); \
    GAPB(o[0]=__builtin_amdgcn_mfma_f32_32x32x16_bf16(PAF(0),VFR(0),o[0],0,0,0), C0,0); \
    GAPB(o[1]=__builtin_amdgcn_mfma_f32_32x32x16_bf16(PAF(0),VFR(4),o[1],0,0,0), C0,4); \
    KRD(GL,0); GAPB(o[0]=__builtin_amdgcn_mfma_f32_32x32x16_bf16(PAF(1),VFR(1),o[0],0,0,0), C0,8); \
    KRD(GL,1); GAPB(o[1]=__builtin_amdgcn_mfma_f32_32x32x16_bf16(PAF(1),VFR(5),o[1],0,0,0), C0,12); \
    KRD(GL,2); GAPB(o[0]=__builtin_amdgcn_mfma_f32_32x32x16_bf16(PAF(2),VFR(2),o[0],0,0,0), C1,0); \
    KRD(GL,3); GAPB(o[1]=__builtin_amdgcn_mfma_f32_32x32x16_bf16(PAF(2),VFR(6),o[1],0,0,0), C1,4); \
    GAPB(o[0]=__builtin_amdgcn_mfma_f32_32x32x16_bf16(PAF(3),VFR(3),o[0],0,0,0), C1,8); \
    GAPB(o[1]=__builtin_amdgcn_mfma_f32_32x32x16_bf16(PAF(3),VFR(7),o[1],0,0,0), C1,12); \
    }while(0)
  int t=1;
  #undef CMASK
  #define CMASK(P0,P1,t) do{}while(0)
  for(;t+5<NT;t+=2){
    STEP(pB0,pB1,pA0,pA1,t,true,true,true);     WAIT_BAR(2); RESC(); ROT();
    STEP(pA0,pA1,pB0,pB1,t+1,true,true,true);   WAIT_BAR(2); RESC(); ROT();
  }
  #undef CMASK
  #define CMASK(P0,P1,t) do{int jb_=(t)-(NT-4); if(jb_>=0)cmask(P0,P1,jb_,qrel,hi);}while(0)
  #define ENDW(tt) do{ if((tt)+3<NT){WAIT_BAR(2);} else if((tt)+2<NT){WAIT_BAR(1);} else {WAIT_BAR(0);} }while(0)
  for(;t+1<NT;t+=2){
    STEP(pB0,pB1,pA0,pA1,t,(t+3<NT),(t+1<NT),(t+1<NT));       ENDW(t);   RESC(); ROT();
    STEP(pA0,pA1,pB0,pB1,t+1,(t+4<NT),(t+2<NT),(t+2<NT));     ENDW(t+1); RESC(); ROT();
  }
  STEP(pB0,pB1,pA0,pA1,NT-1,false,false,false); RESC();
  { float sacc=pB0[0]+pB0[1]; _Pragma("unroll") for(int r=2;r<16;++r)sacc+=pB0[r]; _Pragma("unroll") for(int r=0;r<16;++r)sacc+=pB1[r]; l_reg+=sacc;
    pw0=(u32x4){PKW(pB0,0),PKW(pB0,2),PKW(pB0,4),PKW(pB0,6)};pw1=(u32x4){PKW(pB0,8),PKW(pB0,10),PKW(pB0,12),PKW(pB0,14)};pw2=(u32x4){PKW(pB1,0),PKW(pB1,2),PKW(pB1,4),PKW(pB1,6)};pw3=(u32x4){PKW(pB1,8),PKW(pB1,10),PKW(pB1,12),PKW(pB1,14)};
    SBAR(); pv(o,vb0+sl_cur,PAF(0),PAF(1),PAF(2),PAF(3)); }
  #undef PKW
  #undef PAF
  #undef VFR
  #undef PIN
  #undef MX3
  #undef GAPA
  #undef GAPB
  #undef EX
  #undef VRD
  #undef KRD
  #undef STEP
  #undef ENDW
  {auto rr=__builtin_amdgcn_permlane32_swap(__float_as_uint(l_reg),__float_as_uint(l_reg),false,false);l_reg=__uint_as_float(rr[0])+__uint_as_float(rr[1]);}
  if(hi==0)wsf[32+r32]=l_reg;asm volatile("s_waitcnt lgkmcnt(0)":::"memory");
  float rli[16];
  #pragma unroll
  for(int r=0;r<16;++r)rli[r]=__builtin_amdgcn_rcpf(wsf[32+crow(r,hi)]);
  bf16*Ow=O+(rowbase+q0+wid*QBLK)*DM+h*D;
  { bf16*stg=(bf16*)(shm+LDS_OST)+wid*2048;
    #pragma unroll
    for(int r=0;r<16;++r){const int orow=crow(r,hi);
      #pragma unroll
      for(int d0=0;d0<2;++d0)stg[orow*64+d0*32+r32]=__float2bfloat16(o[d0][r]*rli[r]);}
    asm volatile("s_waitcnt lgkmcnt(0)":::"memory");
    #pragma unroll
    for(int i=0;i<4;++i){const int row=i*8+(lane>>3),ch=lane&7; const u32x4 v=*(const u32x4*)(stg+row*64+ch*8); ATTN_STORE16(Ow+(long)row*DM+ch*8,v);} }
  asm volatile("s_waitcnt lgkmcnt(0)\n\ts_barrier":::"memory");
  #undef DMA_K
  #undef DMA_V
  #undef CMASK
  #undef START
  #undef RESC
  #undef ROT
  #undef BIASFILL
}
constexpr int ATTN_LDS_BYTES=LDS_BYTES;
#undef SBAR
#undef WAIT_BAR
}

constexpr size_t MiB = 1u << 20;
constexpr size_t WS_CTL = 0, CTL_BYTES = 1 * MiB;
constexpr int CW_QCTR = 0;
constexpr int CW_CNT = 1024;
constexpr int CW_KMEAN = 4096;
constexpr size_t WS_W = 1 * MiB;
constexpr size_t W_IN = 0, W_G = W_IN + (size_t)NQKV * 1024, W_PA = W_G + (size_t)NG * 1024, W_PB = W_PA + 1024 * 384, W_PC = W_PB + 1024 * 256,
                 W_O = W_PC + 1024 * 384, W_GU = W_O + 1024 * 1024, W_D = W_GU + (size_t)2 * DFF * 1024, W_LAYER = W_D + (size_t)1024 * DFF;
static_assert(WS_W + 2 * W_LAYER * 2 <= 69 * MiB, "weights");
constexpr size_t WS_ROPE = 69 * MiB;
constexpr size_t WS_LF = 70 * MiB;
constexpr size_t WS_CUM = 71 * MiB;
constexpr size_t WS_LSEB = 72 * MiB;
constexpr size_t WS_XB = 76 * MiB;
constexpr size_t WS_QA = 140 * MiB, WS_KA = 164 * MiB, WS_VA = 188 * MiB, WS_QB = 212 * MiB, WS_KB = 260 * MiB, WS_VB = 276 * MiB,
                 WS_QC = 292 * MiB, WS_KC = 316 * MiB, WS_VC = 340 * MiB;
constexpr size_t WS_H = 140 * MiB;
constexpr size_t WS_PO = 364 * MiB;
constexpr size_t WS_PLSE = 460 * MiB;
constexpr size_t WS_LIST = 463 * MiB;
constexpr size_t WS_GS = 364 * MiB;
constexpr size_t WS_MG = 428 * MiB;
constexpr size_t WS_END = 492 * MiB;
constexpr int LIST_PER_BH = 256 * 2016;
__device__ __forceinline__ int list_off(int bh, int n) { return bh * LIST_PER_BH + 256 * (63 * n - (n * (n - 1)) / 2); }

constexpr int LDS_QW = 150 * 1024;
constexpr int LDS_BYTES = 152 * 1024;
static_assert(attn_body::ATTN_LDS_BYTES <= LDS_QW && pg8::STAGE_BYTES <= LDS_QW, "lds");

__constant__ double ROPE_FR[8] = {0.15915494309189535, 0.03086376340470123, 0.005985185712713705, 0.0011606636412400608,
                                  0.00022507907903927653, 4.364795279280289e-05, 8.464330808241401e-06, 1.6414262627950345e-06};

struct Args { const float* in[16]; float* out; unsigned char* ws; };
typedef const __attribute__((address_space(4))) Args* CArgs;

__device__ __forceinline__ float wave_sum(float v) {
#pragma unroll
    for (int o = 1; o < 64; o <<= 1) v += __shfl_xor(v, o);
    return v;
}
__device__ __forceinline__ unsigned f2bf(float f) { unsigned u = __builtin_bit_cast(unsigned, f); return (u + 0x7fffu + ((u >> 16) & 1u)) >> 16; }
__device__ __forceinline__ unsigned pk2(float lo, float hi) { return f2bf(lo) | (f2bf(hi) << 16); }

__device__ __forceinline__ void transpose_item(const float* Wsrc, int ldw, bf16_t* dst, int ldk, LAS float* scr, int lane) {
#pragma unroll 8
    for (int i = 0; i < 32; ++i) { const int kk = 2 * i + (lane >> 5); scr[kk * 33 + (lane & 31)] = Wsrc[(size_t)kk * ldw + (lane & 31)]; }
    asm volatile("s_waitcnt lgkmcnt(0)" ::: "memory");
    const int c = lane & 7;
#pragma unroll
    for (int j = 0; j < 4; ++j) { const int n = (lane >> 3) + 8 * j; const LAS float* s = scr + (8 * c) * 33 + n;
        u32x4 o; o.x = pk2(s[0 * 33], s[1 * 33]); o.y = pk2(s[2 * 33], s[3 * 33]); o.z = pk2(s[4 * 33], s[5 * 33]); o.w = pk2(s[6 * 33], s[7 * 33]);
        *(u32x4*)(dst + (size_t)(n) * ldk + 8 * c) = o; }
    asm volatile("s_waitcnt lgkmcnt(0)" ::: "memory");
}
constexpr int IT_IN = 16 * 112, IT_G = 16 * 96, IT_PA = 6 * 32, IT_PB = 4 * 32, IT_PC = 6 * 32, IT_O = 16 * 32, IT_GU = 16 * 176, IT_D = 44 * 32;
constexpr int IT_LAYER = IT_IN + IT_G + IT_PA + IT_PB + IT_PC + IT_O + IT_GU + IT_D;
__device__ __forceinline__ void prologue_item(CArgs a, int it, LAS float* scr, int lane) {
    const int l = it / IT_LAYER; int r = it % IT_LAYER;
    bf16_t* WL = (bf16_t*)(a->ws + WS_W) + (size_t)l * W_LAYER;
    if (r < IT_IN) { const int kb = r / 112, nb = r % 112, k0 = 64 * kb, n0 = 32 * nb, c0 = n0 < 1152 ? n0 : n0 + 6;
        transpose_item(a->in[3] + (size_t)l * 1024 * DIN + (size_t)k0 * DIN + c0, DIN, WL + W_IN + (size_t)n0 * 1024 + k0, 1024, scr, lane); return; } r -= IT_IN;
    if (r < IT_G) { const int kb = r / 96, nb = r % 96, k0 = 64 * kb, n0 = 32 * nb, c0 = 3590 + n0;
        transpose_item(a->in[3] + (size_t)l * 1024 * DIN + (size_t)k0 * DIN + c0, DIN, WL + W_G + (size_t)n0 * 1024 + k0, 1024, scr, lane); return; } r -= IT_G;
    if (r < IT_PA) { const int kb = r / 32, nb = r % 32, k0 = 64 * kb, n0 = 32 * nb;
        transpose_item(a->in[5] + (size_t)l * 384 * 1024 + (size_t)k0 * 1024 + n0, 1024, WL + W_PA + (size_t)n0 * 384 + k0, 384, scr, lane); return; } r -= IT_PA;
    if (r < IT_PB) { const int kb = r / 32, nb = r % 32, k0 = 64 * kb, n0 = 32 * nb;
        transpose_item(a->in[6] + (size_t)l * 256 * 1024 + (size_t)k0 * 1024 + n0, 1024, WL + W_PB + (size_t)n0 * 256 + k0, 256, scr, lane); return; } r -= IT_PB;
    if (r < IT_PC) { const int kb = r / 32, nb = r % 32, k0 = 64 * kb, n0 = 32 * nb;
        transpose_item(a->in[7] + (size_t)l * 384 * 1024 + (size_t)k0 * 1024 + n0, 1024, WL + W_PC + (size_t)n0 * 384 + k0, 384, scr, lane); return; } r -= IT_PC;
    if (r < IT_O) { const int kb = r / 32, nb = r % 32, k0 = 64 * kb, n0 = 32 * nb;
        transpose_item(a->in[8] + (size_t)l * 1024 * 1024 + (size_t)k0 * 1024 + n0, 1024, WL + W_O + (size_t)n0 * 1024 + k0, 1024, scr, lane); return; } r -= IT_O;
    if (r < IT_GU) { const int kb = r / 176, nb = r % 176, k0 = 64 * kb, n0 = 32 * nb, pn = n0 >> 8, w = n0 & 255;
        const float* src = (w < 128) ? (a->in[11] + (size_t)l * 1024 * DFF + (size_t)k0 * DFF + 128 * pn + w) : (a->in[12] + (size_t)l * 1024 * DFF + (size_t)k0 * DFF + 128 * pn + (w - 128));
        transpose_item(src, DFF, WL + W_GU + (size_t)n0 * 1024 + k0, 1024, scr, lane); return; } r -= IT_GU;
    { const int kb = r / 32, nb = r % 32, k0 = 64 * kb, n0 = 32 * nb;
        transpose_item(a->in[13] + (size_t)l * DFF * 1024 + (size_t)k0 * 1024 + n0, 1024, WL + W_D + (size_t)n0 * DFF + k0, DFF, scr, lane); }
}

__device__ __forceinline__ void ln_phase(const float* src, const float* gam, const float* bet, float* XF, bf16_t* XB,
                                         const float* wfa, const float* bfl, float* LF, LAS unsigned char* lds, int tid, int lane, int wave) {
    asm volatile("" : "+v"(tid), "+v"(lane));
    LAS float* wl = (LAS float*)lds;
    if (wfa) { for (int i = tid; i < 6144; i += NWAVES * 64) { const int h = i % 6, k = i / 6; wl[h * 1024 + k] = wfa[(size_t)k * DIN + 1152 + h]; } }
    __syncthreads();
    f32x4 g4[4], b4[4];
#pragma unroll
    for (int j = 0; j < 4; ++j) { g4[j] = *(const f32x4*)(gam + 4 * lane + 256 * j); b4[j] = *(const f32x4*)(bet + 4 * lane + 256 * j); }
    for (int row = blockIdx.x * NWAVES + wave; row < T; row += gridDim.x * NWAVES) {
        const f32x4* xr = (const f32x4*)(src + (size_t)row * DM) + lane;
        f32x4 v[4]; float s = 0.f;
#pragma unroll
        for (int j = 0; j < 4; ++j) { v[j] = xr[64 * j]; s += (v[j].x + v[j].y) + (v[j].z + v[j].w); }
        const float mean = wave_sum(s) * (1.f / DM); float s2 = 0.f;
#pragma unroll
        for (int j = 0; j < 4; ++j) { v[j] = v[j] - mean; s2 += (v[j].x * v[j].x + v[j].y * v[j].y) + (v[j].z * v[j].z + v[j].w * v[j].w); }
        const float rstd = 1.f / sqrtf(wave_sum(s2) * (1.f / DM) + LN_EPS);
        f32x4* of = (f32x4*)(XF + (size_t)row * DM) + lane; u32x2* ob = (u32x2*)(XB + (size_t)row * DM) + lane;
#pragma unroll
        for (int j = 0; j < 4; ++j) { v[j] = v[j] * rstd * g4[j] + b4[j]; of[64 * j] = v[j]; u32x2 w; w.x = cvt_pk_bf16(v[j].x, v[j].y); w.y = cvt_pk_bf16(v[j].z, v[j].w); ob[64 * j] = w; }
        if (wfa) {
            float d[6];
#pragma unroll
            for (int h = 0; h < 6; ++h) { float acc = 0.f;
#pragma unroll
                for (int j = 0; j < 4; ++j) { const f32x4 w = *(const LAS f32x4*)(wl + h * 1024 + 4 * lane + 256 * j); acc += (v[j].x * w.x + v[j].y * w.y) + (v[j].z * w.z + v[j].w * w.w); }
                d[h] = wave_sum(acc); }
            if (lane < 6) { float z = d[0];
#pragma unroll
                for (int h = 1; h < 6; ++h) z = (lane == h) ? d[h] : z;
                z += bfl[lane];
                const float ls = fminf(z, 0.f) - log1pf(expf(-fabsf(z)));
                const int b = row / SEQ, sidx = row % SEQ; LF[(size_t)(b * 6 + lane) * SEQ + sidx] = ls; }
        }
    }
    __syncthreads();
}

__device__ __forceinline__ void scan_bh(const float* lf, float* cum, LAS unsigned char* lds, int tid, int lane, int wave) {
    asm volatile("" : "+v"(tid), "+v"(lane));
    LAS float* ws = (LAS float*)lds;
    f32x4 v[8]; const f32x4* p = (const f32x4*)(lf + tid * 32);
#pragma unroll
    for (int j = 0; j < 8; ++j) v[j] = p[j];
    float run = 0.f;
#pragma unroll
    for (int j = 0; j < 8; ++j) { run += v[j].x; v[j].x = run; run += v[j].y; v[j].y = run; run += v[j].z; v[j].z = run; run += v[j].w; v[j].w = run; }
    float inc = run;
#pragma unroll
    for (int o = 1; o < 64; o <<= 1) { const float t = __shfl_up(inc, o); if (lane >= o) inc += t; }
    if (lane == 63) ws[wave] = inc;
    __syncthreads();
    float base = inc - run;
    for (int w = 0; w < wave; ++w) base += ws[w];
    f32x4* q = (f32x4*)(cum + tid * 32);
#pragma unroll
    for (int j = 0; j < 8; ++j) q[j] = v[j] + base;
    __syncthreads();
}

__device__ __forceinline__ float sigmoidf_(float x) { return __builtin_amdgcn_rcpf(1.f + __builtin_amdgcn_exp2f(-x * LOG2E)); }

struct EpiInproj {
    static constexpr bool PERM = true;
    unsigned char* ws; const f32x2* rope; int* kmean;
    __device__ __forceinline__ void operator()(const f32x4 (&acc)[2][2][4][2], const pg8::Unit& u, int wr, int wc, int fr, int fq) const {
        const int row0 = u.pm * 256 + wr * 64 + fr;
#pragma unroll
        for (int bj = 0; bj < 2; ++bj) {
            const int cb = 2 * u.pn + bj;
            size_t base; int pitch, c0; bool rope_on = false, km = false; float sc = 1.f;
            if (cb < 3) { base = WS_QA; pitch = 384; c0 = cb * 128; sc = C2; }
            else if (cb < 6) { base = WS_KA; pitch = 384; c0 = (cb - 3) * 128; }
            else if (cb < 9) { base = WS_VA; pitch = 384; c0 = (cb - 6) * 128; }
            else if (cb < 15) { base = WS_QB; pitch = 768; c0 = (cb - 9) * 128; rope_on = true; sc = C2; }
            else if (cb < 17) { base = WS_KB; pitch = 256; c0 = (cb - 15) * 128; rope_on = true; }
            else if (cb < 19) { base = WS_VB; pitch = 256; c0 = (cb - 17) * 128; }
            else if (cb < 22) { base = WS_QC; pitch = 384; c0 = (cb - 19) * 128; rope_on = true; sc = C2; }
            else if (cb < 25) { base = WS_KC; pitch = 384; c0 = (cb - 22) * 128; rope_on = true; km = true; }
            else { base = WS_VC; pitch = 384; c0 = (cb - 25) * 128; }
            bf16_t* dst = (bf16_t*)(ws + base);
            const int colw = c0 + wc * 32 + 8 * fq;
            const bool rl = rope_on && ((wc & 1) == 0) && (fq < 2);
            float ks[8];
#pragma unroll
            for (int i = 0; i < 8; ++i) ks[i] = 0.f;
#pragma unroll
            for (int ai = 0; ai < 2; ++ai)
#pragma unroll
                for (int m = 0; m < 4; ++m) {
                    const int row = row0 + ai * 128 + m * 16;
                    f32x4 v0 = acc[ai][bj][m][0], v1 = acc[ai][bj][m][1];
                    if (rope_on) {
                        float own[8] = {v0.x, v0.y, v0.z, v0.w, v1.x, v1.y, v1.z, v1.w}, oth[8];
#pragma unroll
                        for (int i = 0; i < 8; ++i) oth[i] = __shfl_xor(own[i], 16);
                        if (rl) {
                            const f32x2* rp = rope + (size_t)(row % SEQ) * 8;
                            const float sg = (fq == 0) ? -1.f : 1.f;
#pragma unroll
                            for (int i = 0; i < 8; ++i) { const f32x2 cs = rp[i]; own[i] = own[i] * cs.x + sg * oth[i] * cs.y; }
                            v0 = (f32x4){own[0], own[1], own[2], own[3]}; v1 = (f32x4){own[4], own[5], own[6], own[7]};
                        }
                    }
                    if (km) { ks[0] += v0.x; ks[1] += v0.y; ks[2] += v0.z; ks[3] += v0.w; ks[4] += v1.x; ks[5] += v1.y; ks[6] += v1.z; ks[7] += v1.w; }
                    v0 = v0 * sc; v1 = v1 * sc;
                    u32x4 w; w.x = cvt_pk_bf16(v0.x, v0.y); w.y = cvt_pk_bf16(v0.z, v0.w); w.z = cvt_pk_bf16(v1.x, v1.y); w.w = cvt_pk_bf16(v1.z, v1.w);
                    *(u32x4*)(dst + (size_t)row * pitch + colw) = w;
                }
            if (km) {
#pragma unroll
                for (int i = 0; i < 8; ++i) { float s = ks[i]; s += __shfl_xor(s, 1); s += __shfl_xor(s, 2); s += __shfl_xor(s, 4); s += __shfl_xor(s, 8); ks[i] = s; }
                if (fr == 0) { const int b = u.pm >> 6, blk = u.pm & 63;
#pragma unroll
                    for (int i = 0; i < 8; ++i) { const int col = colw + i; atomicAdd(kmean + ((size_t)((b * 6 + (col >> 6)) * 64 + blk)) * 64 + (col & 63), __float2int_rn(ks[i] * 262144.f)); } }
            }
        }
    }
};

struct EpiSwiglu {
    static constexpr bool PERM = true;
    bf16_t* H;
    __device__ __forceinline__ void operator()(const f32x4 (&acc)[2][2][4][2], const pg8::Unit& u, int wr, int wc, int fr, int fq) const {
        const int row0 = u.pm * 256 + wr * 64 + fr, col0 = u.pn * 128 + wc * 32 + 8 * fq;
#pragma unroll
        for (int ai = 0; ai < 2; ++ai)
#pragma unroll
            for (int m = 0; m < 4; ++m) {
                float h[8];
#pragma unroll
                for (int n = 0; n < 2; ++n)
#pragma unroll
                    for (int i = 0; i < 4; ++i) { const float g = acc[ai][0][m][n][i], up = acc[ai][1][m][n][i]; h[4 * n + i] = g * sigmoidf_(g) * up; }
                u32x4 w; w.x = cvt_pk_bf16(h[0], h[1]); w.y = cvt_pk_bf16(h[2], h[3]); w.z = cvt_pk_bf16(h[4], h[5]); w.w = cvt_pk_bf16(h[6], h[7]);
                *(u32x4*)(H + (size_t)(row0 + ai * 128 + m * 16) * DFF + col0) = w;
                asm volatile("" ::: "memory");
            }
    }
};

struct EpiResid {
    static constexpr bool PERM = true;
    float* X;
    __device__ __forceinline__ void operator()(const f32x4 (&acc)[2][2][4][2], const pg8::Unit& u, int wr, int wc, int fr, int fq) const {
        const int row0 = u.pm * 256 + wr * 64 + fr, col0 = u.pn * 256 + wc * 32 + 8 * fq;
#pragma unroll
        for (int ai = 0; ai < 2; ++ai)
#pragma unroll
            for (int m = 0; m < 4; ++m)
#pragma unroll
                for (int bj = 0; bj < 2; ++bj) {
                    float* p = X + (size_t)(row0 + ai * 128 + m * 16) * DM + col0 + bj * 128;
                    const f32x4 a = *(const f32x4*)p, b = *(const f32x4*)(p + 4);
                    *(f32x4*)p = a * DN_ALPHA + acc[ai][bj][m][0]; *(f32x4*)(p + 4) = b * DN_ALPHA + acc[ai][bj][m][1];
                    asm volatile("" ::: "memory");
                }
    }
};

struct EpiGate {
    static constexpr bool PERM = true;
    bf16_t* GS;
    __device__ __forceinline__ void operator()(const f32x4 (&acc)[2][2][4][2], const pg8::Unit& u, int wr, int wc, int fr, int fq) const {
        const int row0 = u.pm * 256 + wr * 64 + fr, col0 = u.pn * 256 + wc * 32 + 8 * fq;
#pragma unroll
        for (int ai = 0; ai < 2; ++ai)
#pragma unroll
            for (int m = 0; m < 4; ++m)
#pragma unroll
                for (int bj = 0; bj < 2; ++bj) {
                    const f32x4 a = acc[ai][bj][m][0], b = acc[ai][bj][m][1];
                    u32x4 w; w.x = cvt_pk_bf16(sigmoidf_(a.x), sigmoidf_(a.y)); w.y = cvt_pk_bf16(sigmoidf_(a.z), sigmoidf_(a.w));
                    w.z = cvt_pk_bf16(sigmoidf_(b.x), sigmoidf_(b.y)); w.w = cvt_pk_bf16(sigmoidf_(b.z), sigmoidf_(b.w));
                    *(u32x4*)(GS + (size_t)(row0 + ai * 128 + m * 16) * DM + col0 + bj * 128) = w;
                }
    }
};

template <int FIRST> struct EpiBranch {
    static constexpr bool PERM = true;
    const bf16_t* GS; bf16_t* MG;
    __device__ __forceinline__ void operator()(const f32x4 (&acc)[2][2][4][2], const pg8::Unit& u, int wr, int wc, int fr, int fq) const {
        const int row0 = u.pm * 256 + wr * 64 + fr, col0 = u.pn * 256 + wc * 32 + 8 * fq;
#pragma unroll
        for (int ai = 0; ai < 2; ++ai)
#pragma unroll
            for (int m = 0; m < 4; ++m)
#pragma unroll
                for (int bj = 0; bj < 2; ++bj) {
                    const size_t off = (size_t)(row0 + ai * 128 + m * 16) * DM + col0 + bj * 128;
                    const u32x4 gw = *(const u32x4*)(GS + off);
                    const f32x4 a = acc[ai][bj][m][0], b = acc[ai][bj][m][1];
                    float r[8] = {bflo(gw.x) * a.x, bfhi(gw.x) * a.y, bflo(gw.y) * a.z, bfhi(gw.y) * a.w, bflo(gw.z) * b.x, bfhi(gw.z) * b.y, bflo(gw.w) * b.z, bfhi(gw.w) * b.w};
                    if (!FIRST) { const u32x4 mw = *(const u32x4*)(MG + off);
                        r[0] += bflo(mw.x); r[1] += bfhi(mw.x); r[2] += bflo(mw.y); r[3] += bfhi(mw.y); r[4] += bflo(mw.z); r[5] += bfhi(mw.z); r[6] += bflo(mw.w); r[7] += bfhi(mw.w); }
                    u32x4 w; w.x = cvt_pk_bf16(r[0], r[1]); w.y = cvt_pk_bf16(r[2], r[3]); w.z = cvt_pk_bf16(r[4], r[5]); w.w = cvt_pk_bf16(r[6], r[7]);
                    *(u32x4*)(MG + off) = w;
                    asm volatile("" ::: "memory");
                }
    }
};

typedef short v4i16_t __attribute__((ext_vector_type(4)));
__device__ __forceinline__ int crow(int r, int hi) { return (r & 3) + 8 * (r >> 2) + 4 * hi; }
__device__ __forceinline__ float half_max(float m) { auto rr = __builtin_amdgcn_permlane32_swap(__float_as_uint(m), __float_as_uint(m), false, false); return fmaxf(__uint_as_float(rr[0]), __uint_as_float(rr[1])); }
__device__ __forceinline__ float half_sum(float m) { auto rr = __builtin_amdgcn_permlane32_swap(__float_as_uint(m), __float_as_uint(m), false, false); return __uint_as_float(rr[0]) + __uint_as_float(rr[1]); }

__device__ __forceinline__ void small_attn(const bf16_t* qrow, int ntiles, const bf16_t* Kb, const bf16_t* Vb, int pitch,
                                           int kc0, int kstride, int koff, int qc, int span, LAS unsigned char* vscr, int lane,
                                           f32x16 (&o)[2], float& lse2, const float* cumb = nullptr) {
    asm volatile("" : "+v"(lane));
    const int r32 = lane & 31, hi = lane >> 5;
    bf16x8 qr[4];
#pragma unroll
    for (int d0 = 0; d0 < 4; ++d0) qr[d0] = *(const bf16x8*)(qrow + d0 * 16 + hi * 8);
    o[0] = f32x16{}; o[1] = f32x16{};
    float m = -1e30f, l = 0.f;
    const int lr = lane >> 3, lc = lane & 7;
    LAS unsigned char* kscr = vscr + 4608;
    LAS unsigned char* kw = kscr + lr * 144 + lc * 16;
    LAS unsigned char* vw = vscr + lr * 144 + lc * 16;
    const LAS unsigned char* kfr = kscr + r32 * 144 + 16 * hi;
    const LAS unsigned char* vt = vscr + (4 * hi + ((lane & 15) >> 2)) * 144 + (16 * ((lane >> 4) & 1) + 4 * (lane & 3)) * 2;
#define SA_LOAD(KF, VV, tt) do { const int t_ = (tt) < ntiles ? (tt) : ntiles - 1; \
        _Pragma("unroll") for (int i_ = 0; i_ < 4; ++i_) { const int kk_ = kc0 + 32 * t_ + lr + 8 * i_; const size_t off_ = (size_t)((kk_ < 0 ? 0 : kk_) * kstride + koff) * pitch + 8 * lc; \
            KF[i_] = *(const bf16x8*)(Kb + off_); VV[i_] = *(const bf16x8*)(Vb + off_); } \
        __builtin_amdgcn_sched_barrier(0); } while (0)
#define SA_COMPUTE(KF, VV, tt) do { \
        _Pragma("unroll") for (int i_ = 0; i_ < 4; ++i_) { *(LAS bf16x8*)(kw + 8 * 144 * i_) = KF[i_]; *(LAS bf16x8*)(vw + 8 * 144 * i_) = VV[i_]; } \
        f32x16 p = f32x16{}; \
        _Pragma("unroll") for (int d0 = 0; d0 < 4; ++d0) { const bf16x8 kf_ = *(const LAS bf16x8*)(kfr + 32 * d0); p = __builtin_amdgcn_mfma_f32_32x32x16_bf16(kf_, qr[d0], p, 0, 0, 0); } \
        const int kcb = kc0 + 32 * (tt); float rm = -INFINITY; \
        _Pragma("unroll") for (int r = 0; r < 16; ++r) { const int kc = kcb + crow(r, hi); const bool ok = (kc >= 0) && (kc <= qc) && (qc - kc <= span); \
            if (cumb) p[r] -= cumb[kc < 0 ? 0 : kc] * LOG2E; \
            p[r] = ok ? p[r] : -INFINITY; rm = fmaxf(rm, p[r]); } \
        rm = half_max(rm); \
        const float mn = fmaxf(m, rm); const float f = __builtin_amdgcn_exp2f(m - mn); m = mn; \
        float ls = 0.f; \
        _Pragma("unroll") for (int r = 0; r < 16; ++r) { p[r] = __builtin_amdgcn_exp2f(p[r] - mn); ls += p[r]; } \
        l = l * f + ls; \
        _Pragma("unroll") for (int r = 0; r < 16; ++r) { o[0][r] *= f; o[1][r] *= f; } \
        u32x4 pw0, pw1; \
        pw0.x = cvt_pk_bf16(p[0], p[1]); pw0.y = cvt_pk_bf16(p[2], p[3]); pw0.z = cvt_pk_bf16(p[4], p[5]); pw0.w = cvt_pk_bf16(p[6], p[7]); \
        pw1.x = cvt_pk_bf16(p[8], p[9]); pw1.y = cvt_pk_bf16(p[10], p[11]); pw1.z = cvt_pk_bf16(p[12], p[13]); pw1.w = cvt_pk_bf16(p[14], p[15]); \
        const bf16x8 pb0 = __builtin_bit_cast(bf16x8, pw0), pb1 = __builtin_bit_cast(bf16x8, pw1); \
        _Pragma("unroll") for (int d0 = 0; d0 < 2; ++d0) { \
            _Pragma("unroll") for (int s_ = 0; s_ < 2; ++s_) { \
                const v4i16_t lo = __builtin_amdgcn_ds_read_tr16_b64_v4i16((LAS v4i16_t*)(vt + (16 * s_) * 144 + d0 * 64)); \
                const v4i16_t hh = __builtin_amdgcn_ds_read_tr16_b64_v4i16((LAS v4i16_t*)(vt + (16 * s_ + 8) * 144 + d0 * 64)); \
                const bf16x8 vf = (bf16x8){lo[0], lo[1], lo[2], lo[3], hh[0], hh[1], hh[2], hh[3]}; \
                o[d0] = __builtin_amdgcn_mfma_f32_32x32x16_bf16(vf, s_ == 0 ? pb0 : pb1, o[d0], 0, 0, 0); } } \
    } while (0)
    bf16x8 kA[4], vA[4], kB[4], vB[4], kC[4], vC[4];
    SA_LOAD(kA, vA, 0); SA_LOAD(kB, vB, 1);
    for (int t = 0; t < ntiles; t += 3) {
        SA_LOAD(kC, vC, t + 2); SA_COMPUTE(kA, vA, t);
        if (t + 1 >= ntiles) break;
        SA_LOAD(kA, vA, t + 3); SA_COMPUTE(kB, vB, t + 1);
        if (t + 2 >= ntiles) break;
        SA_LOAD(kB, vB, t + 4); SA_COMPUTE(kC, vC, t + 2);
    }
#undef SA_LOAD
#undef SA_COMPUTE
    l = half_sum(l);
    const float rl = 1.f / l;
#pragma unroll
    for (int r = 0; r < 16; ++r) { o[0][r] *= rl; o[1][r] *= rl; }
    lse2 = m + __builtin_amdgcn_logf(l);
}
__device__ __forceinline__ void small_store(bf16_t* orow, const f32x16 (&o)[2], int hi) {
#pragma unroll
    for (int d0 = 0; d0 < 2; ++d0)
#pragma unroll
        for (int g = 0; g < 4; ++g) { u32x2 w; w.x = cvt_pk_bf16(o[d0][4 * g], o[d0][4 * g + 1]); w.y = cvt_pk_bf16(o[d0][4 * g + 2], o[d0][4 * g + 3]);
            *(u32x2*)(orow + 32 * d0 + 8 * g + 4 * hi) = w; }
}

__device__ __forceinline__ void gating_phase(CArgs a, int layer, LAS unsigned char* lds, int tid) {
    asm volatile("" : "+v"(tid));
    unsigned* ctl = (unsigned*)(a->ws + WS_CTL);
    const int* kmean = (const int*)(ctl + CW_KMEAN + 49152 * layer);
    unsigned* cnt = ctl + CW_CNT + 1024 * layer;
    unsigned* list = (unsigned*)(a->ws + WS_LIST);
    const bf16_t* QC = (const bf16_t*)(a->ws + WS_QC);
    const int half = tid >> 8, ht = tid & 255;
    LAS float* km = (LAS float*)(lds + half * 16384);
    for (int u0 = 0; u0 < 768; u0 += 2 * (int)gridDim.x) {
        const int u = u0 + 2 * (int)blockIdx.x + half; const bool active = u < 768;
        const int bh = active ? (u >> 6) : 0, ob = active ? (u & 63) : 0;
        for (int i = ht; i < ob * 64; i += 256) km[i] = (float)kmean[bh * 4096 + i] * (1.f / 262144.f);
        __syncthreads();
        if (active && ob > 0) {
            const int b = bh / 6, h = bh % 6, t = ob * 256 + ht;
            const u32x4* qp = (const u32x4*)(QC + ((size_t)(b * SEQ + t)) * 384 + h * 64);
            float q[64];
#pragma unroll
            for (int i = 0; i < 8; ++i) { const u32x4 w = qp[i]; q[8 * i] = bflo(w.x); q[8 * i + 1] = bfhi(w.x); q[8 * i + 2] = bflo(w.y); q[8 * i + 3] = bfhi(w.y);
                q[8 * i + 4] = bflo(w.z); q[8 * i + 5] = bfhi(w.z); q[8 * i + 6] = bflo(w.w); q[8 * i + 7] = bfhi(w.w); }
            float v0 = -INFINITY, v1 = -INFINITY, v2 = -INFINITY; int i0 = 0, i1 = 0, i2 = 0;
            for (int n = 0; n < ob; ++n) {
                float d0 = 0.f, d1 = 0.f;
#pragma unroll
                for (int j = 0; j < 16; j += 2) { const f32x4 ka = *(const LAS f32x4*)(km + n * 64 + 4 * j), kb = *(const LAS f32x4*)(km + n * 64 + 4 * j + 4);
                    d0 += (q[4 * j] * ka.x + q[4 * j + 1] * ka.y) + (q[4 * j + 2] * ka.z + q[4 * j + 3] * ka.w);
                    d1 += (q[4 * j + 4] * kb.x + q[4 * j + 5] * kb.y) + (q[4 * j + 6] * kb.z + q[4 * j + 7] * kb.w); }
                const float dot = d0 + d1;
                if (dot > v2) {
                    if (dot > v1) { v2 = v1; i2 = i1; if (dot > v0) { v1 = v0; i1 = i0; v0 = dot; i0 = n; } else { v1 = dot; i1 = n; } }
                    else { v2 = dot; i2 = n; }
                }
            }
            const int nsel = ob < 3 ? ob : 3;
#pragma unroll
            for (int j = 0; j < 3; ++j) if (j < nsel) { const int n = (j == 0) ? i0 : (j == 1) ? i1 : i2;
                const unsigned pos = atomicAdd(cnt + bh * 64 + n, 1u);
                list[list_off(bh, n) + pos] = ((unsigned)t << 2) | (unsigned)j; }
        }
        __syncthreads();
    }
}

constexpr int NU_FOX = 768, NU_SEL = 768, NU_OWN = 384, NU_DIL = 1536, NU_TOTAL = NU_FOX + NU_SEL + NU_OWN + NU_DIL;
__device__ __forceinline__ void attention_phase(CArgs a, int layer, LAS unsigned char* lds, char* lds_gen, int tid, int lane, int wave) {
    asm volatile("" : "+v"(tid), "+v"(lane));
    unsigned* ctl = (unsigned*)(a->ws + WS_CTL);
    unsigned* qctr = ctl + CW_QCTR + 64 * layer;
    const unsigned* cnt = ctl + CW_CNT + 1024 * layer;
    const unsigned* list = (const unsigned*)(a->ws + WS_LIST);
    volatile LAS unsigned* qw = (volatile LAS unsigned*)(lds + LDS_QW);
    LAS unsigned char* vscr = lds + wave * 9216;
    bf16_t* QCp = (bf16_t*)(a->ws + WS_QC); const bf16_t* KCp = (const bf16_t*)(a->ws + WS_KC); const bf16_t* VCp = (const bf16_t*)(a->ws + WS_VC);
    bf16_t* PO = (bf16_t*)(a->ws + WS_PO); float* PLSE = (float*)(a->ws + WS_PLSE);
    for (;;) {
        __syncthreads();
        if (tid == 0) *qw = atomicAdd(qctr, 1u);
        __syncthreads();
        const int u = (int)*qw;
        if (u >= NU_TOTAL) break;
        int lane_ = lane; asm volatile("" : "+v"(lane_)); const int r32 = lane_ & 31, hi = lane_ >> 5;
        if (u < NU_FOX) {
            const int qb = 63 - u / 12, bh = u % 12, b = bh / 6, h = bh % 6;
#ifdef FOX_SIMPLE
            {   const int t = 256 * qb + 32 * wave + r32; const size_t tok = (size_t)(b * SEQ + t);
                bf16_t* qrow = (bf16_t*)(a->ws + WS_QA) + tok * 384 + h * 64;
                const bf16_t* Kb = (const bf16_t*)(a->ws + WS_KA) + (size_t)(b * SEQ) * 384 + h * 64; const bf16_t* Vb = (const bf16_t*)(a->ws + WS_VA) + (size_t)(b * SEQ) * 384 + h * 64;
                f32x16 o[2]; float lse2;
                small_attn(qrow, 8 * qb + wave + 1, Kb, Vb, 384, 0, 1, 0, t, 1 << 29, vscr, lane, o, lse2, (const float*)(a->ws + WS_CUM) + (size_t)bh * SEQ);
                small_store(qrow, o, hi); }
#elif !defined(NO_FOX)
#ifdef PROBE_FOX2
            attn_body::attn_unit<24>(b, h, qb, (const attn_body::bf16*)(a->ws + WS_QA), (const attn_body::bf16*)(a->ws + WS_KA), (const attn_body::bf16*)(a->ws + WS_VA),
                                    (attn_body::bf16*)(a->ws + 487 * MiB), (const float*)(a->ws + WS_CUM) + (size_t)bh * SEQ, lds_gen);
#endif
            attn_body::attn_unit<24>(b, h, qb, (const attn_body::bf16*)(a->ws + WS_QA), (const attn_body::bf16*)(a->ws + WS_KA), (const attn_body::bf16*)(a->ws + WS_VA),
                                    (attn_body::bf16*)(a->ws + WS_QA), (const float*)(a->ws + WS_CUM) + (size_t)bh * SEQ, lds_gen);
#endif
        } else if (u < NU_FOX + NU_SEL) {
            const int v = u - NU_FOX, n = v / 12, bh = v % 12, b = bh / 6, h = bh % 6;
            int cn = (int)cnt[bh * 64 + n]; const int cap = (63 - n) * 256; cn = cn < cap ? cn : cap;
            const unsigned* lp = list + list_off(bh, n);
            const bf16_t* Kb = KCp + (size_t)(b * SEQ) * 384 + h * 64; const bf16_t* Vb = VCp + (size_t)(b * SEQ) * 384 + h * 64;
#ifdef PROBE_SMALL2
            for (int rep_ = 0; rep_ < 2; ++rep_)
#endif
            for (int c = wave; c * 32 < cn; c += NWAVES) {
                const int e = c * 32 + r32; const bool valid = e < cn;
                const unsigned ent = lp[valid ? e : 0];
                const int t = (int)(ent >> 2), slot = (int)(ent & 3);
                const size_t tok = (size_t)(b * SEQ + t);
                f32x16 o[2]; float lse2;
                small_attn(QCp + tok * 384 + h * 64, 8, Kb, Vb, 384, 0, 1, 256 * n, 1 << 28, 1 << 29, vscr, lane, o, lse2);
                if (valid) { small_store(PO + ((tok * 6 + h) * 4 + slot) * 64, o, hi); if (hi == 0) PLSE[(tok * 6 + h) * 4 + slot] = lse2; }
            }
        } else if (u < NU_FOX + NU_SEL + NU_OWN) {
            const int v = u - NU_FOX - NU_SEL, bh = v / 32, pr = v % 32, b = bh / 6, h = bh % 6;
            const bf16_t* Kb = KCp + (size_t)(b * SEQ) * 384 + h * 64; const bf16_t* Vb = VCp + (size_t)(b * SEQ) * 384 + h * 64;
#ifdef PROBE_SMALL2
            for (int rep_ = 0; rep_ < 2; ++rep_)
#endif
            for (int s = 0; s < 2; ++s) {
                const int blk = 2 * pr + s, ch = s == 0 ? wave : 7 - wave;
                const int t = 256 * blk + 32 * ch + r32; const size_t tok = (size_t)(b * SEQ + t);
                f32x16 o[2]; float lse2;
                small_attn(QCp + tok * 384 + h * 64, ch + 1, Kb, Vb, 384, 0, 1, 256 * blk, 32 * ch + r32, 1 << 29, vscr, lane, o, lse2);
                small_store(PO + ((tok * 6 + h) * 4 + 3) * 64, o, hi); if (hi == 0) PLSE[(tok * 6 + h) * 4 + 3] = lse2;
            }
        } else {
            const int v = u - NU_FOX - NU_SEL - NU_OWN, wu = v * NWAVES + wave;
            const int c512 = wu & 511, rest = wu >> 9, kvh = rest & 3, g = (rest >> 2) % 3, b = rest / 12;
            const int dil = g == 0 ? 1 : (g == 1 ? 4 : 16), cpc = 512 / dil;
            const int res = c512 / cpc, cidx = c512 % cpc, qc0 = 32 * cidx, qc = qc0 + r32, tq = qc * dil + res;
            const size_t tok = (size_t)(b * SEQ + tq);
            bf16_t* qrow = (bf16_t*)(a->ws + WS_QB) + tok * 768 + (g * 4 + kvh) * 64;
            const bf16_t* Kb = (const bf16_t*)(a->ws + WS_KB) + (size_t)(b * SEQ) * 256 + kvh * 64; const bf16_t* Vb = (const bf16_t*)(a->ws + WS_VB) + (size_t)(b * SEQ) * 256 + kvh * 64;
            f32x16 o[2]; float lse2;
            small_attn(qrow, 5, Kb, Vb, 256, qc0 - 128, dil, res, qc, 128, vscr, lane, o, lse2);
            small_store(qrow, o, hi);
            if (hi == 0) ((float*)(a->ws + WS_LSEB))[((size_t)g * T + tok) * 4 + kvh] = lse2;
        }
    }
}

__device__ __forceinline__ void combine_phase(CArgs a, int tid) {
    asm volatile("" : "+v"(tid));
    const size_t gt = (size_t)blockIdx.x * (NWAVES * 64) + tid, gs = (size_t)gridDim.x * (NWAVES * 64);
    bf16_t* QBp = (bf16_t*)(a->ws + WS_QB); const float* LSEB = (const float*)(a->ws + WS_LSEB);
    for (size_t i = gt; i < (size_t)T * 32; i += gs) {
        const int ch = (int)(i & 7), kvh = (int)((i >> 3) & 3); const size_t tok = i >> 5;
        float l[3], w[3];
#pragma unroll
        for (int g = 0; g < 3; ++g) l[g] = LSEB[((size_t)g * T + tok) * 4 + kvh];
        const float mx = fmaxf(l[0], fmaxf(l[1], l[2]));
        float ws_ = 0.f;
#pragma unroll
        for (int g = 0; g < 3; ++g) { w[g] = __builtin_amdgcn_exp2f(l[g] - mx); ws_ += w[g]; }
        const float inv = 1.f / ws_;
        float y[8] = {0.f, 0.f, 0.f, 0.f, 0.f, 0.f, 0.f, 0.f};
#pragma unroll
        for (int g = 0; g < 3; ++g) { const u32x4 ow = *(const u32x4*)(QBp + tok * 768 + (g * 4 + kvh) * 64 + ch * 8); const float wg = w[g] * inv;
            y[0] += wg * bflo(ow.x); y[1] += wg * bfhi(ow.x); y[2] += wg * bflo(ow.y); y[3] += wg * bfhi(ow.y); y[4] += wg * bflo(ow.z); y[5] += wg * bfhi(ow.z); y[6] += wg * bflo(ow.w); y[7] += wg * bfhi(ow.w); }
        u32x4 r; r.x = cvt_pk_bf16(y[0], y[1]); r.y = cvt_pk_bf16(y[2], y[3]); r.z = cvt_pk_bf16(y[4], y[5]); r.w = cvt_pk_bf16(y[6], y[7]);
        *(u32x4*)(QBp + tok * 768 + kvh * 64 + ch * 8) = r;
    }
    bf16_t* QCp = (bf16_t*)(a->ws + WS_QC); const bf16_t* PO = (const bf16_t*)(a->ws + WS_PO); const float* PLSE = (const float*)(a->ws + WS_PLSE);
    for (size_t i = gt; i < (size_t)T * 48; i += gs) {
        const int ch = (int)(i & 7); const size_t th = i >> 3; const int h = (int)(th % 6); const size_t tok = th / 6;
        const int ob = (int)((tok % SEQ) >> 8), nsel = ob < 3 ? ob : 3;
        float l[4], w[4];
#pragma unroll
        for (int j = 0; j < 4; ++j) l[j] = (j == 3 || j < nsel) ? PLSE[th * 4 + j] : -INFINITY;
        const float mx = fmaxf(fmaxf(l[0], l[1]), fmaxf(l[2], l[3]));
        float ws_ = 0.f;
#pragma unroll
        for (int j = 0; j < 4; ++j) { w[j] = __builtin_amdgcn_exp2f(l[j] - mx); ws_ += w[j]; }
        const float inv = 1.f / ws_;
        float y[8] = {0.f, 0.f, 0.f, 0.f, 0.f, 0.f, 0.f, 0.f};
#pragma unroll
        for (int j = 0; j < 4; ++j) if (j == 3 || j < nsel) { const u32x4 ow = *(const u32x4*)(PO + (th * 4 + j) * 64 + ch * 8); const float wg = w[j] * inv;
            y[0] += wg * bflo(ow.x); y[1] += wg * bfhi(ow.x); y[2] += wg * bflo(ow.y); y[3] += wg * bfhi(ow.y); y[4] += wg * bflo(ow.z); y[5] += wg * bfhi(ow.z); y[6] += wg * bflo(ow.w); y[7] += wg * bfhi(ow.w); }
        u32x4 r; r.x = cvt_pk_bf16(y[0], y[1]); r.y = cvt_pk_bf16(y[2], y[3]); r.z = cvt_pk_bf16(y[4], y[5]); r.w = cvt_pk_bf16(y[6], y[7]);
        *(u32x4*)(QCp + tok * 384 + h * 64 + ch * 8) = r;
    }
}

#ifndef MIXER_ON
#define MIXER_ON 1
#endif
#define XB_TMO      128
#define XB_XCNT(j)  (256  + 64 * (j))
#define XB_XSUB(j)  (1280 + 64 * (j))
#define XB_XGEN(j)  (2304 + 64 * (j))
#define XB_TOP      3328
#define XB_TOPGEN   3392
#define XCD_BAR_WORDS 3456
#define XB_SPIN_CAP (1u << 18)

__device__ __forceinline__ unsigned xb_ld(unsigned* p)              { return __hip_atomic_load(p, __ATOMIC_RELAXED, __HIP_MEMORY_SCOPE_AGENT); }
__device__ __forceinline__ unsigned xb_add(unsigned* p, unsigned v) { return __hip_atomic_fetch_add(p, v, __ATOMIC_RELAXED, __HIP_MEMORY_SCOPE_AGENT); }
__device__ __forceinline__ unsigned xb_xcc_id() { return (unsigned)__builtin_amdgcn_s_getreg((3 << 11) | 20) & 0xFu; }
#define XB_SPIN(cond, bar) do { unsigned _sp = 0; while (cond) { __builtin_amdgcn_s_sleep(1); \
    if ((++_sp & 255u) == 0u) { if (xb_ld(&(bar)[XB_TMO])) break; if (_sp > XB_SPIN_CAP) { atomicAdd(&(bar)[XB_TMO], 1u); break; } } } } while (0)

struct XcdBarrier {
    unsigned* bar; unsigned x;
    volatile LAS unsigned* st;
};

__device__ __forceinline__ XcdBarrier xcd_barrier_post(unsigned* bar, volatile LAS unsigned* st) {
    XcdBarrier b; b.bar = bar; b.x = xb_xcc_id(); b.st = st;
    if (threadIdx.x == 0) (void)xb_add(&bar[XB_XCNT(b.x)], 1u);
    return b;
}
__device__ __forceinline__ void xcd_barrier_complete(unsigned* bar, unsigned x, unsigned& nloc, unsigned& nx) {
    const unsigned G = gridDim.x * gridDim.y * gridDim.z;
    unsigned sum, cnt, mine, sp = 0u;
    for (;;) {
        sum = 0u; cnt = 0u; mine = 0u;
#pragma unroll
        for (unsigned j = 0; j < 16; ++j) { const unsigned c = xb_ld(&bar[XB_XCNT(j)]); sum += c; cnt += (c > 0u) ? 1u : 0u; mine = (j == x) ? c : mine; }
        if (sum == G) break;
        __builtin_amdgcn_s_sleep(1);
        if ((++sp & 255u) == 0u) { if (xb_ld(&bar[XB_TMO])) break; if (sp > XB_SPIN_CAP) { atomicAdd(&bar[XB_TMO], 1u); break; } }
    }
    nloc = mine > 0u ? mine : 1u; nx = cnt > 0u ? cnt : 1u;
}

__device__ __forceinline__ void xcd_barrier(const XcdBarrier& b) {
    asm volatile("s_waitcnt vmcnt(0)" ::: "memory");
    __syncthreads();
    if (threadIdx.x == 0) {
        unsigned* bar = b.bar;
        __builtin_amdgcn_s_waitcnt(0);
        unsigned nloc = b.st[0], nx = b.st[1];
        if (nloc == 0u) { xcd_barrier_complete(bar, b.x, nloc, nx); b.st[0] = nloc; b.st[1] = nx; }
        const unsigned old = xb_add(&bar[XB_XSUB(b.x)], 1u);
        const unsigned gen = old / nloc;
        if (old + 1u == (gen + 1u) * nloc) {
            __builtin_amdgcn_fence(__ATOMIC_RELEASE, "agent");
            asm volatile("s_waitcnt vmcnt(0)" ::: "memory");
            const unsigned og = xb_add(&bar[XB_TOP], 1u);
            const unsigned tg = og / nx;
            if (og + 1u == (tg + 1u) * nx) xb_add(&bar[XB_TOPGEN], 1u);
            else XB_SPIN(xb_ld(&bar[XB_TOPGEN]) == tg, bar);
            __builtin_amdgcn_fence(__ATOMIC_ACQUIRE, "agent");
            xb_add(&bar[XB_XGEN(b.x)], 1u);
            asm volatile("s_waitcnt vmcnt(0)" ::: "memory");
        } else {
            XB_SPIN(xb_ld(&bar[XB_XGEN(b.x)]) == gen, bar);
            __builtin_amdgcn_fence(__ATOMIC_ACQUIRE, "agent");
            asm volatile("s_waitcnt vmcnt(0)" ::: "memory");
        }
    }
    __syncthreads();
}

constexpr int CW_BAR = 110016;
static_assert((CW_BAR + XCD_BAR_WORDS) * 4 <= (int)CTL_BYTES, "ctl");
#define GBX() int G = gridDim.x, bx = blockIdx.x; asm volatile("" : "+s"(G), "+s"(bx))
#define AP() ({ CArgs p_ = kp; asm volatile("" : "+s"(p_)); p_; }); GBX()
#define TIDS() int tid_ = threadIdx.x; asm volatile("" : "+v"(tid_)); const int tid = tid_, lane = tid & 63, wave = __builtin_amdgcn_readfirstlane(tid >> 6); (void)lane; (void)wave
#define XBP(a) ((bf16_t*)((a)->ws + WS_XB))
#define LFP(a) ((float*)((a)->ws + WS_LF))
#define WLP(a) ((const bf16_t*)((a)->ws + WS_W) + (size_t)layer * W_LAYER)
template <int layer> __device__ __forceinline__ void layer_body(const CArgs kp, LAS unsigned char* lds, unsigned char* lds_raw, const XcdBarrier& bar) {
#if MIXER_ON
        { const CArgs a = AP(); TIDS(); if (bx < 12) scan_bh(LFP(a) + (size_t)bx * SEQ, (float*)(a->ws + WS_CUM) + (size_t)bx * SEQ, lds, tid, lane, wave); }
#ifndef NO_INPROJ
        { const CArgs a = AP(); pg8::StaticOrder S; pg8::Gemm g{XBP(a), WLP(a) + W_IN, 1024, 1024, 1024}; S.init(T, NQKV, G, bx);
          EpiInproj E{a->ws, (const f32x2*)(a->ws + WS_ROPE), (int*)((unsigned*)(a->ws + WS_CTL) + CW_KMEAN + 49152 * layer)};
          pg8::gemm_phase<EpiInproj, true>(lds, g, S, E);
#ifdef PROBE_DUP
          pg8::gemm_phase<EpiInproj, true>(lds, g, S, E);
#endif
 }
#endif
        xcd_barrier(bar);
#ifndef NO_GATING
        { const CArgs a = AP(); TIDS(); gating_phase(a, layer, lds, tid); }
#endif
        xcd_barrier(bar);
        { const CArgs a = AP(); TIDS(); attention_phase(a, layer, lds, (char*)lds_raw, tid, lane, wave); }
        xcd_barrier(bar);
        { const CArgs a = AP(); TIDS(); combine_phase(a, tid); }
        xcd_barrier(bar);
        {
            pg8::StaticOrder S; { GBX(); S.init(T, 1024, G, bx); }
            { const CArgs a = AP(); pg8::Gemm g{XBP(a), WLP(a) + W_G, 1024, 1024, 1024}; EpiGate E{(bf16_t*)(a->ws + WS_GS)}; pg8::gemm_phase<EpiGate, true>(lds, g, S, E); }
            { const CArgs a = AP(); pg8::Gemm g{(const bf16_t*)(a->ws + WS_QA), WLP(a) + W_PA, 384, 384, 384}; EpiBranch<1> E{(const bf16_t*)(a->ws + WS_GS), (bf16_t*)(a->ws + WS_MG)}; pg8::gemm_phase<EpiBranch<1>, true>(lds, g, S, E); }
#ifndef ONLY_A
            { const CArgs a = AP(); pg8::Gemm g{XBP(a), WLP(a) + W_G + (size_t)1024 * 1024, 1024, 1024, 1024}; EpiGate E{(bf16_t*)(a->ws + WS_GS)}; pg8::gemm_phase<EpiGate, true>(lds, g, S, E); }
            { const CArgs a = AP(); pg8::Gemm g{(const bf16_t*)(a->ws + WS_QB), WLP(a) + W_PB, 768, 256, 256}; EpiBranch<0> E{(const bf16_t*)(a->ws + WS_GS), (bf16_t*)(a->ws + WS_MG)}; pg8::gemm_phase<EpiBranch<0>, true>(lds, g, S, E); }
            { const CArgs a = AP(); pg8::Gemm g{XBP(a), WLP(a) + W_G + (size_t)2048 * 1024, 1024, 1024, 1024}; EpiGate E{(bf16_t*)(a->ws + WS_GS)}; pg8::gemm_phase<EpiGate, true>(lds, g, S, E); }
            { const CArgs a = AP(); pg8::Gemm g{(const bf16_t*)(a->ws + WS_QC), WLP(a) + W_PC, 384, 384, 384}; EpiBranch<0> E{(const bf16_t*)(a->ws + WS_GS), (bf16_t*)(a->ws + WS_MG)}; pg8::gemm_phase<EpiBranch<0>, true>(lds, g, S, E); }
#endif
        }
        xcd_barrier(bar);
        { const CArgs a = AP(); pg8::StaticOrder S; pg8::Gemm g{(const bf16_t*)(a->ws + WS_MG), WLP(a) + W_O, 1024, 1024, 1024}; S.init(T, 1024, G, bx); EpiResid E{a->out}; pg8::gemm_phase<EpiResid, true>(lds, g, S, E); }
        xcd_barrier(bar);
#else
        {
            const CArgs a = AP(); TIDS();
            for (size_t i = (size_t)bx * 512 + tid; i < (size_t)T * DM / 4; i += (size_t)G * 512) { f32x4* p = (f32x4*)a->out + i; *p = *p * DN_ALPHA; }
        }
        xcd_barrier(bar);
#endif
        { const CArgs a = AP(); TIDS(); ln_phase(a->out, a->in[9] + layer * DM, a->in[10] + layer * DM, a->out, XBP(a), nullptr, nullptr, nullptr, lds, tid, lane, wave); }
        xcd_barrier(bar);
#ifndef NO_P8
        { const CArgs a = AP(); pg8::StaticOrder S; pg8::Gemm g{XBP(a), WLP(a) + W_GU, 1024, 1024, 1024}; S.init(T, 2 * DFF, G, bx); EpiSwiglu E{(bf16_t*)(a->ws + WS_H)}; pg8::gemm_phase<EpiSwiglu, true>(lds, g, S, E);
#ifdef PROBE_DUP
          pg8::gemm_phase<EpiSwiglu, true>(lds, g, S, E);
#endif
 }
#endif
        xcd_barrier(bar);
#ifndef NO_P9
        { const CArgs a = AP(); pg8::StaticOrder S; pg8::Gemm g{(const bf16_t*)(a->ws + WS_H), WLP(a) + W_D, DFF, DFF, DFF}; S.init(T, 1024, G, bx); EpiResid E{a->out}; pg8::gemm_phase<EpiResid, true>(lds, g, S, E); }
#endif
        xcd_barrier(bar);
        if (layer + 1 < DEPTH) {
            { const CArgs a = AP(); TIDS(); ln_phase(a->out, a->in[14] + layer * DM, a->in[15] + layer * DM, a->out, XBP(a), a->in[3] + (size_t)(layer + 1) * 1024 * DIN, a->in[4] + (layer + 1) * 6, LFP(a), lds, tid, lane, wave); }
            xcd_barrier(bar);
        } else {
            const CArgs a = AP(); TIDS(); ln_phase(a->out, a->in[14] + layer * DM, a->in[15] + layer * DM, a->out, XBP(a), nullptr, nullptr, nullptr, lds, tid, lane, wave);
        }
}

__global__ void __launch_bounds__(NWAVES * 64, 2) fwd_kernel(Args a_unused) {
    extern __shared__ __attribute__((aligned(16))) unsigned char lds_raw[];
    cg::grid_group grid = cg::this_grid();
    LAS unsigned char* lds = (LAS unsigned char*)lds_raw;
    const CArgs kp = (CArgs)__builtin_amdgcn_kernarg_segment_ptr();
    if (threadIdx.x < 16) ((LAS unsigned*)(lds + LDS_QW + 64))[threadIdx.x] = 0u;
    __syncthreads();
    const XcdBarrier bar = xcd_barrier_post((unsigned*)(kp->ws + WS_CTL) + CW_BAR, (volatile LAS unsigned*)(lds + LDS_QW + 64));

    {
        const CArgs a = AP(); TIDS();
        LAS float* scr = (LAS float*)(lds + wave * 16384);
        for (int it = bx * NWAVES + wave; it < 2 * IT_LAYER; it += G * NWAVES) prologue_item(a, it, scr, lane);
        f32x2* rope = (f32x2*)(a->ws + WS_ROPE);
        for (int i = bx * (NWAVES * 64) + tid; i < SEQ * 8; i += G * NWAVES * 64) {
            const int pos = i >> 3, fi = i & 7; double t = (double)pos * ROPE_FR[fi]; t -= floor(t); const float fr = (float)t;
            rope[i] = (f32x2){__builtin_amdgcn_cosf(fr), __builtin_amdgcn_sinf(fr)};
        }
        __syncthreads();
        ln_phase(a->in[0], a->in[1], a->in[2], a->out, XBP(a), a->in[3], a->in[4], LFP(a), lds, tid, lane, wave);
    }
    grid.sync();

    layer_body<0>(kp, lds, lds_raw, bar);
    layer_body<1>(kp, lds, lds_raw, bar);
}

extern "C" void kernel_launch(void* const* d_in, const int* in_sizes, int n_in, void* d_out, int out_size, void* d_ws, size_t ws_size, hipStream_t stream) {
    static int grid = 0;
    if (grid == 0) {
        if (n_in != 16 || in_sizes[0] != T * DM || out_size != T * DM || ws_size < WS_END) {
            fprintf(stderr, "kernel_launch: unexpected problem geometry (n_in %d, in0 %d, out %d, ws %zu)\n", n_in, n_in > 0 ? in_sizes[0] : -1, out_size, ws_size); grid = -1; return; }
        int dev = 0, cus = 0, per_cu = 0;
        (void)hipGetDevice(&dev); (void)hipDeviceGetAttribute(&cus, hipDeviceAttributeMultiprocessorCount, dev);
        if (hipFuncSetAttribute((const void*)fwd_kernel, hipFuncAttributeMaxDynamicSharedMemorySize, LDS_BYTES) != hipSuccess) { fprintf(stderr, "kernel_launch: hipFuncSetAttribute failed\n"); grid = -1; return; }
        if (hipOccupancyMaxActiveBlocksPerMultiprocessor(&per_cu, (const void*)fwd_kernel, NWAVES * 64, LDS_BYTES) != hipSuccess || per_cu < 1) { fprintf(stderr, "kernel_launch: occupancy query says %d\n", per_cu); per_cu = 1; }
        (void)hipGetLastError();
        grid = cus * 1;
        if (grid % 8 != 0 || grid <= 0) grid = 256;
    }
    if (grid < 0) return;
    (void)hipMemsetAsync((char*)d_ws + WS_CTL, 0, CTL_BYTES, stream);
    Args a{};
    for (int i = 0; i < 16; ++i) a.in[i] = (const float*)d_in[i];
    a.out = (float*)d_out; a.ws = (unsigned char*)d_ws;
    void* args[] = {&a};
    const hipError_t e = hipLaunchCooperativeKernel((const void*)fwd_kernel, dim3(grid), dim3(NWAVES * 64), args, LDS_BYTES, stream);
    if (e != hipSuccess) fprintf(stderr, "kernel_launch: cooperative launch failed: %s (grid %d)\n", hipGetErrorString(e), grid);
}
```

```cpp
#include <hip/hip_runtime.h>
#include <hip/hip_cooperative_groups.h>
#include <hip/hip_bf16.h>
#include <cstdio>
#include <cstdint>
#include <cmath>
namespace cg = cooperative_groups;

#define LAS __attribute__((address_space(3)))
typedef unsigned short bf16_t;
typedef short bf16x8 __attribute__((ext_vector_type(8)));
typedef short s16x4 __attribute__((ext_vector_type(4)));
typedef float f32x2 __attribute__((ext_vector_type(2)));
typedef float f32x4 __attribute__((ext_vector_type(4)));
typedef float f32x16 __attribute__((ext_vector_type(16)));
typedef unsigned u32x4 __attribute__((ext_vector_type(4)));
typedef unsigned u32x2 __attribute__((ext_vector_type(2)));

constexpr int BATCH = 2, SEQ = 16384, DM = 1024, T = BATCH * SEQ, DEPTH = 2, DFF = 2816, DIN = 6662;
constexpr int NQKV = 3584, NG = 3072;
constexpr float LN_EPS = 1e-5f;
constexpr float DN_ALPHA = 1.4142135623730951f;
constexpr float LOG2E = 1.4426950408889634f;
constexpr float C2 = 0.125f * LOG2E;
constexpr int NWAVES = 8;

typedef __bf16 bf16x2_t __attribute__((ext_vector_type(2)));
__device__ __forceinline__ unsigned cvt_pk_bf16(float lo, float hi) { f32x2 v = {lo, hi}; bf16x2_t b = __builtin_convertvector(v, bf16x2_t); return __builtin_bit_cast(unsigned, b); }
__device__ __forceinline__ float bf2f(unsigned short b) { return __uint_as_float(((unsigned)b) << 16); }
__device__ __forceinline__ float bflo(unsigned w) { return __uint_as_float(w << 16); }
__device__ __forceinline__ float bfhi(unsigned w) { return __uint_as_float(w & 0xffff0000u); }

namespace pg8 {
constexpr int BM = 256, BK = 64, HALF = 128, HTB = HALF * BK * 2, STAGE_BYTES = 8 * HTB, NXCD = 8, WGM = 8;
__host__ __device__ __forceinline__ int lds_byte(int r, int c) { const int st = (r >> 4) * 2 + (c >> 5), rr = r & 15, cc = c & 31, ob = rr * 64 + cc * 2; return st * 1024 + (ob ^ (((ob >> 9) & 1) << 5)); }
__host__ __device__ __forceinline__ void stage_rc(int b, int& R, int& C) { const int st = b / 1024, sb = b % 1024, swz = sb ^ (((sb >> 9) & 1) << 5); R = (st >> 1) * 16 + swz / 64; C = (st & 1) * 32 + (swz % 64) / 2; }
__host__ __device__ __forceinline__ int perm32(int rho) { const int n = rho >> 4, i = rho & 15; return 8 * (i >> 2) + 4 * n + (i & 3); }

struct Unit { int pm, pn; };
struct Gemm { const bf16_t* A; const bf16_t* Bt; int lda, ldb, K; };

struct StaticOrder {
    int nM, nN, nwg, G, c;
    __host__ __device__ void init(int M, int N, int G_, int c_) { nM = M / BM; nN = N / BM; nwg = nM * nN; G = G_; c = c_; }
    __host__ __device__ bool next(int i, Unit& u) const {
        const long L = (long)i * G + c; if (L >= nwg) return false;
        int wgid = (int)L; { const int q = nwg / NXCD, r = nwg % NXCD, xcd = wgid % NXCD, off = wgid / NXCD; wgid = (xcd < r ? xcd * (q + 1) : r * (q + 1) + (xcd - r) * q) + off; }
        const int nig = WGM * nN, gid = wgid / nig, fm = gid * WGM, gsz = (nM - fm) < WGM ? (nM - fm) : WGM;
        u.pm = fm + ((wgid % nig) % gsz); u.pn = (wgid % nig) / gsz; return true;
    }
};

template <class Epi, bool ALIGN_EPI>
__device__ __forceinline__ void gemm_phase(LAS unsigned char* lds, const Gemm g, const StaticOrder& S, const Epi& E) {
    int tid_ = threadIdx.x; asm volatile("" : "+v"(tid_));
    const int tid = tid_, wid = __builtin_amdgcn_readfirstlane(tid >> 6), lane = tid & 63, wr = wid >> 2, wc = wid & 3, fr = lane & 15, fq = lane >> 4;
    const int nt = g.K / BK;
    unsigned voffA[2], voffB[2];
#pragma unroll
    for (int i = 0; i < 2; ++i) { int R, C; stage_rc(tid * 16 + i * 8192, R, C); const int Rb = (R & ~31) + perm32(R & 31);
        voffA[i] = (unsigned)(R * g.lda + C) * 2u; voffB[i] = (unsigned)(Rb * g.ldb + C) * 2u; }
    const size_t kstep = (size_t)(BK * 2);
    const size_t hA = (size_t)HALF * g.lda * 2, hB = (size_t)HALF * g.ldb * 2;
    const size_t tA = 2 * hA, tB = 2 * hB;
    const unsigned ldsw = (unsigned)wid * 1024u;
    const int aoff = lds_byte(wr * 64 + fr, fq * 8), boff = lds_byte(wc * 32 + fr, fq * 8);
#define PG8_SA(b, h) (((b) * 2 + (h)) * HTB)
#define PG8_SB(b, h) ((4 + (b) * 2 + (h)) * HTB)
#define PG8_STAGE(bufoff, gbase, voff) do { _Pragma("unroll") for (int _i = 0; _i < 2; ++_i) \
        __builtin_amdgcn_global_load_lds((const unsigned*)((const char*)(gbase) + (voff)[_i]), (LAS unsigned*)(lds + (bufoff) + ldsw + _i * 8192), 16, 0, 0); } while (0)
#define PG8_LDA(dst, b, h) do { _Pragma("unroll") for (int m = 0; m < 4; ++m) _Pragma("unroll") for (int k = 0; k < 2; ++k) dst[m][k] = *(const LAS bf16x8*)(lds + PG8_SA(b, h) + aoff + m * 2048 + k * 1024); } while (0)
#define PG8_LDB(dst, b, h) do { _Pragma("unroll") for (int n = 0; n < 2; ++n) _Pragma("unroll") for (int k = 0; k < 2; ++k) dst[n][k] = *(const LAS bf16x8*)(lds + PG8_SB(b, h) + boff + n * 2048 + k * 1024); } while (0)
#define PG8_MMA(ai, bj, At, Bt) do { __builtin_amdgcn_s_setprio(1); _Pragma("unroll") for (int m = 0; m < 4; ++m) _Pragma("unroll") for (int n = 0; n < 2; ++n) _Pragma("unroll") for (int k = 0; k < 2; ++k) \
        acc[ai][bj][m][n] = __builtin_amdgcn_mfma_f32_16x16x32_bf16(Bt[n][k], At[m][k], acc[ai][bj][m][n], 0, 0, 0); __builtin_amdgcn_s_setprio(0); } while (0)
#define PG8_WAIT_V(n) asm volatile("s_waitcnt vmcnt(" #n ")" ::: "memory")
#define PG8_WAIT_L(n) asm volatile("s_waitcnt lgkmcnt(" #n ")" ::: "memory")
#define PG8_BAR __builtin_amdgcn_s_barrier()
#define PG8_SCHED __builtin_amdgcn_sched_barrier(0)
    Unit cur, nxt; int ui = 0;
    if (!S.next(0, cur)) return;
    f32x4 acc[2][2][4][2];
#pragma unroll
    for (int a = 0; a < 2; ++a)
#pragma unroll
        for (int b = 0; b < 2; ++b)
#pragma unroll
            for (int m = 0; m < 4; ++m)
#pragma unroll
                for (int n = 0; n < 2; ++n) acc[a][b][m][n] = (f32x4){0.f, 0.f, 0.f, 0.f};
    bf16x8 At[4][2], B0[2][2], B1[2][2];
    const char* cA = (const char*)g.A + (size_t)cur.pm * tA; const char* cB = (const char*)g.Bt + (size_t)cur.pn * tB;
    PG8_STAGE(PG8_SB(0, 0), cB, voffB); PG8_STAGE(PG8_SB(0, 1), cB + hB, voffB); PG8_STAGE(PG8_SA(0, 0), cA, voffA); PG8_STAGE(PG8_SA(0, 1), cA + hA, voffA);
    if (wr == 1) PG8_BAR;
    PG8_WAIT_V(2); PG8_BAR;
    PG8_STAGE(PG8_SB(1, 0), cB + kstep, voffB); PG8_STAGE(PG8_SA(1, 0), cA + kstep, voffA); PG8_STAGE(PG8_SB(1, 1), cB + hB + kstep, voffB);
    PG8_WAIT_V(6); PG8_BAR;
    for (;;) {
        const bool has_next = S.next(ui + 1, nxt);
        const char* nA = has_next ? (const char*)g.A + (size_t)nxt.pm * tA : cA; const char* nB = has_next ? (const char*)g.Bt + (size_t)nxt.pn * tB : cB;
        for (int t = 0; t < nt; t += 2) {
            const bool last = (t == nt - 2);
            const char* a1 = cA + (size_t)(t + 1) * kstep;
            const char* a2 = last ? nA : cA + (size_t)(t + 2) * kstep; const char* b2 = last ? nB : cB + (size_t)(t + 2) * kstep;
            const char* a3 = a2 + kstep; const char* b3 = b2 + kstep;
            PG8_LDB(B0, 0, 0); PG8_LDB(B1, 0, 1); PG8_SCHED; PG8_LDA(At, 0, 0); PG8_STAGE(PG8_SA(1, 1), a1 + hA, voffA);
            PG8_WAIT_V(8); PG8_WAIT_L(0); PG8_BAR; PG8_MMA(0, 0, At, B0); PG8_MMA(0, 1, At, B1); PG8_BAR; PG8_SCHED;
            PG8_LDA(At, 0, 1); PG8_STAGE(PG8_SB(0, 0), b2, voffB); PG8_STAGE(PG8_SB(0, 1), b2 + hB, voffB); PG8_STAGE(PG8_SA(0, 0), a2, voffA);
            PG8_WAIT_V(8); PG8_WAIT_L(0); PG8_BAR; PG8_MMA(1, 0, At, B0); PG8_MMA(1, 1, At, B1); PG8_BAR; PG8_SCHED;
            PG8_LDB(B0, 1, 0); PG8_LDB(B1, 1, 1); PG8_SCHED; PG8_LDA(At, 1, 0); PG8_STAGE(PG8_SA(0, 1), a2 + hA, voffA);
            PG8_WAIT_V(8); PG8_WAIT_L(0); PG8_BAR; PG8_MMA(0, 0, At, B0); PG8_MMA(0, 1, At, B1); PG8_BAR; PG8_SCHED;
            PG8_LDA(At, 1, 1); PG8_STAGE(PG8_SB(1, 0), b3, voffB); PG8_STAGE(PG8_SB(1, 1), b3 + hB, voffB); PG8_STAGE(PG8_SA(1, 0), a3, voffA);
            PG8_WAIT_V(8); PG8_WAIT_L(0); PG8_BAR; PG8_MMA(1, 0, At, B0); PG8_MMA(1, 1, At, B1); PG8_BAR; PG8_SCHED;
        }
        if constexpr (ALIGN_EPI) { if (wr == 0) PG8_BAR; }
        E(acc, cur, wr, wc, fr, fq);
        if (!has_next) break;
#pragma unroll
        for (int a = 0; a < 2; ++a)
#pragma unroll
            for (int b = 0; b < 2; ++b)
#pragma unroll
                for (int m = 0; m < 4; ++m)
#pragma unroll
                    for (int n = 0; n < 2; ++n) acc[a][b][m][n] = (f32x4){0.f, 0.f, 0.f, 0.f};
        cur = nxt; cA = nA; cB = nB; ++ui;
        if constexpr (ALIGN_EPI) { if (wr == 1) PG8_BAR; }
    }
    PG8_WAIT_V(0);
    if constexpr (!ALIGN_EPI) { if (wr == 0) PG8_BAR; }
    PG8_BAR;
#undef PG8_SA
#undef PG8_SB
#undef PG8_STAGE
#undef PG8_LDA
#undef PG8_LDB
#undef PG8_MMA
#undef PG8_WAIT_V
#undef PG8_WAIT_L
#undef PG8_BAR
#undef PG8_SCHED
}
}
namespace attn_body {
using bf16=__hip_bfloat16;
using bf16x8=__attribute__((ext_vector_type(8)))short;
using s16x4=__attribute__((ext_vector_type(4)))short;
using f32x16=__attribute__((ext_vector_type(16)))float;
using u32x4=__attribute__((ext_vector_type(4)))unsigned;
using f32x4v=__attribute__((ext_vector_type(4)))float;
constexpr int BATCH=2,NHEAD=6,SEQ=16384,D=64,DM=NHEAD*D;
constexpr int NW=8,QBLK=32,QB=QBLK*NW,KVBLK=64,NQB=SEQ/QB;
constexpr int ATTN_PITCH=DM, ATTN_UNIT_ROWS=QB;
__device__ __forceinline__ int crow(int r,int hi){return (r&3)+8*(r>>2)+4*hi;}
#define SBAR() __builtin_amdgcn_sched_barrier(0)
__device__ __forceinline__ void cmask(f32x16&p0,f32x16&p1,int jb,int qrel,int hi){
  const float NEG=-INFINITY; int kb=64*jb+4*hi;
  #pragma unroll
  for(int r=0;r<16;++r){int kv=kb+(r&3)+8*(r>>2); if(kv>qrel)p0[r]=NEG; if(kv+32>qrel)p1[r]=NEG;}
}

constexpr int NSLOT=3, SLOTB=8192;
constexpr int LDS_K=0, LDS_V=NSLOT*SLOTB, LDS_WS=2*NSLOT*SLOTB, LDS_OST=LDS_WS+NW*64*4, LDS_BIAS=LDS_OST+NW*4096, LDS_BYTES=LDS_BIAS+SEQ*4;
constexpr float C2=0.125f*1.4426950408889634f;
__device__ __forceinline__ void glds16(const void*gsrc,unsigned lds_dst){unsigned keep;
  asm volatile("s_mov_b32 %0, m0\n\ts_mov_b32 m0, %2\n\ts_nop 0\n\tglobal_load_lds_dwordx4 %1, off\n\ts_mov_b32 m0, %0":"=&s"(keep):"v"(gsrc),"s"(lds_dst):"memory");}
__device__ __forceinline__ float max3f(float a,float b,float c){float r;asm("v_max3_f32 %0, %1, %2, %3":"=v"(r):"v"(a),"v"(b),"v"(c));return r;}
__device__ __forceinline__ float max2f(float a,float b){float r;asm("v_max_f32_e32 %0, %1, %2":"=v"(r):"v"(a),"v"(b));return r;}
__device__ __forceinline__ float fadd_s(float a,float b){float r;asm("v_add_f32_e32 %0, %1, %2":"=v"(r):"v"(a),"v"(b));return r;}
__device__ __forceinline__ float fsub_s(float a,float b){float r;asm("v_sub_f32_e32 %0, %1, %2":"=v"(r):"v"(a),"v"(b));return r;}
typedef float f32x2_t __attribute__((ext_vector_type(2))); typedef __bf16 bf16x2_t __attribute__((ext_vector_type(2)));
__device__ __forceinline__ unsigned cvtpk_s(float lo,float hi){f32x2_t v={lo,hi};bf16x2_t b=__builtin_convertvector(v,bf16x2_t);return __builtin_bit_cast(unsigned,b);}
#define WAIT_BAR(N) asm volatile("s_waitcnt vmcnt(" #N ") lgkmcnt(0)\n\ts_barrier":::"memory")

__device__ __forceinline__ void qkt(f32x16&p0,f32x16&p1,const char*Kslot,const bf16x8*qr,int r32,int hi){
  const char*kb=Kslot+hi*1024+r32*16;
  #pragma unroll
  for(int d0=0;d0<4;++d0){
    const bf16x8 b0=*reinterpret_cast<const bf16x8*>(kb+d0*2048);
    const bf16x8 b1=*reinterpret_cast<const bf16x8*>(kb+d0*2048+512);
    {p0=__builtin_amdgcn_mfma_f32_32x32x16_bf16(b0,qr[d0],p0,0,0,0);p1=__builtin_amdgcn_mfma_f32_32x32x16_bf16(b1,qr[d0],p1,0,0,0);}}
}
typedef __attribute__((address_space(3))) const char* lds_cptr;
typedef short v4i16_t __attribute__((ext_vector_type(4)));
__device__ __forceinline__ void kload8(bf16x8*kf,lds_cptr kp){
  kf[0]=*(const __attribute__((address_space(3))) bf16x8*)(kp);      kf[1]=*(const __attribute__((address_space(3))) bf16x8*)(kp+512);
  kf[2]=*(const __attribute__((address_space(3))) bf16x8*)(kp+2048); kf[3]=*(const __attribute__((address_space(3))) bf16x8*)(kp+2560);
  kf[4]=*(const __attribute__((address_space(3))) bf16x8*)(kp+4096); kf[5]=*(const __attribute__((address_space(3))) bf16x8*)(kp+4608);
  kf[6]=*(const __attribute__((address_space(3))) bf16x8*)(kp+6144); kf[7]=*(const __attribute__((address_space(3))) bf16x8*)(kp+6656);
}
__device__ __forceinline__ void kload2(bf16x8*kf,lds_cptr kp,int j){ kf[2*j]=*(const __attribute__((address_space(3))) bf16x8*)(kp+j*2048); kf[2*j+1]=*(const __attribute__((address_space(3))) bf16x8*)(kp+j*2048+512); }
__device__ __forceinline__ s16x4 vtr(lds_cptr p){ return __builtin_bit_cast(s16x4,__builtin_amdgcn_ds_read_tr16_b64_v4i16((__attribute__((address_space(3))) v4i16_t*)p)); }
__device__ __forceinline__ float rowmax(const f32x16&p0,const f32x16&p1){
  float a=max3f(p0[0],p0[1],p1[0]),b=max3f(p0[2],p0[3],p1[1]);a=max3f(a,p1[2],p1[3]);
  #pragma unroll
  for(int r=4;r<16;r+=4){a=max3f(a,p0[r],p0[r+1]);b=max3f(b,p0[r+2],p0[r+3]);a=max3f(a,p1[r],p1[r+1]);b=max3f(b,p1[r+2],p1[r+3]);}
  const float m=max2f(a,b);
  auto rr=__builtin_amdgcn_permlane32_swap(__float_as_uint(m),__float_as_uint(m),false,false);
  return max2f(__uint_as_float(rr[0]),__uint_as_float(rr[1]));
}
__device__ __forceinline__ void pv(f32x16*o,int vb,bf16x8 pa0,bf16x8 pa1,bf16x8 pa2,bf16x8 pa3){
  #pragma unroll
  for(int d0=0;d0<2;++d0){s16x4 lo[4],hi[4];
    #pragma unroll
    for(int ks=0;ks<4;++ks){
      asm volatile("ds_read_b64_tr_b16 %0,%1 offset:%c2":"=&v"(lo[ks]):"v"(vb),"i"(d0*4096+ks*1024):"memory");
      asm volatile("ds_read_b64_tr_b16 %0,%1 offset:%c2":"=&v"(hi[ks]):"v"(vb),"i"(d0*4096+ks*1024+512):"memory");}
    asm volatile("s_waitcnt lgkmcnt(0)":::"memory");SBAR();
    #define PK(k) (bf16x8){lo[k][0],lo[k][1],lo[k][2],lo[k][3],hi[k][0],hi[k][1],hi[k][2],hi[k][3]}
    o[d0]=__builtin_amdgcn_mfma_f32_32x32x16_bf16(pa0,PK(0),o[d0],0,0,0);
    o[d0]=__builtin_amdgcn_mfma_f32_32x32x16_bf16(pa1,PK(1),o[d0],0,0,0);
    o[d0]=__builtin_amdgcn_mfma_f32_32x32x16_bf16(pa2,PK(2),o[d0],0,0,0);
    o[d0]=__builtin_amdgcn_mfma_f32_32x32x16_bf16(pa3,PK(3),o[d0],0,0,0);
    #undef PK
  }
}

#ifndef ATTN_STORE16
#define ATTN_STORE16(p,v) (*(u32x4*)(p)=(v))
#endif
template<int THRL> __device__ __forceinline__ void attn_unit(int b,int h,int qb,const bf16*Q,const bf16*__restrict__ K,const bf16*__restrict__ V,bf16*O,const float*__restrict__ cum,char*shm){
  int tid_=threadIdx.x; asm volatile("":"+v"(tid_)); const int tid=tid_,lane=tid&63,r32=lane&31,hi=lane>>5; const int wid=__builtin_amdgcn_readfirstlane(tid>>6);
  const long rowbase=(long)b*SEQ; const int q0=qb*QB;
  const bf16*Qw=Q+(rowbase+q0+wid*QBLK)*DM+h*D;
  const bf16*Kh=K+rowbase*DM+h*D,*Vh=V+rowbase*DM+h*D;
  const unsigned lds0=(unsigned)(uintptr_t)shm;
  float*wsf=(float*)(shm+LDS_WS)+wid*64;
  const bf16*ksrc=Kh+(long)lane*DM+wid*8;
  const bf16*vsrc=Vh+(long)(16*(wid&3)+(lane>>2))*DM+(wid>>2)*32+(lane&3)*8;
  const unsigned kdst=lds0+LDS_K+wid*1024, vdst=lds0+LDS_V+wid*1024;
  #define DMA_K(t,slot) glds16(ksrc+(long)(t)*KVBLK*DM,(unsigned)__builtin_amdgcn_readfirstlane(kdst+(slot)))
  #define DMA_V(t,slot) glds16(vsrc+(long)(t)*KVBLK*DM,(unsigned)__builtin_amdgcn_readfirstlane(vdst+(slot)))
  const int vb0=(int)(lds0+LDS_V)+((lane>>4)&1)*32+(lane&3)*8+(4*hi+((lane&15)>>2))*64;
  const char*Kbase=shm+LDS_K; bf16x8 kf[8];
  const lds_cptr shm3=(lds_cptr)shm; const lds_cptr kp0=shm3+LDS_K+hi*1024+r32*16; const lds_cptr vp0=shm3+LDS_V+((lane>>4)&1)*32+(lane&3)*8+(4*hi+((lane&15)>>2))*64;
  const int NT=(q0+QB)/KVBLK;
  const __attribute__((address_space(3))) float* biasl=(const __attribute__((address_space(3))) float*)(shm3+LDS_BIAS);
  { __attribute__((address_space(3))) float* bw=(__attribute__((address_space(3))) float*)(shm3+LDS_BIAS);
    for(int i=tid*4;i<q0+QB;i+=NW*64*4){ f32x4v v=*reinterpret_cast<const f32x4v*>(cum+i); v=v*(-1.4426950408889634f); *(__attribute__((address_space(3))) f32x4v*)(bw+i)=v; }
    asm volatile("s_waitcnt vmcnt(0) lgkmcnt(0)\n\ts_barrier":::"memory"); }
  DMA_K(0,0);DMA_V(0,0);DMA_K(1,SLOTB);
  bf16x8 qr[4];
  #pragma unroll
  for(int d0=0;d0<4;++d0)qr[d0]=*reinterpret_cast<const bf16x8*>(&Qw[(long)r32*DM+d0*16+hi*8]);
  float mhat=0.f,l_reg=0.f;f32x16 o[2];o[0]=f32x16{};o[1]=f32x16{};
  #define BIASFILL(C0,C1,t) do{ const __attribute__((address_space(3))) float* bp_=biasl+64*(t)+4*hi; \
    _Pragma("unroll") for(int g_=0;g_<4;++g_){ const f32x4v v_=*(const __attribute__((address_space(3))) f32x4v*)(bp_+8*g_); const f32x4v w_=*(const __attribute__((address_space(3))) f32x4v*)(bp_+32+8*g_); \
      _Pragma("unroll") for(int i_=0;i_<4;++i_){ C0[4*g_+i_]=v_[i_]-mhat; C1[4*g_+i_]=w_[i_]-mhat; } } }while(0)
  const int qrel=wid*QBLK+r32;
  #define CMASK(P0,P1,t) do{int jb_=(t)-(NT-4); if(jb_>=0)cmask(P0,P1,jb_,qrel,hi);}while(0)
  bool resc=false;
  #define START(P0,P1) do{ const float rm=rowmax(P0,P1); resc=false; \
    { const float dl=rm; mhat=fadd_s(mhat,dl); \
      _Pragma("unroll") for(int r=0;r<16;++r){P0[r]=fsub_s(P0[r],dl);P1[r]=fsub_s(P1[r],dl);} \
      } \
    _Pragma("unroll") for(int r=0;r<16;++r)P0[r]=__builtin_amdgcn_exp2f(P0[r]); }while(0)
  #define RESC() do{ if(resc){ asm volatile("s_waitcnt lgkmcnt(0)":::"memory"); \
      _Pragma("unroll") for(int d_=0;d_<2;++d_) _Pragma("unroll") for(int r=0;r<16;++r)o[d_][r]*=wsf[crow(r,hi)]; } }while(0)
  f32x16 pA0,pA1,pB0,pB1;
  int sl_prev=0,sl_cur=0,sl_next=SLOTB;
  #define ROT() do{sl_prev=sl_cur;sl_cur=sl_next;sl_next=(sl_next==(NSLOT-1)*SLOTB)?0:sl_next+SLOTB;}while(0)
  DMA_K(2,2*SLOTB);
  WAIT_BAR(3);
  BIASFILL(pA0,pA1,0); qkt(pA0,pA1,Kbase,qr,r32,hi);asm volatile("s_nop 15\n\ts_nop 7":"+v"(pA0),"+v"(pA1));CMASK(pA0,pA1,0);
  START(pA0,pA1);
  _Pragma("unroll") for(int r=0;r<16;++r)pA1[r]=__builtin_amdgcn_exp2f(pA1[r]);
  WAIT_BAR(0);
  DMA_K(3,0);DMA_V(1,SLOTB);
  ROT();
  kload8(kf,kp0+sl_cur);
  WAIT_BAR(2);
  s16x4 vlo[8],vhi[8]; u32x4 pw0,pw1,pw2,pw3;
  #define PKW(P,B) cvtpk_s(P[B],P[B+1])
  #define PAF(k) __builtin_bit_cast(bf16x8,pw##k)
  #define VFR(i) (bf16x8){vlo[i][0],vlo[i][1],vlo[i][2],vlo[i][3],vhi[i][0],vhi[i][1],vhi[i][2],vhi[i][3]}
  #define PIN(x) asm volatile("":"+v"(x))
  #define MX3(a,b,c) __builtin_fmaxf(__builtin_fmaxf((a),(b)),(c))
  #define GAPA(MF,A0,A1,A2,A3,W0,W1,PW) do{ MF; sacc+=A0; sacc+=A1; sacc+=A2; sacc+=A3; PIN(sacc); W0; W1; PIN(PW); SBAR(); }while(0)
  #define EX(v) __builtin_amdgcn_exp2f(v)
  #define GAPB(MF,X,B) do{ MF; X[B]=EX(X[B]); X[B+1]=EX(X[B+1]); X[B+2]=EX(X[B+2]); X[B+3]=EX(X[B+3]); PIN(X); SBAR(); }while(0)
  #define VRD(i) do{ vlo[i]=vtr(vp_+(((i)>>2)*4096+((i)&3)*1024)); vhi[i]=vtr(vp_+(((i)>>2)*4096+((i)&3)*1024+512)); }while(0)
  #define KRD(G,j) do{ if(G){ kload2(kf,kp0+sl_next,j); SBAR(); } }while(0)
  #define STEP(C0,C1,P0,P1,t,GK,GV,GL) do{ SBAR(); \
    BIASFILL(C0,C1,t); SBAR(); \
    const lds_cptr vp_=vp0+sl_prev; \
    VRD(0); SBAR(); float sacc=(P0[0]+P0[1]); \
    GAPA(C0=__builtin_amdgcn_mfma_f32_32x32x16_bf16(kf[0],qr[0],C0,0,0,0), P0[2],P0[3],P0[4],P0[5],     pw0[0]=PKW(P0,0), pw0[1]=PKW(P0,2), pw0); \
    VRD(4); SBAR(); GAPA(C1=__builtin_amdgcn_mfma_f32_32x32x16_bf16(kf[1],qr[0],C1,0,0,0), P0[6],P0[7],P0[8],P0[9],     pw0[2]=PKW(P0,4), pw0[3]=PKW(P0,6), pw0); \
    VRD(1); SBAR(); GAPA(C0=__builtin_amdgcn_mfma_f32_32x32x16_bf16(kf[2],qr[1],C0,0,0,0),   P0[10],P0[11],P0[12],P0[13], pw1[0]=PKW(P0,8), pw1[1]=PKW(P0,10), pw1); \
    VRD(5); SBAR(); GAPA(C1=__builtin_amdgcn_mfma_f32_32x32x16_bf16(kf[3],qr[1],C1,0,0,0),   P0[14],P0[15],P1[0],P1[1],   pw1[2]=PKW(P0,12),pw1[3]=PKW(P0,14), pw1); \
    VRD(2); SBAR(); GAPA(C0=__builtin_amdgcn_mfma_f32_32x32x16_bf16(kf[4],qr[2],C0,0,0,0),   P1[2],P1[3],P1[4],P1[5],     pw2[0]=PKW(P1,0), pw2[1]=PKW(P1,2), pw2); \
    VRD(6); SBAR(); GAPA(C1=__builtin_amdgcn_mfma_f32_32x32x16_bf16(kf[5],qr[2],C1,0,0,0),   P1[6],P1[7],P1[8],P1[9],     pw2[2]=PKW(P1,4), pw2[3]=PKW(P1,6), pw2); \
    VRD(3); SBAR(); GAPA(C0=__builtin_amdgcn_mfma_f32_32x32x16_bf16(kf[6],qr[3],C0,0,0,0),   P1[10],P1[11],P1[12],P1[13], pw3[0]=PKW(P1,8), pw3[1]=PKW(P1,10), pw3); \
    VRD(7); SBAR(); GAPA(C1=__builtin_amdgcn_mfma_f32_32x32x16_bf16(kf[7],qr[3],C1,0,0,0),   P1[14],P1[15],0.f,0.f,       pw3[2]=PKW(P1,12),pw3[3]=PKW(P1,14), pw3); \
    l_reg+=sacc; \
    if(GK){DMA_K((t)+3,sl_cur);} if(GV){DMA_V((t)+1,sl_next);} \
    CMASK(C0,C1,t); \
    { float a=MX3(C0[0],C0[1],C1[0]),b=MX3(C0[2],C0[3],C1[1]); a=MX3(a,C1[2],C1[3]); \
      _Pragma("unroll") for(int r=4;r<16;r+=4){a=MX3(a,C0[r],C0[r+1]);b=MX3(b,C0[r+2],C0[r+3]);a=MX3(a,C1[r],C1[r+1]);b=MX3(b,C1[r+2],C1[r+3]);} \
      float rm=__builtin_fmaxf(a,b); { auto rr=__builtin_amdgcn_permlane32_swap(__float_as_uint(rm),__float_as_uint(rm),false,false); rm=__builtin_fmaxf(__uint_as_float(rr[0]),__uint_as_float(rr[1])); } \
      resc=false; \
      if(__builtin_expect(__any(rm>(float)THRL),0)){ const float dl=__builtin_fmaxf(rm,0.f); mhat+=dl; \
        _Pragma("unroll") for(int r=0;r<16;++r){C0[r]-=dl;C1[r]-=dl;} \
        const float f=__builtin_amdgcn_exp2f(-dl); l_reg*=f; if(hi==0)wsf[r32]=f; resc=true; } } \
    SBAR(); \
    GAPB(o[0]=__builtin_amdgcn_mfma_f32_32x32x16_bf16(PAF(0),VFR(0),o[0],0,0,0), C0,0); \
    GAPB(o[1]=__builtin_amdgcn_mfma_f32_32x32x16_bf16(PAF(0),VFR(4),o[1],0,0,0), C0,4); \
    KRD(GL,0); GAPB(o[0]=__builtin_amdgcn_mfma_f32_32x32x16_bf16(PAF(1),VFR(1),o[0],0,0,0), C0,8); \
    KRD(GL,1); GAPB(o[1]=__builtin_amdgcn_mfma_f32_32x32x16_bf16(PAF(1),VFR(5),o[1],0,0,0), C0,12); \
    KRD(GL,2); GAPB(o[0]=__builtin_amdgcn_mfma_f32_32x32x16_bf16(PAF(2),VFR(2),o[0],0,0,0), C1,0); \
    KRD(GL,3); GAPB(o[1]=__builtin_amdgcn_mfma_f32_32x32x16_bf16(PAF(2),VFR(6),o[1],0,0,0), C1,4); \
    GAPB(o[0]=__builtin_amdgcn_mfma_f32_32x32x16_bf16(PAF(3),VFR(3),o[0],0,0,0), C1,8); \
    GAPB(o[1]=__builtin_amdgcn_mfma_f32_32x32x16_bf16(PAF(3),VFR(7),o[1],0,0,0), C1,12); \
    }while(0)
  int t=1;
  #undef CMASK
  #define CMASK(P0,P1,t) do{}while(0)
  for(;t+5<NT;t+=2){
    STEP(pB0,pB1,pA0,pA1,t,true,true,true);     WAIT_BAR(2); RESC(); ROT();
    STEP(pA0,pA1,pB0,pB1,t+1,true,true,true);   WAIT_BAR(2); RESC(); ROT();
  }
  #undef CMASK
  #define CMASK(P0,P1,t) do{int jb_=(t)-(NT-4); if(jb_>=0)cmask(P0,P1,jb_,qrel,hi);}while(0)
  #define ENDW(tt) do{ if((tt)+3<NT){WAIT_BAR(2);} else if((tt)+2<NT){WAIT_BAR(1);} else {WAIT_BAR(0);} }while(0)
  for(;t+1<NT;t+=2){
    STEP(pB0,pB1,pA0,pA1,t,(t+3<NT),(t+1<NT),(t+1<NT));       ENDW(t);   RESC(); ROT();
    STEP(pA0,pA1,pB0,pB1,t+1,(t+4<NT),(t+2<NT),(t+2<NT));     ENDW(t+1); RESC(); ROT();
  }
  STEP(pB0,pB1,pA0,pA1,NT-1,false,false,false); RESC();
  { float sacc=pB0[0]+pB0[1]; _Pragma("unroll") for(int r=2;r<16;++r)sacc+=pB0[r]; _Pragma("unroll") for(int r=0;r<16;++r)sacc+=pB1[r]; l_reg+=sacc;
    pw0=(u32x4){PKW(pB0,0),PKW(pB0,2),PKW(pB0,4),PKW(pB0,6)};pw1=(u32x4){PKW(pB0,8),PKW(pB0,10),PKW(pB0,12),PKW(pB0,14)};pw2=(u32x4){PKW(pB1,0),PKW(pB1,2),PKW(pB1,4),PKW(pB1,6)};pw3=(u32x4){PKW(pB1,8),PKW(pB1,10),PKW(pB1,12),PKW(pB1,14)};
    SBAR(); pv(o,vb0+sl_cur,PAF(0),PAF(1),PAF(2),PAF(3)); }
  #undef PKW
  #undef PAF
  #undef VFR
  #undef PIN
  #undef MX3
  #undef GAPA
  #undef GAPB
  #undef EX
  #undef VRD
  #undef KRD
  #undef STEP
  #undef ENDW
  {auto rr=__builtin_amdgcn_permlane32_swap(__float_as_uint(l_reg),__float_as_uint(l_reg),false,false);l_reg=__uint_as_float(rr[0])+__uint_as_float(rr[1]);}
  if(hi==0)wsf[32+r32]=l_reg;asm volatile("s_waitcnt lgkmcnt(0)":::"memory");
  float rli[16];
  #pragma unroll
  for(int r=0;r<16;++r)rli[r]=__builtin_amdgcn_rcpf(wsf[32+crow(r,hi)]);
  bf16*Ow=O+(rowbase+q0+wid*QBLK)*DM+h*D;
  { bf16*stg=(bf16*)(shm+LDS_OST)+wid*2048;
    #pragma unroll
    for(int r=0;r<16;++r){const int orow=crow(r,hi);
      #pragma unroll
      for(int d0=0;d0<2;++d0)stg[orow*64+d0*32+r32]=__float2bfloat16(o[d0][r]*rli[r]);}
    asm volatile("s_waitcnt lgkmcnt(0)":::"memory");
    #pragma unroll
    for(int i=0;i<4;++i){const int row=i*8+(lane>>3),ch=lane&7; const u32x4 v=*(const u32x4*)(stg+row*64+ch*8); ATTN_STORE16(Ow+(long)row*DM+ch*8,v);} }
  asm volatile("s_waitcnt lgkmcnt(0)\n\ts_barrier":::"memory");
  #undef DMA_K
  #undef DMA_V
  #undef CMASK
  #undef START
  #undef RESC
  #undef ROT
  #undef BIASFILL
}
constexpr int ATTN_LDS_BYTES=LDS_BYTES;
#undef SBAR
#undef WAIT_BAR
}

constexpr size_t MiB = 1u << 20;
constexpr size_t WS_CTL = 0, CTL_BYTES = 1 * MiB;
constexpr int CW_QCTR = 0;
constexpr int CW_CNT = 1024;
constexpr int CW_KMEAN = 4096;
constexpr size_t WS_W = 1 * MiB;
constexpr size_t W_IN = 0, W_G = W_IN + (size_t)NQKV * 1024, W_PA = W_G + (size_t)NG * 1024, W_PB = W_PA + 1024 * 384, W_PC = W_PB + 1024 * 256,
                 W_O = W_PC + 1024 * 384, W_GU = W_O + 1024 * 1024, W_D = W_GU + (size_t)2 * DFF * 1024, W_LAYER = W_D + (size_t)1024 * DFF;
static_assert(WS_W + 2 * W_LAYER * 2 <= 69 * MiB, "weights");
constexpr size_t WS_ROPE = 69 * MiB;
constexpr size_t WS_LF = 70 * MiB;
constexpr size_t WS_CUM = 71 * MiB;
constexpr size_t WS_LSEB = 72 * MiB;
constexpr size_t WS_XB = 76 * MiB;
constexpr size_t WS_QA = 140 * MiB, WS_KA = 164 * MiB, WS_VA = 188 * MiB, WS_QB = 212 * MiB, WS_KB = 260 * MiB, WS_VB = 276 * MiB,
                 WS_QC = 292 * MiB, WS_KC = 316 * MiB, WS_VC = 340 * MiB;
constexpr size_t WS_H = 140 * MiB;
constexpr size_t WS_PO = 364 * MiB;
constexpr size_t WS_PLSE = 460 * MiB;
constexpr size_t WS_LIST = 463 * MiB;
constexpr size_t WS_GS = 364 * MiB;
constexpr size_t WS_MG = 428 * MiB;
constexpr size_t WS_END = 492 * MiB;
constexpr int LIST_PER_BH = 256 * 2016;
__device__ __forceinline__ int list_off(int bh, int n) { return bh * LIST_PER_BH + 256 * (63 * n - (n * (n - 1)) / 2); }

constexpr int LDS_QW = 150 * 1024;
constexpr int LDS_BYTES = 152 * 1024;
static_assert(attn_body::ATTN_LDS_BYTES <= LDS_QW && pg8::STAGE_BYTES <= LDS_QW, "lds");

__constant__ double ROPE_FR[8] = {0.15915494309189535, 0.03086376340470123, 0.005985185712713705, 0.0011606636412400608,
                                  0.00022507907903927653, 4.364795279280289e-05, 8.464330808241401e-06, 1.6414262627950345e-06};

struct Args { const float* in[16]; float* out; unsigned char* ws; };
typedef const __attribute__((address_space(4))) Args* CArgs;

__device__ __forceinline__ float wave_sum(float v) {
#pragma unroll
    for (int o = 1; o < 64; o <<= 1) v += __shfl_xor(v, o);
    return v;
}
__device__ __forceinline__ unsigned f2bf(float f) { unsigned u = __builtin_bit_cast(unsigned, f); return (u + 0x7fffu + ((u >> 16) & 1u)) >> 16; }
__device__ __forceinline__ unsigned pk2(float lo, float hi) { return f2bf(lo) | (f2bf(hi) << 16); }

__device__ __forceinline__ void transpose_item(const float* Wsrc, int ldw, bf16_t* dst, int ldk, LAS float* scr, int lane) {
#pragma unroll 8
    for (int i = 0; i < 32; ++i) { const int kk = 2 * i + (lane >> 5); scr[kk * 33 + (lane & 31)] = Wsrc[(size_t)kk * ldw + (lane & 31)]; }
    asm volatile("s_waitcnt lgkmcnt(0)" ::: "memory");
    const int c = lane & 7;
#pragma unroll
    for (int j = 0; j < 4; ++j) { const int n = (lane >> 3) + 8 * j; const LAS float* s = scr + (8 * c) * 33 + n;
        u32x4 o; o.x = pk2(s[0 * 33], s[1 * 33]); o.y = pk2(s[2 * 33], s[3 * 33]); o.z = pk2(s[4 * 33], s[5 * 33]); o.w = pk2(s[6 * 33], s[7 * 33]);
        *(u32x4*)(dst + (size_t)(n) * ldk + 8 * c) = o; }
    asm volatile("s_waitcnt lgkmcnt(0)" ::: "memory");
}
constexpr int IT_IN = 16 * 112, IT_G = 16 * 96, IT_PA = 6 * 32, IT_PB = 4 * 32, IT_PC = 6 * 32, IT_O = 16 * 32, IT_GU = 16 * 176, IT_D = 44 * 32;
constexpr int IT_LAYER = IT_IN + IT_G + IT_PA + IT_PB + IT_PC + IT_O + IT_GU + IT_D;
__device__ __forceinline__ void prologue_item(CArgs a, int it, LAS float* scr, int lane) {
    const int l = it / IT_LAYER; int r = it % IT_LAYER;
    bf16_t* WL = (bf16_t*)(a->ws + WS_W) + (size_t)l * W_LAYER;
    if (r < IT_IN) { const int kb = r / 112, nb = r % 112, k0 = 64 * kb, n0 = 32 * nb, c0 = n0 < 1152 ? n0 : n0 + 6;
        transpose_item(a->in[3] + (size_t)l * 1024 * DIN + (size_t)k0 * DIN + c0, DIN, WL + W_IN + (size_t)n0 * 1024 + k0, 1024, scr, lane); return; } r -= IT_IN;
    if (r < IT_G) { const int kb = r / 96, nb = r % 96, k0 = 64 * kb, n0 = 32 * nb, c0 = 3590 + n0;
        transpose_item(a->in[3] + (size_t)l * 1024 * DIN + (size_t)k0 * DIN + c0, DIN, WL + W_G + (size_t)n0 * 1024 + k0, 1024, scr, lane); return; } r -= IT_G;
    if (r < IT_PA) { const int kb = r / 32, nb = r % 32, k0 = 64 * kb, n0 = 32 * nb;
        transpose_item(a->in[5] + (size_t)l * 384 * 1024 + (size_t)k0 * 1024 + n0, 1024, WL + W_PA + (size_t)n0 * 384 + k0, 384, scr, lane); return; } r -= IT_PA;
    if (r < IT_PB) { const int kb = r / 32, nb = r % 32, k0 = 64 * kb, n0 = 32 * nb;
        transpose_item(a->in[6] + (size_t)l * 256 * 1024 + (size_t)k0 * 1024 + n0, 1024, WL + W_PB + (size_t)n0 * 256 + k0, 256, scr, lane); return; } r -= IT_PB;
    if (r < IT_PC) { const int kb = r / 32, nb = r % 32, k0 = 64 * kb, n0 = 32 * nb;
        transpose_item(a->in[7] + (size_t)l * 384 * 1024 + (size_t)k0 * 1024 + n0, 1024, WL + W_PC + (size_t)n0 * 384 + k0, 384, scr, lane); return; } r -= IT_PC;
    if (r < IT_O) { const int kb = r / 32, nb = r % 32, k0 = 64 * kb, n0 = 32 * nb;
        transpose_item(a->in[8] + (size_t)l * 1024 * 1024 + (size_t)k0 * 1024 + n0, 1024, WL + W_O + (size_t)n0 * 1024 + k0, 1024, scr, lane); return; } r -= IT_O;
    if (r < IT_GU) { const int kb = r / 176, nb = r % 176, k0 = 64 * kb, n0 = 32 * nb, pn = n0 >> 8, w = n0 & 255;
        const float* src = (w < 128) ? (a->in[11] + (size_t)l * 1024 * DFF + (size_t)k0 * DFF + 128 * pn + w) : (a->in[12] + (size_t)l * 1024 * DFF + (size_t)k0 * DFF + 128 * pn + (w - 128));
        transpose_item(src, DFF, WL + W_GU + (size_t)n0 * 1024 + k0, 1024, scr, lane); return; } r -= IT_GU;
    { const int kb = r / 32, nb = r % 32, k0 = 64 * kb, n0 = 32 * nb;
        transpose_item(a->in[13] + (size_t)l * DFF * 1024 + (size_t)k0 * 1024 + n0, 1024, WL + W_D + (size_t)n0 * DFF + k0, DFF, scr, lane); }
}

__device__ __forceinline__ void ln_phase(const float* src, const float* gam, const float* bet, float* XF, f32x2* ST, bf16_t* XB,
                                         const float* wfa, const float* bfl, float* LF, LAS unsigned char* lds, int tid, int lane, int wave) {
    asm volatile("" : "+v"(tid), "+v"(lane));
    LAS float* wl = (LAS float*)lds;
    if (wfa) { for (int i = tid; i < 6144; i += NWAVES * 64) { const int h = i % 6, k = i / 6; wl[h * 1024 + k] = wfa[(size_t)k * DIN + 1152 + h]; } }
    __syncthreads();
    f32x4 g4[4], b4[4];
#pragma unroll
    for (int j = 0; j < 4; ++j) { g4[j] = *(const f32x4*)(gam + 4 * lane + 256 * j); b4[j] = *(const f32x4*)(bet + 4 * lane + 256 * j); }
    const int NGW = gridDim.x * NWAVES;
    for (int row0 = blockIdx.x * NWAVES + wave; row0 < T; row0 += 2 * NGW) {
        f32x4 v[2][4]; float s[2]; bool ok[2];
#pragma unroll
        for (int u = 0; u < 2; ++u) { const int row = row0 + u * NGW; ok[u] = row < T; const f32x4* xr = (const f32x4*)(src + (size_t)(ok[u] ? row : row0) * DM) + lane; s[u] = 0.f;
#pragma unroll
            for (int j = 0; j < 4; ++j) v[u][j] = xr[64 * j]; }
#pragma unroll
        for (int u = 0; u < 2; ++u) {
#pragma unroll
            for (int j = 0; j < 4; ++j) s[u] += (v[u][j].x + v[u][j].y) + (v[u][j].z + v[u][j].w); }
        float mean[2], s2[2], rstd[2];
#pragma unroll
        for (int u = 0; u < 2; ++u) s[u] = wave_sum(s[u]);
#pragma unroll
        for (int u = 0; u < 2; ++u) { mean[u] = s[u] * (1.f / DM); s2[u] = 0.f;
#pragma unroll
            for (int j = 0; j < 4; ++j) { v[u][j] = v[u][j] - mean[u]; s2[u] += (v[u][j].x * v[u][j].x + v[u][j].y * v[u][j].y) + (v[u][j].z * v[u][j].z + v[u][j].w * v[u][j].w); } }
#pragma unroll
        for (int u = 0; u < 2; ++u) s2[u] = wave_sum(s2[u]);
#pragma unroll
        for (int u = 0; u < 2; ++u) { rstd[u] = 1.f / sqrtf(s2[u] * (1.f / DM) + LN_EPS);
            const int row = row0 + u * NGW;
            if (ok[u]) {
                f32x4* of = (f32x4*)(XF + (size_t)row * DM) + lane; u32x2* ob = (u32x2*)(XB + (size_t)row * DM) + lane;
                if (ST && lane == 0) ST[row] = (f32x2){mean[u], rstd[u]};
#pragma unroll
                for (int j = 0; j < 4; ++j) { v[u][j] = v[u][j] * rstd[u] * g4[j] + b4[j]; if (!ST) of[64 * j] = v[u][j]; u32x2 w; w.x = cvt_pk_bf16(v[u][j].x, v[u][j].y); w.y = cvt_pk_bf16(v[u][j].z, v[u][j].w); ob[64 * j] = w; }
            } }
        if (wfa) {
#pragma unroll
            for (int u = 0; u < 2; ++u) {
                const int row = row0 + u * NGW;
                float d[6];
#pragma unroll
                for (int h = 0; h < 6; ++h) { float acc = 0.f;
#pragma unroll
                    for (int j = 0; j < 4; ++j) { const f32x4 w = *(const LAS f32x4*)(wl + h * 1024 + 4 * lane + 256 * j); acc += (v[u][j].x * w.x + v[u][j].y * w.y) + (v[u][j].z * w.z + v[u][j].w * w.w); }
                    d[h] = wave_sum(acc); }
                if (lane < 6 && ok[u]) { float z = d[0];
#pragma unroll
                    for (int h = 1; h < 6; ++h) z = (lane == h) ? d[h] : z;
                    z += bfl[lane];
                    const float ls = fminf(z, 0.f) - log1pf(expf(-fabsf(z)));
                    const int b = row / SEQ, sidx = row % SEQ; LF[(size_t)(b * 6 + lane) * SEQ + sidx] = ls; }
            }
        }
    }
    __syncthreads();
}

__device__ __forceinline__ void scan_bh(const float* lf, float* cum, LAS unsigned char* lds, int tid, int lane, int wave) {
    asm volatile("" : "+v"(tid), "+v"(lane));
    LAS float* ws = (LAS float*)lds;
    f32x4 v[8]; const f32x4* p = (const f32x4*)(lf + tid * 32);
#pragma unroll
    for (int j = 0; j < 8; ++j) v[j] = p[j];
    float run = 0.f;
#pragma unroll
    for (int j = 0; j < 8; ++j) { run += v[j].x; v[j].x = run; run += v[j].y; v[j].y = run; run += v[j].z; v[j].z = run; run += v[j].w; v[j].w = run; }
    float inc = run;
#pragma unroll
    for (int o = 1; o < 64; o <<= 1) { const float t = __shfl_up(inc, o); if (lane >= o) inc += t; }
    if (lane == 63) ws[wave] = inc;
    __syncthreads();
    float base = inc - run;
    for (int w = 0; w < wave; ++w) base += ws[w];
    f32x4* q = (f32x4*)(cum + tid * 32);
#pragma unroll
    for (int j = 0; j < 8; ++j) q[j] = v[j] + base;
    __syncthreads();
}

__device__ __forceinline__ float sigmoidf_(float x) { return __builtin_amdgcn_rcpf(1.f + __builtin_amdgcn_exp2f(-x * LOG2E)); }

struct EpiInproj {
    static constexpr bool PERM = true;
    unsigned char* ws; const f32x2* rope; int* kmean;
    __device__ __forceinline__ void operator()(const f32x4 (&acc)[2][2][4][2], const pg8::Unit& u, int wr, int wc, int fr, int fq) const {
        const int row0 = u.pm * 256 + wr * 64 + fr;
#pragma unroll
        for (int bj = 0; bj < 2; ++bj) {
            const int cb = 2 * u.pn + bj;
            size_t base; int pitch, c0; bool rope_on = false, km = false; float sc = 1.f;
            if (cb < 3) { base = WS_QA; pitch = 384; c0 = cb * 128; sc = C2; }
            else if (cb < 6) { base = WS_KA; pitch = 384; c0 = (cb - 3) * 128; }
            else if (cb < 9) { base = WS_VA; pitch = 384; c0 = (cb - 6) * 128; }
            else if (cb < 15) { base = WS_QB; pitch = 768; c0 = (cb - 9) * 128; rope_on = true; sc = C2; }
            else if (cb < 17) { base = WS_KB; pitch = 256; c0 = (cb - 15) * 128; rope_on = true; }
            else if (cb < 19) { base = WS_VB; pitch = 256; c0 = (cb - 17) * 128; }
            else if (cb < 22) { base = WS_QC; pitch = 384; c0 = (cb - 19) * 128; rope_on = true; sc = C2; }
            else if (cb < 25) { base = WS_KC; pitch = 384; c0 = (cb - 22) * 128; rope_on = true; km = true; }
            else { base = WS_VC; pitch = 384; c0 = (cb - 25) * 128; }
            bf16_t* dst = (bf16_t*)(ws + base);
            const int colw = c0 + wc * 32 + 8 * fq;
            const bool rl = rope_on && ((wc & 1) == 0) && (fq < 2);
            float ks[8];
#pragma unroll
            for (int i = 0; i < 8; ++i) ks[i] = 0.f;
#pragma unroll
            for (int ai = 0; ai < 2; ++ai)
#pragma unroll
                for (int m = 0; m < 4; ++m) {
                    const int row = row0 + ai * 128 + m * 16;
                    f32x4 v0 = acc[ai][bj][m][0], v1 = acc[ai][bj][m][1];
                    if (rope_on) {
                        float own[8] = {v0.x, v0.y, v0.z, v0.w, v1.x, v1.y, v1.z, v1.w}, oth[8];
#pragma unroll
                        for (int i = 0; i < 8; ++i) oth[i] = __shfl_xor(own[i], 16);
                        if (rl) {
                            const f32x2* rp = rope + (size_t)(row % SEQ) * 8;
                            const float sg = (fq == 0) ? -1.f : 1.f;
#pragma unroll
                            for (int i = 0; i < 8; ++i) { const f32x2 cs = rp[i]; own[i] = own[i] * cs.x + sg * oth[i] * cs.y; }
                            v0 = (f32x4){own[0], own[1], own[2], own[3]}; v1 = (f32x4){own[4], own[5], own[6], own[7]};
                        }
                    }
                    if (km) { ks[0] += v0.x; ks[1] += v0.y; ks[2] += v0.z; ks[3] += v0.w; ks[4] += v1.x; ks[5] += v1.y; ks[6] += v1.z; ks[7] += v1.w; }
                    v0 = v0 * sc; v1 = v1 * sc;
                    u32x4 w; w.x = cvt_pk_bf16(v0.x, v0.y); w.y = cvt_pk_bf16(v0.z, v0.w); w.z = cvt_pk_bf16(v1.x, v1.y); w.w = cvt_pk_bf16(v1.z, v1.w);
                    *(u32x4*)(dst + (size_t)row * pitch + colw) = w;
                }
            if (km) {
#pragma unroll
                for (int i = 0; i < 8; ++i) { float s = ks[i]; s += __shfl_xor(s, 1); s += __shfl_xor(s, 2); s += __shfl_xor(s, 4); s += __shfl_xor(s, 8); ks[i] = s; }
                if (fr == 0) { const int b = u.pm >> 6, blk = u.pm & 63;
#pragma unroll
                    for (int i = 0; i < 8; ++i) { const int col = colw + i; atomicAdd(kmean + ((size_t)((b * 6 + (col >> 6)) * 64 + blk)) * 64 + (col & 63), __float2int_rn(ks[i] * 262144.f)); } }
            }
        }
    }
};

struct EpiSwiglu {
    static constexpr bool PERM = true;
    bf16_t* H;
    __device__ __forceinline__ void operator()(const f32x4 (&acc)[2][2][4][2], const pg8::Unit& u, int wr, int wc, int fr, int fq) const {
        const int row0 = u.pm * 256 + wr * 64 + fr, col0 = u.pn * 128 + wc * 32 + 8 * fq;
#pragma unroll
        for (int ai = 0; ai < 2; ++ai)
#pragma unroll
            for (int m = 0; m < 4; ++m) {
                float h[8];
#pragma unroll
                for (int n = 0; n < 2; ++n)
#pragma unroll
                    for (int i = 0; i < 4; ++i) { const float g = acc[ai][0][m][n][i], up = acc[ai][1][m][n][i]; h[4 * n + i] = g * sigmoidf_(g) * up; }
                u32x4 w; w.x = cvt_pk_bf16(h[0], h[1]); w.y = cvt_pk_bf16(h[2], h[3]); w.z = cvt_pk_bf16(h[4], h[5]); w.w = cvt_pk_bf16(h[6], h[7]);
                *(u32x4*)(H + (size_t)(row0 + ai * 128 + m * 16) * DFF + col0) = w;
                asm volatile("" ::: "memory");
            }
    }
};

struct EpiResid {
    static constexpr bool PERM = true;
    const float* src; float* X; const f32x2* ST; const float* gam; const float* bet;
    __device__ __forceinline__ void operator()(const f32x4 (&acc)[2][2][4][2], const pg8::Unit& u, int wr, int wc, int fr, int fq) const {
        const int row0 = u.pm * 256 + wr * 64 + fr, col0 = u.pn * 256 + wc * 32 + 8 * fq;
        f32x4 g[2][2], b[2][2];
#pragma unroll
        for (int bj = 0; bj < 2; ++bj)
#pragma unroll
            for (int n = 0; n < 2; ++n) { g[bj][n] = *(const f32x4*)(gam + col0 + bj * 128 + 4 * n); b[bj][n] = *(const f32x4*)(bet + col0 + bj * 128 + 4 * n); }
#pragma unroll
        for (int ai = 0; ai < 2; ++ai)
#pragma unroll
            for (int m = 0; m < 4; ++m) {
                const int row = row0 + ai * 128 + m * 16;
                const f32x2 st = ST[row];
#pragma unroll
                for (int bj = 0; bj < 2; ++bj) {
                    const size_t off = (size_t)row * DM + col0 + bj * 128;
                    const f32x4 s0 = *(const f32x4*)(src + off), s1 = *(const f32x4*)(src + off + 4);
                    const f32x4 x0 = (s0 - st.x) * st.y * g[bj][0] + b[bj][0], x1 = (s1 - st.x) * st.y * g[bj][1] + b[bj][1];
                    *(f32x4*)(X + off) = x0 * DN_ALPHA + acc[ai][bj][m][0]; *(f32x4*)(X + off + 4) = x1 * DN_ALPHA + acc[ai][bj][m][1];
                    asm volatile("" ::: "memory");
                }
            }
    }
};

struct EpiGate {
    static constexpr bool PERM = true;
    bf16_t* GS;
    __device__ __forceinline__ void operator()(const f32x4 (&acc)[2][2][4][2], const pg8::Unit& u, int wr, int wc, int fr, int fq) const {
        const int row0 = u.pm * 256 + wr * 64 + fr, col0 = u.pn * 256 + wc * 32 + 8 * fq;
#pragma unroll
        for (int ai = 0; ai < 2; ++ai)
#pragma unroll
            for (int m = 0; m < 4; ++m)
#pragma unroll
                for (int bj = 0; bj < 2; ++bj) {
                    const f32x4 a = acc[ai][bj][m][0], b = acc[ai][bj][m][1];
                    u32x4 w; w.x = cvt_pk_bf16(sigmoidf_(a.x), sigmoidf_(a.y)); w.y = cvt_pk_bf16(sigmoidf_(a.z), sigmoidf_(a.w));
                    w.z = cvt_pk_bf16(sigmoidf_(b.x), sigmoidf_(b.y)); w.w = cvt_pk_bf16(sigmoidf_(b.z), sigmoidf_(b.w));
                    *(u32x4*)(GS + (size_t)(row0 + ai * 128 + m * 16) * DM + col0 + bj * 128) = w;
                }
    }
};

template <int FIRST> struct EpiBranch {
    static constexpr bool PERM = true;
    const bf16_t* GS; bf16_t* MG;
    __device__ __forceinline__ void operator()(const f32x4 (&acc)[2][2][4][2], const pg8::Unit& u, int wr, int wc, int fr, int fq) const {
        const int row0 = u.pm * 256 + wr * 64 + fr, col0 = u.pn * 256 + wc * 32 + 8 * fq;
#pragma unroll
        for (int ai = 0; ai < 2; ++ai)
#pragma unroll
            for (int m = 0; m < 4; ++m)
#pragma unroll
                for (int bj = 0; bj < 2; ++bj) {
                    const size_t off = (size_t)(row0 + ai * 128 + m * 16) * DM + col0 + bj * 128;
                    const u32x4 gw = *(const u32x4*)(GS + off);
                    const f32x4 a = acc[ai][bj][m][0], b = acc[ai][bj][m][1];
                    float r[8] = {bflo(gw.x) * a.x, bfhi(gw.x) * a.y, bflo(gw.y) * a.z, bfhi(gw.y) * a.w, bflo(gw.z) * b.x, bfhi(gw.z) * b.y, bflo(gw.w) * b.z, bfhi(gw.w) * b.w};
                    if (!FIRST) { const u32x4 mw = *(const u32x4*)(MG + off);
                        r[0] += bflo(mw.x); r[1] += bfhi(mw.x); r[2] += bflo(mw.y); r[3] += bfhi(mw.y); r[4] += bflo(mw.z); r[5] += bfhi(mw.z); r[6] += bflo(mw.w); r[7] += bfhi(mw.w); }
                    u32x4 w; w.x = cvt_pk_bf16(r[0], r[1]); w.y = cvt_pk_bf16(r[2], r[3]); w.z = cvt_pk_bf16(r[4], r[5]); w.w = cvt_pk_bf16(r[6], r[7]);
                    *(u32x4*)(MG + off) = w;
                    asm volatile("" ::: "memory");
                }
    }
};

typedef short v4i16_t __attribute__((ext_vector_type(4)));
__device__ __forceinline__ int crow(int r, int hi) { return (r & 3) + 8 * (r >> 2) + 4 * hi; }
__device__ __forceinline__ float half_max(float m) { auto rr = __builtin_amdgcn_permlane32_swap(__float_as_uint(m), __float_as_uint(m), false, false); return fmaxf(__uint_as_float(rr[0]), __uint_as_float(rr[1])); }
__device__ __forceinline__ float half_sum(float m) { auto rr = __builtin_amdgcn_permlane32_swap(__float_as_uint(m), __float_as_uint(m), false, false); return __uint_as_float(rr[0]) + __uint_as_float(rr[1]); }

__device__ __forceinline__ void small_attn(const bf16_t* qrow, int ntiles, const bf16_t* Kb, const bf16_t* Vb, int pitch,
                                           int kc0, int kstride, int koff, int qc, int span, LAS unsigned char* vscr, int lane,
                                           f32x16 (&o)[2], float& lse2, const float* cumb = nullptr) {
    asm volatile("" : "+v"(lane));
    const int r32 = lane & 31, hi = lane >> 5;
    bf16x8 qr[4];
#pragma unroll
    for (int d0 = 0; d0 < 4; ++d0) qr[d0] = *(const bf16x8*)(qrow + d0 * 16 + hi * 8);
    o[0] = f32x16{}; o[1] = f32x16{};
    float m = -1e30f, l = 0.f;
    const int lr = lane >> 3, lc = lane & 7;
    LAS unsigned char* kscr = vscr + 4608;
    LAS unsigned char* kw = kscr + lr * 144 + lc * 16;
    LAS unsigned char* vw = vscr + lr * 144 + lc * 16;
    const LAS unsigned char* kfr = kscr + r32 * 144 + 16 * hi;
    const LAS unsigned char* vt = vscr + (4 * hi + ((lane & 15) >> 2)) * 144 + (16 * ((lane >> 4) & 1) + 4 * (lane & 3)) * 2;
#define SA_LOAD(KF, VV, tt) do { const int t_ = (tt) < ntiles ? (tt) : ntiles - 1; \
        _Pragma("unroll") for (int i_ = 0; i_ < 4; ++i_) { const int kk_ = kc0 + 32 * t_ + lr + 8 * i_; const size_t off_ = (size_t)((kk_ < 0 ? 0 : kk_) * kstride + koff) * pitch + 8 * lc; \
            KF[i_] = *(const bf16x8*)(Kb + off_); VV[i_] = *(const bf16x8*)(Vb + off_); } \
        __builtin_amdgcn_sched_barrier(0); } while (0)
#define SA_COMPUTE(KF, VV, tt) do { \
        _Pragma("unroll") for (int i_ = 0; i_ < 4; ++i_) { *(LAS bf16x8*)(kw + 8 * 144 * i_) = KF[i_]; *(LAS bf16x8*)(vw + 8 * 144 * i_) = VV[i_]; } \
        f32x16 p = f32x16{}; \
        _Pragma("unroll") for (int d0 = 0; d0 < 4; ++d0) { const bf16x8 kf_ = *(const LAS bf16x8*)(kfr + 32 * d0); p = __builtin_amdgcn_mfma_f32_32x32x16_bf16(kf_, qr[d0], p, 0, 0, 0); } \
        const int kcb = kc0 + 32 * (tt); float rm = -INFINITY; \
        _Pragma("unroll") for (int r = 0; r < 16; ++r) { const int kc = kcb + crow(r, hi); const bool ok = (kc >= 0) && (kc <= qc) && (qc - kc <= span); \
            if (cumb) p[r] -= cumb[kc < 0 ? 0 : kc] * LOG2E; \
            p[r] = ok ? p[r] : -INFINITY; rm = fmaxf(rm, p[r]); } \
        rm = half_max(rm); \
        const float mn = fmaxf(m, rm); const float f = __builtin_amdgcn_exp2f(m - mn); m = mn; \
        float ls = 0.f; \
        _Pragma("unroll") for (int r = 0; r < 16; ++r) { p[r] = __builtin_amdgcn_exp2f(p[r] - mn); ls += p[r]; } \
        l = l * f + ls; \
        _Pragma("unroll") for (int r = 0; r < 16; ++r) { o[0][r] *= f; o[1][r] *= f; } \
        u32x4 pw0, pw1; \
        pw0.x = cvt_pk_bf16(p[0], p[1]); pw0.y = cvt_pk_bf16(p[2], p[3]); pw0.z = cvt_pk_bf16(p[4], p[5]); pw0.w = cvt_pk_bf16(p[6], p[7]); \
        pw1.x = cvt_pk_bf16(p[8], p[9]); pw1.y = cvt_pk_bf16(p[10], p[11]); pw1.z = cvt_pk_bf16(p[12], p[13]); pw1.w = cvt_pk_bf16(p[14], p[15]); \
        const bf16x8 pb0 = __builtin_bit_cast(bf16x8, pw0), pb1 = __builtin_bit_cast(bf16x8, pw1); \
        _Pragma("unroll") for (int d0 = 0; d0 < 2; ++d0) { \
            _Pragma("unroll") for (int s_ = 0; s_ < 2; ++s_) { \
                const v4i16_t lo = __builtin_amdgcn_ds_read_tr16_b64_v4i16((LAS v4i16_t*)(vt + (16 * s_) * 144 + d0 * 64)); \
                const v4i16_t hh = __builtin_amdgcn_ds_read_tr16_b64_v4i16((LAS v4i16_t*)(vt + (16 * s_ + 8) * 144 + d0 * 64)); \
                const bf16x8 vf = (bf16x8){lo[0], lo[1], lo[2], lo[3], hh[0], hh[1], hh[2], hh[3]}; \
                o[d0] = __builtin_amdgcn_mfma_f32_32x32x16_bf16(vf, s_ == 0 ? pb0 : pb1, o[d0], 0, 0, 0); } } \
    } while (0)
    bf16x8 kA[4], vA[4], kB[4], vB[4], kC[4], vC[4];
    SA_LOAD(kA, vA, 0); SA_LOAD(kB, vB, 1);
    for (int t = 0; t < ntiles; t += 3) {
        SA_LOAD(kC, vC, t + 2); SA_COMPUTE(kA, vA, t);
        if (t + 1 >= ntiles) break;
        SA_LOAD(kA, vA, t + 3); SA_COMPUTE(kB, vB, t + 1);
        if (t + 2 >= ntiles) break;
        SA_LOAD(kB, vB, t + 4); SA_COMPUTE(kC, vC, t + 2);
    }
#undef SA_LOAD
#undef SA_COMPUTE
    l = half_sum(l);
    const float rl = 1.f / l;
#pragma unroll
    for (int r = 0; r < 16; ++r) { o[0][r] *= rl; o[1][r] *= rl; }
    lse2 = m + __builtin_amdgcn_logf(l);
}
__device__ __forceinline__ void small_store(bf16_t* orow, const f32x16 (&o)[2], int hi) {
#pragma unroll
    for (int d0 = 0; d0 < 2; ++d0)
#pragma unroll
        for (int g = 0; g < 4; ++g) { u32x2 w; w.x = cvt_pk_bf16(o[d0][4 * g], o[d0][4 * g + 1]); w.y = cvt_pk_bf16(o[d0][4 * g + 2], o[d0][4 * g + 3]);
            *(u32x2*)(orow + 32 * d0 + 8 * g + 4 * hi) = w; }
}

__device__ __forceinline__ void gating_phase(CArgs a, int layer, LAS unsigned char* lds, int tid) {
    asm volatile("" : "+v"(tid));
    unsigned* ctl = (unsigned*)(a->ws + WS_CTL);
    const int* kmean = (const int*)(ctl + CW_KMEAN + 49152 * layer);
    unsigned* cnt = ctl + CW_CNT + 1024 * layer;
    unsigned* list = (unsigned*)(a->ws + WS_LIST);
    const bf16_t* QC = (const bf16_t*)(a->ws + WS_QC);
    const int half = tid >> 8, ht = tid & 255;
    LAS float* km = (LAS float*)(lds + half * 16384);
    for (int u0 = 0; u0 < 768; u0 += 2 * (int)gridDim.x) {
        const int u = u0 + 2 * (int)blockIdx.x + half; const bool active = u < 768;
        const int bh = active ? (u >> 6) : 0, ob = active ? (u & 63) : 0;
        for (int i = ht; i < ob * 64; i += 256) km[i] = (float)kmean[bh * 4096 + i] * (1.f / 262144.f);
        __syncthreads();
        if (active && ob > 0) {
            const int b = bh / 6, h = bh % 6, t = ob * 256 + ht;
            const u32x4* qp = (const u32x4*)(QC + ((size_t)(b * SEQ + t)) * 384 + h * 64);
            float q[64];
#pragma unroll
            for (int i = 0; i < 8; ++i) { const u32x4 w = qp[i]; q[8 * i] = bflo(w.x); q[8 * i + 1] = bfhi(w.x); q[8 * i + 2] = bflo(w.y); q[8 * i + 3] = bfhi(w.y);
                q[8 * i + 4] = bflo(w.z); q[8 * i + 5] = bfhi(w.z); q[8 * i + 6] = bflo(w.w); q[8 * i + 7] = bfhi(w.w); }
            float v0 = -INFINITY, v1 = -INFINITY, v2 = -INFINITY; int i0 = 0, i1 = 0, i2 = 0;
            for (int n = 0; n < ob; ++n) {
                float d0 = 0.f, d1 = 0.f;
#pragma unroll
                for (int j = 0; j < 16; j += 2) { const f32x4 ka = *(const LAS f32x4*)(km + n * 64 + 4 * j), kb = *(const LAS f32x4*)(km + n * 64 + 4 * j + 4);
                    d0 += (q[4 * j] * ka.x + q[4 * j + 1] * ka.y) + (q[4 * j + 2] * ka.z + q[4 * j + 3] * ka.w);
                    d1 += (q[4 * j + 4] * kb.x + q[4 * j + 5] * kb.y) + (q[4 * j + 6] * kb.z + q[4 * j + 7] * kb.w); }
                const float dot = d0 + d1;
                if (dot > v2) {
                    if (dot > v1) { v2 = v1; i2 = i1; if (dot > v0) { v1 = v0; i1 = i0; v0 = dot; i0 = n; } else { v1 = dot; i1 = n; } }
                    else { v2 = dot; i2 = n; }
                }
            }
            const int nsel = ob < 3 ? ob : 3;
#pragma unroll
            for (int j = 0; j < 3; ++j) if (j < nsel) { const int n = (j == 0) ? i0 : (j == 1) ? i1 : i2;
                const unsigned pos = atomicAdd(cnt + bh * 64 + n, 1u);
                list[list_off(bh, n) + pos] = ((unsigned)t << 2) | (unsigned)j; }
        }
        __syncthreads();
    }
}

__device__ __forceinline__ unsigned my_xcc_id() { return (unsigned)__builtin_amdgcn_s_getreg((3 << 11) | 20) & 7u; }
constexpr int CW_XQ = 3072;
constexpr int PER_X_FOX = 96, PER_X_SEL = 96, PER_X_OWN = 48, PER_X_DIL = 48, PER_X = PER_X_FOX + PER_X_SEL + PER_X_OWN + PER_X_DIL;
constexpr int NU_FOX = 768, NU_SEL = 768, NU_OWN = 384, NU_DIL = 384, NU_TOTAL = NU_FOX + NU_SEL + NU_OWN + NU_DIL;
__device__ __forceinline__ void attention_phase(CArgs a, int layer, LAS unsigned char* lds, char* lds_gen, int tid, int lane, int wave) {
    asm volatile("" : "+v"(tid), "+v"(lane));
    unsigned* ctl = (unsigned*)(a->ws + WS_CTL);
    unsigned* qctr = ctl + CW_QCTR + 64 * layer;
    const unsigned* cnt = ctl + CW_CNT + 1024 * layer;
    const unsigned* list = (const unsigned*)(a->ws + WS_LIST);
    volatile LAS unsigned* qw = (volatile LAS unsigned*)(lds + LDS_QW);
    LAS unsigned char* vscr = lds + wave * 9216;
    bf16_t* QCp = (bf16_t*)(a->ws + WS_QC); const bf16_t* KCp = (const bf16_t*)(a->ws + WS_KC); const bf16_t* VCp = (const bf16_t*)(a->ws + WS_VC);
    bf16_t* PO = (bf16_t*)(a->ws + WS_PO); float* PLSE = (float*)(a->ws + WS_PLSE);
    for (;;) {
        __syncthreads();
        if (tid == 0) *qw = atomicAdd(qctr, 1u);
        __syncthreads();
        const int u = (int)*qw;
        if (u >= NU_TOTAL) break;
        int lane_ = lane; asm volatile("" : "+v"(lane_)); const int r32 = lane_ & 31, hi = lane_ >> 5;
        if (u < NU_FOX) {
            const int qb = 63 - u / 12, bh = u % 12, b = bh / 6, h = bh % 6;
#ifdef FOX_SIMPLE
            {   const int t = 256 * qb + 32 * wave + r32; const size_t tok = (size_t)(b * SEQ + t);
                bf16_t* qrow = (bf16_t*)(a->ws + WS_QA) + tok * 384 + h * 64;
                const bf16_t* Kb = (const bf16_t*)(a->ws + WS_KA) + (size_t)(b * SEQ) * 384 + h * 64; const bf16_t* Vb = (const bf16_t*)(a->ws + WS_VA) + (size_t)(b * SEQ) * 384 + h * 64;
                f32x16 o[2]; float lse2;
                small_attn(qrow, 8 * qb + wave + 1, Kb, Vb, 384, 0, 1, 0, t, 1 << 29, vscr, lane, o, lse2, (const float*)(a->ws + WS_CUM) + (size_t)bh * SEQ);
                small_store(qrow, o, hi); }
#elif !defined(NO_FOX)
#ifdef PROBE_FOX2
            attn_body::attn_unit<24>(b, h, qb, (const attn_body::bf16*)(a->ws + WS_QA), (const attn_body::bf16*)(a->ws + WS_KA), (const attn_body::bf16*)(a->ws + WS_VA),
                                    (attn_body::bf16*)(a->ws + 487 * MiB), (const float*)(a->ws + WS_CUM) + (size_t)bh * SEQ, lds_gen);
#endif
            attn_body::attn_unit<24>(b, h, qb, (const attn_body::bf16*)(a->ws + WS_QA), (const attn_body::bf16*)(a->ws + WS_KA), (const attn_body::bf16*)(a->ws + WS_VA),
                                    (attn_body::bf16*)(a->ws + WS_QA), (const float*)(a->ws + WS_CUM) + (size_t)bh * SEQ, lds_gen);
#endif
        } else if (u < NU_FOX + NU_SEL) {
            const int v = u - NU_FOX, n = v / 12, bh = v % 12, b = bh / 6, h = bh % 6;
            int cn = (int)cnt[bh * 64 + n]; const int cap = (63 - n) * 256; cn = cn < cap ? cn : cap;
            const unsigned* lp = list + list_off(bh, n);
            const bf16_t* Kb = KCp + (size_t)(b * SEQ) * 384 + h * 64; const bf16_t* Vb = VCp + (size_t)(b * SEQ) * 384 + h * 64;
#ifdef PROBE_SMALL2
            for (int rep_ = 0; rep_ < 2; ++rep_)
#endif
            for (int c = wave; c * 32 < cn; c += NWAVES) {
                const int e = c * 32 + r32; const bool valid = e < cn;
                const unsigned ent = lp[valid ? e : 0];
                const int t = (int)(ent >> 2), slot = (int)(ent & 3);
                const size_t tok = (size_t)(b * SEQ + t);
                f32x16 o[2]; float lse2;
                small_attn(QCp + tok * 384 + h * 64, 8, Kb, Vb, 384, 0, 1, 256 * n, 1 << 28, 1 << 29, vscr, lane, o, lse2);
                if (valid) { small_store(PO + ((tok * 6 + h) * 4 + slot) * 64, o, hi); if (hi == 0) PLSE[(tok * 6 + h) * 4 + slot] = lse2; }
            }
        } else if (u < NU_FOX + NU_SEL + NU_OWN) {
            const int v = u - NU_FOX - NU_SEL, bh = v / 32, pr = v % 32, b = bh / 6, h = bh % 6;
            const bf16_t* Kb = KCp + (size_t)(b * SEQ) * 384 + h * 64; const bf16_t* Vb = VCp + (size_t)(b * SEQ) * 384 + h * 64;
#ifdef PROBE_SMALL2
            for (int rep_ = 0; rep_ < 2; ++rep_)
#endif
            for (int s = 0; s < 2; ++s) {
                const int blk = 2 * pr + s, ch = s == 0 ? wave : 7 - wave;
                const int t = 256 * blk + 32 * ch + r32; const size_t tok = (size_t)(b * SEQ + t);
                f32x16 o[2]; float lse2;
                small_attn(QCp + tok * 384 + h * 64, ch + 1, Kb, Vb, 384, 0, 1, 256 * blk, 32 * ch + r32, 1 << 29, vscr, lane, o, lse2);
                small_store(PO + ((tok * 6 + h) * 4 + 3) * 64, o, hi); if (hi == 0) PLSE[(tok * 6 + h) * 4 + 3] = lse2;
            }
        } else {
            const int v = u - NU_FOX - NU_SEL - NU_OWN;
            for (int j4 = 0; j4 < 4; ++j4) {
            const int wu = (v * NWAVES + wave) * 4 + j4;
            const int c512 = wu & 511, rest = wu >> 9, kvh = rest & 3, g = (rest >> 2) % 3, b = rest / 12;
            const int dil = g == 0 ? 1 : (g == 1 ? 4 : 16), cpc = 512 / dil;
            const int res = c512 / cpc, cidx = c512 % cpc, qc0 = 32 * cidx, qc = qc0 + r32, tq = qc * dil + res;
            const size_t tok = (size_t)(b * SEQ + tq);
            bf16_t* qrow = (bf16_t*)(a->ws + WS_QB) + tok * 768 + (g * 4 + kvh) * 64;
            const bf16_t* Kb = (const bf16_t*)(a->ws + WS_KB) + (size_t)(b * SEQ) * 256 + kvh * 64; const bf16_t* Vb = (const bf16_t*)(a->ws + WS_VB) + (size_t)(b * SEQ) * 256 + kvh * 64;
            f32x16 o[2]; float lse2;
            small_attn(qrow, 5, Kb, Vb, 256, qc0 - 128, dil, res, qc, 128, vscr, lane, o, lse2);
            small_store(qrow, o, hi);
            if (hi == 0) ((float*)(a->ws + WS_LSEB))[((size_t)g * T + tok) * 4 + kvh] = lse2;
            }
        }
    }
}

__device__ __forceinline__ void combine_phase(CArgs a, int tid) {
    asm volatile("" : "+v"(tid));
    const size_t gt = (size_t)blockIdx.x * (NWAVES * 64) + tid, gs = (size_t)gridDim.x * (NWAVES * 64);
    bf16_t* QBp = (bf16_t*)(a->ws + WS_QB); const float* LSEB = (const float*)(a->ws + WS_LSEB);
    for (size_t i = gt; i < (size_t)T * 32; i += gs) {
        const int ch = (int)(i & 7), kvh = (int)((i >> 3) & 3); const size_t tok = i >> 5;
        float l[3], w[3];
#pragma unroll
        for (int g = 0; g < 3; ++g) l[g] = LSEB[((size_t)g * T + tok) * 4 + kvh];
        const float mx = fmaxf(l[0], fmaxf(l[1], l[2]));
        float ws_ = 0.f;
#pragma unroll
        for (int g = 0; g < 3; ++g) { w[g] = __builtin_amdgcn_exp2f(l[g] - mx); ws_ += w[g]; }
        const float inv = 1.f / ws_;
        float y[8] = {0.f, 0.f, 0.f, 0.f, 0.f, 0.f, 0.f, 0.f};
#pragma unroll
        for (int g = 0; g < 3; ++g) { const u32x4 ow = *(const u32x4*)(QBp + tok * 768 + (g * 4 + kvh) * 64 + ch * 8); const float wg = w[g] * inv;
            y[0] += wg * bflo(ow.x); y[1] += wg * bfhi(ow.x); y[2] += wg * bflo(ow.y); y[3] += wg * bfhi(ow.y); y[4] += wg * bflo(ow.z); y[5] += wg * bfhi(ow.z); y[6] += wg * bflo(ow.w); y[7] += wg * bfhi(ow.w); }
        u32x4 r; r.x = cvt_pk_bf16(y[0], y[1]); r.y = cvt_pk_bf16(y[2], y[3]); r.z = cvt_pk_bf16(y[4], y[5]); r.w = cvt_pk_bf16(y[6], y[7]);
        *(u32x4*)(QBp + tok * 768 + kvh * 64 + ch * 8) = r;
    }
    bf16_t* QCp = (bf16_t*)(a->ws + WS_QC); const bf16_t* PO = (const bf16_t*)(a->ws + WS_PO); const float* PLSE = (const float*)(a->ws + WS_PLSE);
    for (size_t i = gt; i < (size_t)T * 48; i += gs) {
        const int ch = (int)(i & 7); const size_t th = i >> 3; const int h = (int)(th % 6); const size_t tok = th / 6;
        const int ob = (int)((tok % SEQ) >> 8), nsel = ob < 3 ? ob : 3;
        float l[4], w[4];
#pragma unroll
        for (int j = 0; j < 4; ++j) l[j] = (j == 3 || j < nsel) ? PLSE[th * 4 + j] : -INFINITY;
        const float mx = fmaxf(fmaxf(l[0], l[1]), fmaxf(l[2], l[3]));
        float ws_ = 0.f;
#pragma unroll
        for (int j = 0; j < 4; ++j) { w[j] = __builtin_amdgcn_exp2f(l[j] - mx); ws_ += w[j]; }
        const float inv = 1.f / ws_;
        float y[8] = {0.f, 0.f, 0.f, 0.f, 0.f, 0.f, 0.f, 0.f};
#pragma unroll
        for (int j = 0; j < 4; ++j) if (j == 3 || j < nsel) { const u32x4 ow = *(const u32x4*)(PO + (th * 4 + j) * 64 + ch * 8); const float wg = w[j] * inv;
            y[0] += wg * bflo(ow.x); y[1] += wg * bfhi(ow.x); y[2] += wg * bflo(ow.y); y[3] += wg * bfhi(ow.y); y[4] += wg * bflo(ow.z); y[5] += wg * bfhi(ow.z); y[6] += wg * bflo(ow.w); y[7] += wg * bfhi(ow.w); }
        u32x4 r; r.x = cvt_pk_bf16(y[0], y[1]); r.y = cvt_pk_bf16(y[2], y[3]); r.z = cvt_pk_bf16(y[4], y[5]); r.w = cvt_pk_bf16(y[6], y[7]);
        *(u32x4*)(QCp + tok * 384 + h * 64 + ch * 8) = r;
    }
}

#ifndef MIXER_ON
#define MIXER_ON 1
#endif
#define XB_TMO      128
#define XB_XCNT(j)  (256  + 64 * (j))
#define XB_XSUB(j)  (1280 + 64 * (j))
#define XB_XGEN(j)  (2304 + 64 * (j))
#define XB_TOP      3328
#define XB_TOPGEN   3392
#define XCD_BAR_WORDS 3456
#define XB_SPIN_CAP (1u << 18)

__device__ __forceinline__ unsigned xb_ld(unsigned* p)              { return __hip_atomic_load(p, __ATOMIC_RELAXED, __HIP_MEMORY_SCOPE_AGENT); }
__device__ __forceinline__ unsigned xb_add(unsigned* p, unsigned v) { return __hip_atomic_fetch_add(p, v, __ATOMIC_RELAXED, __HIP_MEMORY_SCOPE_AGENT); }
__device__ __forceinline__ unsigned xb_xcc_id() { return (unsigned)__builtin_amdgcn_s_getreg((3 << 11) | 20) & 0xFu; }
#define XB_SPIN(cond, bar) do { unsigned _sp = 0; while (cond) { __builtin_amdgcn_s_sleep(1); \
    if ((++_sp & 255u) == 0u) { if (xb_ld(&(bar)[XB_TMO])) break; if (_sp > XB_SPIN_CAP) { atomicAdd(&(bar)[XB_TMO], 1u); break; } } } } while (0)

struct XcdBarrier {
    unsigned* bar; unsigned x;
    volatile LAS unsigned* st;
};

__device__ __forceinline__ XcdBarrier xcd_barrier_post(unsigned* bar, volatile LAS unsigned* st) {
    XcdBarrier b; b.bar = bar; b.x = xb_xcc_id(); b.st = st;
    if (threadIdx.x == 0) (void)xb_add(&bar[XB_XCNT(b.x)], 1u);
    return b;
}
__device__ __forceinline__ void xcd_barrier_complete(unsigned* bar, unsigned x, unsigned& nloc, unsigned& nx) {
    const unsigned G = gridDim.x * gridDim.y * gridDim.z;
    unsigned sum, cnt, mine, sp = 0u;
    for (;;) {
        sum = 0u; cnt = 0u; mine = 0u;
#pragma unroll
        for (unsigned j = 0; j < 16; ++j) { const unsigned c = xb_ld(&bar[XB_XCNT(j)]); sum += c; cnt += (c > 0u) ? 1u : 0u; mine = (j == x) ? c : mine; }
        if (sum == G) break;
        __builtin_amdgcn_s_sleep(1);
        if ((++sp & 255u) == 0u) { if (xb_ld(&bar[XB_TMO])) break; if (sp > XB_SPIN_CAP) { atomicAdd(&bar[XB_TMO], 1u); break; } }
    }
    nloc = mine > 0u ? mine : 1u; nx = cnt > 0u ? cnt : 1u;
}

__device__ __forceinline__ void xcd_barrier(const XcdBarrier& b) {
    asm volatile("s_waitcnt vmcnt(0)" ::: "memory");
    __syncthreads();
    if (threadIdx.x == 0) {
        unsigned* bar = b.bar;
        __builtin_amdgcn_s_waitcnt(0);
        unsigned nloc = b.st[0], nx = b.st[1];
        if (nloc == 0u) { xcd_barrier_complete(bar, b.x, nloc, nx); b.st[0] = nloc; b.st[1] = nx; }
        const unsigned old = xb_add(&bar[XB_XSUB(b.x)], 1u);
        const unsigned gen = old / nloc;
        if (old + 1u == (gen + 1u) * nloc) {
            __builtin_amdgcn_fence(__ATOMIC_RELEASE, "agent");
            asm volatile("s_waitcnt vmcnt(0)" ::: "memory");
            const unsigned og = xb_add(&bar[XB_TOP], 1u);
            const unsigned tg = og / nx;
            if (og + 1u == (tg + 1u) * nx) xb_add(&bar[XB_TOPGEN], 1u);
            else XB_SPIN(xb_ld(&bar[XB_TOPGEN]) == tg, bar);
            __builtin_amdgcn_fence(__ATOMIC_ACQUIRE, "agent");
            xb_add(&bar[XB_XGEN(b.x)], 1u);
            asm volatile("s_waitcnt vmcnt(0)" ::: "memory");
        } else {
            XB_SPIN(xb_ld(&bar[XB_XGEN(b.x)]) == gen, bar);
            __builtin_amdgcn_fence(__ATOMIC_ACQUIRE, "agent");
            asm volatile("s_waitcnt vmcnt(0)" ::: "memory");
        }
    }
    __syncthreads();
}

constexpr int CW_BAR = 110016;
static_assert((CW_BAR + XCD_BAR_WORDS) * 4 <= (int)CTL_BYTES, "ctl");
#define GBX() int G = gridDim.x, bx = blockIdx.x; asm volatile("" : "+s"(G), "+s"(bx))
#define AP() ({ CArgs p_ = kp; asm volatile("" : "+s"(p_)); p_; }); GBX()
#define TIDS() int tid_ = threadIdx.x; asm volatile("" : "+v"(tid_)); const int tid = tid_, lane = tid & 63, wave = __builtin_amdgcn_readfirstlane(tid >> 6); (void)lane; (void)wave
#define XBP(a) ((bf16_t*)((a)->ws + WS_XB))
#define LFP(a) ((float*)((a)->ws + WS_LF))
#define STP(a) ((f32x2*)((a)->ws + 74 * MiB))
#define WLP(a) ((const bf16_t*)((a)->ws + WS_W) + (size_t)layer * W_LAYER)
template <int layer> __device__ __forceinline__ void layer_body(const CArgs kp, LAS unsigned char* lds, unsigned char* lds_raw, const XcdBarrier& bar) {
#if MIXER_ON
        { const CArgs a = AP(); TIDS(); if (bx < 12) scan_bh(LFP(a) + (size_t)bx * SEQ, (float*)(a->ws + WS_CUM) + (size_t)bx * SEQ, lds, tid, lane, wave); }
#ifndef NO_INPROJ
        { const CArgs a = AP(); pg8::StaticOrder S; pg8::Gemm g{XBP(a), WLP(a) + W_IN, 1024, 1024, 1024}; S.init(T, NQKV, G, bx);
          EpiInproj E{a->ws, (const f32x2*)(a->ws + WS_ROPE), (int*)((unsigned*)(a->ws + WS_CTL) + CW_KMEAN + 49152 * layer)};
          pg8::gemm_phase<EpiInproj, true>(lds, g, S, E);
#ifdef PROBE_DUP
          pg8::gemm_phase<EpiInproj, true>(lds, g, S, E);
#endif
 }
#endif
        xcd_barrier(bar);
#ifndef NO_GATING
        { const CArgs a = AP(); TIDS(); gating_phase(a, layer, lds, tid); }
#endif
        xcd_barrier(bar);
        { const CArgs a = AP(); TIDS(); attention_phase(a, layer, lds, (char*)lds_raw, tid, lane, wave); }
        xcd_barrier(bar);
        { const CArgs a = AP(); TIDS(); combine_phase(a, tid); }
        xcd_barrier(bar);
        {
            pg8::StaticOrder S; { GBX(); S.init(T, 1024, G, bx); }
            { const CArgs a = AP(); pg8::Gemm g{XBP(a), WLP(a) + W_G, 1024, 1024, 1024}; EpiGate E{(bf16_t*)(a->ws + WS_GS)}; pg8::gemm_phase<EpiGate, true>(lds, g, S, E); }
            { const CArgs a = AP(); pg8::Gemm g{(const bf16_t*)(a->ws + WS_QA), WLP(a) + W_PA, 384, 384, 384}; EpiBranch<1> E{(const bf16_t*)(a->ws + WS_GS), (bf16_t*)(a->ws + WS_MG)}; pg8::gemm_phase<EpiBranch<1>, true>(lds, g, S, E); }
#ifndef ONLY_A
            { const CArgs a = AP(); pg8::Gemm g{XBP(a), WLP(a) + W_G + (size_t)1024 * 1024, 1024, 1024, 1024}; EpiGate E{(bf16_t*)(a->ws + WS_GS)}; pg8::gemm_phase<EpiGate, true>(lds, g, S, E); }
            { const CArgs a = AP(); pg8::Gemm g{(const bf16_t*)(a->ws + WS_QB), WLP(a) + W_PB, 768, 256, 256}; EpiBranch<0> E{(const bf16_t*)(a->ws + WS_GS), (bf16_t*)(a->ws + WS_MG)}; pg8::gemm_phase<EpiBranch<0>, true>(lds, g, S, E); }
            { const CArgs a = AP(); pg8::Gemm g{XBP(a), WLP(a) + W_G + (size_t)2048 * 1024, 1024, 1024, 1024}; EpiGate E{(bf16_t*)(a->ws + WS_GS)}; pg8::gemm_phase<EpiGate, true>(lds, g, S, E); }
            { const CArgs a = AP(); pg8::Gemm g{(const bf16_t*)(a->ws + WS_QC), WLP(a) + W_PC, 384, 384, 384}; EpiBranch<0> E{(const bf16_t*)(a->ws + WS_GS), (bf16_t*)(a->ws + WS_MG)}; pg8::gemm_phase<EpiBranch<0>, true>(lds, g, S, E); }
#endif
        }
        xcd_barrier(bar);
        { const CArgs a = AP(); pg8::StaticOrder S; pg8::Gemm g{(const bf16_t*)(a->ws + WS_MG), WLP(a) + W_O, 1024, 1024, 1024}; S.init(T, 1024, G, bx);
          EpiResid E{layer == 0 ? a->in[0] : (const float*)a->out, a->out, STP(a), layer == 0 ? a->in[1] : a->in[14] + (layer - 1) * DM, layer == 0 ? a->in[2] : a->in[15] + (layer - 1) * DM};
          pg8::gemm_phase<EpiResid, true>(lds, g, S, E); }
        xcd_barrier(bar);
#else
        {
            const CArgs a = AP(); TIDS();
            for (size_t i = (size_t)bx * 512 + tid; i < (size_t)T * DM / 4; i += (size_t)G * 512) { f32x4* p = (f32x4*)a->out + i; *p = *p * DN_ALPHA; }
        }
        xcd_barrier(bar);
#endif
        { const CArgs a = AP(); TIDS(); ln_phase(a->out, a->in[9] + layer * DM, a->in[10] + layer * DM, a->out, STP(a), XBP(a), nullptr, nullptr, nullptr, lds, tid, lane, wave); }
        xcd_barrier(bar);
#ifndef NO_P8
        { const CArgs a = AP(); pg8::StaticOrder S; pg8::Gemm g{XBP(a), WLP(a) + W_GU, 1024, 1024, 1024}; S.init(T, 2 * DFF, G, bx); EpiSwiglu E{(bf16_t*)(a->ws + WS_H)}; pg8::gemm_phase<EpiSwiglu, true>(lds, g, S, E);
#ifdef PROBE_DUP
          pg8::gemm_phase<EpiSwiglu, true>(lds, g, S, E);
#endif
 }
#endif
        xcd_barrier(bar);
#ifndef NO_P9
        { const CArgs a = AP(); pg8::StaticOrder S; pg8::Gemm g{(const bf16_t*)(a->ws + WS_H), WLP(a) + W_D, DFF, DFF, DFF}; S.init(T, 1024, G, bx); EpiResid E{a->out, a->out, STP(a), a->in[9] + layer * DM, a->in[10] + layer * DM}; pg8::gemm_phase<EpiResid, true>(lds, g, S, E); }
#endif
        xcd_barrier(bar);
        if (layer + 1 < DEPTH) {
            { const CArgs a = AP(); TIDS(); ln_phase(a->out, a->in[14] + layer * DM, a->in[15] + layer * DM, a->out, STP(a), XBP(a), a->in[3] + (size_t)(layer + 1) * 1024 * DIN, a->in[4] + (layer + 1) * 6, LFP(a), lds, tid, lane, wave); }
            xcd_barrier(bar);
        } else {
            const CArgs a = AP(); TIDS(); ln_phase(a->out, a->in[14] + layer * DM, a->in[15] + layer * DM, a->out, nullptr, XBP(a), nullptr, nullptr, nullptr, lds, tid, lane, wave);
        }
}

__global__ void __launch_bounds__(NWAVES * 64, 2) fwd_kernel(Args a_unused) {
    extern __shared__ __attribute__((aligned(16))) unsigned char lds_raw[];
    cg::grid_group grid = cg::this_grid();
    LAS unsigned char* lds = (LAS unsigned char*)lds_raw;
    const CArgs kp = (CArgs)__builtin_amdgcn_kernarg_segment_ptr();
    if (threadIdx.x < 16) ((LAS unsigned*)(lds + LDS_QW + 64))[threadIdx.x] = 0u;
    __syncthreads();
    const XcdBarrier bar = xcd_barrier_post((unsigned*)(kp->ws + WS_CTL) + CW_BAR, (volatile LAS unsigned*)(lds + LDS_QW + 64));

    {
        const CArgs a = AP(); TIDS();
        LAS float* scr = (LAS float*)(lds + wave * 16384);
        for (int it = bx * NWAVES + wave; it < 2 * IT_LAYER; it += G * NWAVES) prologue_item(a, it, scr, lane);
        f32x2* rope = (f32x2*)(a->ws + WS_ROPE);
        for (int i = bx * (NWAVES * 64) + tid; i < SEQ * 8; i += G * NWAVES * 64) {
            const int pos = i >> 3, fi = i & 7; double t = (double)pos * ROPE_FR[fi]; t -= floor(t); const float fr = (float)t;
            rope[i] = (f32x2){__builtin_amdgcn_cosf(fr), __builtin_amdgcn_sinf(fr)};
        }
        __syncthreads();
        ln_phase(a->in[0], a->in[1], a->in[2], a->out, STP(a), XBP(a), a->in[3], a->in[4], LFP(a), lds, tid, lane, wave);
    }
    grid.sync();

    layer_body<0>(kp, lds, lds_raw, bar);
    layer_body<1>(kp, lds, lds_raw, bar);
}

extern "C" void kernel_launch(void* const* d_in, const int* in_sizes, int n_in, void* d_out, int out_size, void* d_ws, size_t ws_size, hipStream_t stream) {
    static int grid = 0;
    if (grid == 0) {
        if (n_in != 16 || in_sizes[0] != T * DM || out_size != T * DM || ws_size < WS_END) {
            fprintf(stderr, "kernel_launch: unexpected problem geometry (n_in %d, in0 %d, out %d, ws %zu)\n", n_in, n_in > 0 ? in_sizes[0] : -1, out_size, ws_size); grid = -1; return; }
        int dev = 0, cus = 0, per_cu = 0;
        (void)hipGetDevice(&dev); (void)hipDeviceGetAttribute(&cus, hipDeviceAttributeMultiprocessorCount, dev);
        if (hipFuncSetAttribute((const void*)fwd_kernel, hipFuncAttributeMaxDynamicSharedMemorySize, LDS_BYTES) != hipSuccess) { fprintf(stderr, "kernel_launch: hipFuncSetAttribute failed\n"); grid = -1; return; }
        if (hipOccupancyMaxActiveBlocksPerMultiprocessor(&per_cu, (const void*)fwd_kernel, NWAVES * 64, LDS_BYTES) != hipSuccess || per_cu < 1) { fprintf(stderr, "kernel_launch: occupancy query says %d\n", per_cu); per_cu = 1; }
        (void)hipGetLastError();
        grid = cus * 1;
        if (grid % 8 != 0 || grid <= 0) grid = 256;
    }
    if (grid < 0) return;
    (void)hipMemsetAsync((char*)d_ws + WS_CTL, 0, CTL_BYTES, stream);
    Args a{};
    for (int i = 0; i < 16; ++i) a.in[i] = (const float*)d_in[i];
    a.out = (float*)d_out; a.ws = (unsigned char*)d_ws;
    void* args[] = {&a};
    const hipError_t e = hipLaunchCooperativeKernel((const void*)fwd_kernel, dim3(grid), dim3(NWAVES * 64), args, LDS_BYTES, stream);
    if (e != hipSuccess) fprintf(stderr, "kernel_launch: cooperative launch failed: %s (grid %d)\n", hipGetErrorString(e), grid);
}
```

```cpp
#include <hip/hip_runtime.h>
#include <hip/hip_cooperative_groups.h>
#include <hip/hip_bf16.h>
#include <cstdio>
#include <cstdint>
#include <cmath>
namespace cg = cooperative_groups;

#define LAS __attribute__((address_space(3)))
typedef unsigned short bf16_t;
typedef short bf16x8 __attribute__((ext_vector_type(8)));
typedef short s16x4 __attribute__((ext_vector_type(4)));
typedef float f32x2 __attribute__((ext_vector_type(2)));
typedef float f32x4 __attribute__((ext_vector_type(4)));
typedef float f32x16 __attribute__((ext_vector_type(16)));
typedef unsigned u32x4 __attribute__((ext_vector_type(4)));
typedef unsigned u32x2 __attribute__((ext_vector_type(2)));

constexpr int BATCH = 2, SEQ = 16384, DM = 1024, T = BATCH * SEQ, DEPTH = 2, DFF = 2816, DIN = 6662;
constexpr int NQKV = 3584, NG = 3072;
constexpr float LN_EPS = 1e-5f;
constexpr float DN_ALPHA = 1.4142135623730951f;
constexpr float LOG2E = 1.4426950408889634f;
constexpr float C2 = 0.125f * LOG2E;
constexpr int NWAVES = 8;

typedef __bf16 bf16x2_t __attribute__((ext_vector_type(2)));
__device__ __forceinline__ unsigned cvt_pk_bf16(float lo, float hi) { f32x2 v = {lo, hi}; bf16x2_t b = __builtin_convertvector(v, bf16x2_t); return __builtin_bit_cast(unsigned, b); }
__device__ __forceinline__ float bf2f(unsigned short b) { return __uint_as_float(((unsigned)b) << 16); }
__device__ __forceinline__ float bflo(unsigned w) { return __uint_as_float(w << 16); }
__device__ __forceinline__ float bfhi(unsigned w) { return __uint_as_float(w & 0xffff0000u); }

namespace pg8 {
constexpr int BM = 256, BK = 64, HALF = 128, HTB = HALF * BK * 2, STAGE_BYTES = 8 * HTB, NXCD = 8, WGM = 8;
__host__ __device__ __forceinline__ int lds_byte(int r, int c) { const int st = (r >> 4) * 2 + (c >> 5), rr = r & 15, cc = c & 31, ob = rr * 64 + cc * 2; return st * 1024 + (ob ^ (((ob >> 9) & 1) << 5)); }
__host__ __device__ __forceinline__ void stage_rc(int b, int& R, int& C) { const int st = b / 1024, sb = b % 1024, swz = sb ^ (((sb >> 9) & 1) << 5); R = (st >> 1) * 16 + swz / 64; C = (st & 1) * 32 + (swz % 64) / 2; }
__host__ __device__ __forceinline__ int perm32(int rho) { const int n = rho >> 4, i = rho & 15; return 8 * (i >> 2) + 4 * n + (i & 3); }

struct Unit { int pm, pn; };
struct Gemm { const bf16_t* A; const bf16_t* Bt; int lda, ldb, K; };

struct StaticOrder {
    int nM, nN, nwg, G, c;
    __host__ __device__ void init(int M, int N, int G_, int c_) { nM = M / BM; nN = N / BM; nwg = nM * nN; G = G_; c = c_; }
    __host__ __device__ bool next(int i, Unit& u) const {
        const long L = (long)i * G + c; if (L >= nwg) return false;
        int wgid = (int)L; { const int q = nwg / NXCD, r = nwg % NXCD, xcd = wgid % NXCD, off = wgid / NXCD; wgid = (xcd < r ? xcd * (q + 1) : r * (q + 1) + (xcd - r) * q) + off; }
        const int nig = WGM * nN, gid = wgid / nig, fm = gid * WGM, gsz = (nM - fm) < WGM ? (nM - fm) : WGM;
        u.pm = fm + ((wgid % nig) % gsz); u.pn = (wgid % nig) / gsz; return true;
    }
};

template <class Epi, bool ALIGN_EPI>
__device__ __forceinline__ void gemm_phase(LAS unsigned char* lds, const Gemm g, const StaticOrder& S, const Epi& E) {
    int tid_ = threadIdx.x; asm volatile("" : "+v"(tid_));
    const int tid = tid_, wid = __builtin_amdgcn_readfirstlane(tid >> 6), lane = tid & 63, wr = wid >> 2, wc = wid & 3, fr = lane & 15, fq = lane >> 4;
    const int nt = g.K / BK;
    unsigned voffA[2], voffB[2];
#pragma unroll
    for (int i = 0; i < 2; ++i) { int R, C; stage_rc(tid * 16 + i * 8192, R, C); const int Rb = (R & ~31) + perm32(R & 31);
        voffA[i] = (unsigned)(R * g.lda + C) * 2u; voffB[i] = (unsigned)(Rb * g.ldb + C) * 2u; }
    const size_t kstep = (size_t)(BK * 2);
    const size_t hA = (size_t)HALF * g.lda * 2, hB = (size_t)HALF * g.ldb * 2;
    const size_t tA = 2 * hA, tB = 2 * hB;
    const unsigned ldsw = (unsigned)wid * 1024u;
    const int aoff = lds_byte(wr * 64 + fr, fq * 8), boff = lds_byte(wc * 32 + fr, fq * 8);
#define PG8_SA(b, h) (((b) * 2 + (h)) * HTB)
#define PG8_SB(b, h) ((4 + (b) * 2 + (h)) * HTB)
#define PG8_STAGE(bufoff, gbase, voff) do { _Pragma("unroll") for (int _i = 0; _i < 2; ++_i) \
        __builtin_amdgcn_global_load_lds((const unsigned*)((const char*)(gbase) + (voff)[_i]), (LAS unsigned*)(lds + (bufoff) + ldsw + _i * 8192), 16, 0, 0); } while (0)
#define PG8_LDA(dst, b, h) do { _Pragma("unroll") for (int m = 0; m < 4; ++m) _Pragma("unroll") for (int k = 0; k < 2; ++k) dst[m][k] = *(const LAS bf16x8*)(lds + PG8_SA(b, h) + aoff + m * 2048 + k * 1024); } while (0)
#define PG8_LDB(dst, b, h) do { _Pragma("unroll") for (int n = 0; n < 2; ++n) _Pragma("unroll") for (int k = 0; k < 2; ++k) dst[n][k] = *(const LAS bf16x8*)(lds + PG8_SB(b, h) + boff + n * 2048 + k * 1024); } while (0)
#define PG8_MMA(ai, bj, At, Bt) do { __builtin_amdgcn_s_setprio(1); _Pragma("unroll") for (int m = 0; m < 4; ++m) _Pragma("unroll") for (int n = 0; n < 2; ++n) _Pragma("unroll") for (int k = 0; k < 2; ++k) \
        acc[ai][bj][m][n] = __builtin_amdgcn_mfma_f32_16x16x32_bf16(Bt[n][k], At[m][k], acc[ai][bj][m][n], 0, 0, 0); __builtin_amdgcn_s_setprio(0); } while (0)
#define PG8_WAIT_V(n) asm volatile("s_waitcnt vmcnt(" #n ")" ::: "memory")
#define PG8_WAIT_L(n) asm volatile("s_waitcnt lgkmcnt(" #n ")" ::: "memory")
#define PG8_BAR __builtin_amdgcn_s_barrier()
#define PG8_SCHED __builtin_amdgcn_sched_barrier(0)
    Unit cur, nxt; int ui = 0;
    if (!S.next(0, cur)) return;
    f32x4 acc[2][2][4][2];
#pragma unroll
    for (int a = 0; a < 2; ++a)
#pragma unroll
        for (int b = 0; b < 2; ++b)
#pragma unroll
            for (int m = 0; m < 4; ++m)
#pragma unroll
                for (int n = 0; n < 2; ++n) acc[a][b][m][n] = (f32x4){0.f, 0.f, 0.f, 0.f};
    bf16x8 At[4][2], B0[2][2], B1[2][2];
    const char* cA = (const char*)g.A + (size_t)cur.pm * tA; const char* cB = (const char*)g.Bt + (size_t)cur.pn * tB;
    PG8_STAGE(PG8_SB(0, 0), cB, voffB); PG8_STAGE(PG8_SB(0, 1), cB + hB, voffB); PG8_STAGE(PG8_SA(0, 0), cA, voffA); PG8_STAGE(PG8_SA(0, 1), cA + hA, voffA);
    if (wr == 1) PG8_BAR;
    PG8_WAIT_V(2); PG8_BAR;
    PG8_STAGE(PG8_SB(1, 0), cB + kstep, voffB); PG8_STAGE(PG8_SA(1, 0), cA + kstep, voffA); PG8_STAGE(PG8_SB(1, 1), cB + hB + kstep, voffB);
    PG8_WAIT_V(6); PG8_BAR;
    for (;;) {
        const bool has_next = S.next(ui + 1, nxt);
        const char* nA = has_next ? (const char*)g.A + (size_t)nxt.pm * tA : cA; const char* nB = has_next ? (const char*)g.Bt + (size_t)nxt.pn * tB : cB;
        for (int t = 0; t < nt; t += 2) {
            const bool last = (t == nt - 2);
            const char* a1 = cA + (size_t)(t + 1) * kstep;
            const char* a2 = last ? nA : cA + (size_t)(t + 2) * kstep; const char* b2 = last ? nB : cB + (size_t)(t + 2) * kstep;
            const char* a3 = a2 + kstep; const char* b3 = b2 + kstep;
            PG8_LDB(B0, 0, 0); PG8_LDB(B1, 0, 1); PG8_SCHED; PG8_LDA(At, 0, 0); PG8_STAGE(PG8_SA(1, 1), a1 + hA, voffA);
            PG8_WAIT_V(8); PG8_WAIT_L(0); PG8_BAR; PG8_MMA(0, 0, At, B0); PG8_MMA(0, 1, At, B1); PG8_BAR; PG8_SCHED;
            PG8_LDA(At, 0, 1); PG8_STAGE(PG8_SB(0, 0), b2, voffB); PG8_STAGE(PG8_SB(0, 1), b2 + hB, voffB); PG8_STAGE(PG8_SA(0, 0), a2, voffA);
            PG8_WAIT_V(8); PG8_WAIT_L(0); PG8_BAR; PG8_MMA(1, 0, At, B0); PG8_MMA(1, 1, At, B1); PG8_BAR; PG8_SCHED;
            PG8_LDB(B0, 1, 0); PG8_LDB(B1, 1, 1); PG8_SCHED; PG8_LDA(At, 1, 0); PG8_STAGE(PG8_SA(0, 1), a2 + hA, voffA);
            PG8_WAIT_V(8); PG8_WAIT_L(0); PG8_BAR; PG8_MMA(0, 0, At, B0); PG8_MMA(0, 1, At, B1); PG8_BAR; PG8_SCHED;
            PG8_LDA(At, 1, 1); PG8_STAGE(PG8_SB(1, 0), b3, voffB); PG8_STAGE(PG8_SB(1, 1), b3 + hB, voffB); PG8_STAGE(PG8_SA(1, 0), a3, voffA);
            PG8_WAIT_V(8); PG8_WAIT_L(0); PG8_BAR; PG8_MMA(1, 0, At, B0); PG8_MMA(1, 1, At, B1); PG8_BAR; PG8_SCHED;
        }
        if constexpr (ALIGN_EPI) { if (wr == 0) PG8_BAR; }
        E(acc, cur, wr, wc, fr, fq);
        if (!has_next) break;
#pragma unroll
        for (int a = 0; a < 2; ++a)
#pragma unroll
            for (int b = 0; b < 2; ++b)
#pragma unroll
                for (int m = 0; m < 4; ++m)
#pragma unroll
                    for (int n = 0; n < 2; ++n) acc[a][b][m][n] = (f32x4){0.f, 0.f, 0.f, 0.f};
        cur = nxt; cA = nA; cB = nB; ++ui;
        if constexpr (ALIGN_EPI) { if (wr == 1) PG8_BAR; }
    }
    PG8_WAIT_V(0);
    if constexpr (!ALIGN_EPI) { if (wr == 0) PG8_BAR; }
    PG8_BAR;
#undef PG8_SA
#undef PG8_SB
#undef PG8_STAGE
#undef PG8_LDA
#undef PG8_LDB
#undef PG8_MMA
#undef PG8_WAIT_V
#undef PG8_WAIT_L
#undef PG8_BAR
#undef PG8_SCHED
}
}
namespace attn_body {
using bf16=__hip_bfloat16;
using bf16x8=__attribute__((ext_vector_type(8)))short;
using s16x4=__attribute__((ext_vector_type(4)))short;
using f32x16=__attribute__((ext_vector_type(16)))float;
using u32x4=__attribute__((ext_vector_type(4)))unsigned;
using f32x4v=__attribute__((ext_vector_type(4)))float;
constexpr int BATCH=2,NHEAD=6,SEQ=16384,D=64,DM=NHEAD*D;
constexpr int NW=8,QBLK=32,QB=QBLK*NW,KVBLK=64,NQB=SEQ/QB;
constexpr int ATTN_PITCH=DM, ATTN_UNIT_ROWS=QB;
__device__ __forceinline__ int crow(int r,int hi){return (r&3)+8*(r>>2)+4*hi;}
#define SBAR() __builtin_amdgcn_sched_barrier(0)
__device__ __forceinline__ void cmask(f32x16&p0,f32x16&p1,int jb,int qrel,int hi){
  const float NEG=-INFINITY; int kb=64*jb+4*hi;
  #pragma unroll
  for(int r=0;r<16;++r){int kv=kb+(r&3)+8*(r>>2); if(kv>qrel)p0[r]=NEG; if(kv+32>qrel)p1[r]=NEG;}
}

constexpr int NSLOT=3, SLOTB=8192;
constexpr int LDS_K=0, LDS_V=NSLOT*SLOTB, LDS_WS=2*NSLOT*SLOTB, LDS_OST=LDS_WS+NW*64*4, LDS_BIAS=LDS_OST+NW*4096, LDS_BYTES=LDS_BIAS+SEQ*4;
constexpr float C2=0.125f*1.4426950408889634f;
__device__ __forceinline__ void glds16(const void*gsrc,unsigned lds_dst){unsigned keep;
  asm volatile("s_mov_b32 %0, m0\n\ts_mov_b32 m0, %2\n\ts_nop 0\n\tglobal_load_lds_dwordx4 %1, off\n\ts_mov_b32 m0, %0":"=&s"(keep):"v"(gsrc),"s"(lds_dst):"memory");}
__device__ __forceinline__ float max3f(float a,float b,float c){float r;asm("v_max3_f32 %0, %1, %2, %3":"=v"(r):"v"(a),"v"(b),"v"(c));return r;}
__device__ __forceinline__ float max2f(float a,float b){float r;asm("v_max_f32_e32 %0, %1, %2":"=v"(r):"v"(a),"v"(b));return r;}
__device__ __forceinline__ float fadd_s(float a,float b){float r;asm("v_add_f32_e32 %0, %1, %2":"=v"(r):"v"(a),"v"(b));return r;}
__device__ __forceinline__ float fsub_s(float a,float b){float r;asm("v_sub_f32_e32 %0, %1, %2":"=v"(r):"v"(a),"v"(b));return r;}
typedef float f32x2_t __attribute__((ext_vector_type(2))); typedef __bf16 bf16x2_t __attribute__((ext_vector_type(2)));
__device__ __forceinline__ unsigned cvtpk_s(float lo,float hi){f32x2_t v={lo,hi};bf16x2_t b=__builtin_convertvector(v,bf16x2_t);return __builtin_bit_cast(unsigned,b);}
#define WAIT_BAR(N) asm volatile("s_waitcnt vmcnt(" #N ") lgkmcnt(0)\n\ts_barrier":::"memory")

__device__ __forceinline__ void qkt(f32x16&p0,f32x16&p1,const char*Kslot,const bf16x8*qr,int r32,int hi){
  const char*kb=Kslot+hi*1024+r32*16;
  #pragma unroll
  for(int d0=0;d0<4;++d0){
    const bf16x8 b0=*reinterpret_cast<const bf16x8*>(kb+d0*2048);
    const bf16x8 b1=*reinterpret_cast<const bf16x8*>(kb+d0*2048+512);
    {p0=__builtin_amdgcn_mfma_f32_32x32x16_bf16(b0,qr[d0],p0,0,0,0);p1=__builtin_amdgcn_mfma_f32_32x32x16_bf16(b1,qr[d0],p1,0,0,0);}}
}
typedef __attribute__((address_space(3))) const char* lds_cptr;
typedef short v4i16_t __attribute__((ext_vector_type(4)));
__device__ __forceinline__ void kload8(bf16x8*kf,lds_cptr kp){
  kf[0]=*(const __attribute__((address_space(3))) bf16x8*)(kp);      kf[1]=*(const __attribute__((address_space(3))) bf16x8*)(kp+512);
  kf[2]=*(const __attribute__((address_space(3))) bf16x8*)(kp+2048); kf[3]=*(const __attribute__((address_space(3))) bf16x8*)(kp+2560);
  kf[4]=*(const __attribute__((address_space(3))) bf16x8*)(kp+4096); kf[5]=*(const __attribute__((address_space(3))) bf16x8*)(kp+4608);
  kf[6]=*(const __attribute__((address_space(3))) bf16x8*)(kp+6144); kf[7]=*(const __attribute__((address_space(3))) bf16x8*)(kp+6656);
}
__device__ __forceinline__ void kload2(bf16x8*kf,lds_cptr kp,int j){ kf[2*j]=*(const __attribute__((address_space(3))) bf16x8*)(kp+j*2048); kf[2*j+1]=*(const __attribute__((address_space(3))) bf16x8*)(kp+j*2048+512); }
__device__ __forceinline__ s16x4 vtr(lds_cptr p){ return __builtin_bit_cast(s16x4,__builtin_amdgcn_ds_read_tr16_b64_v4i16((__attribute__((address_space(3))) v4i16_t*)p)); }
__device__ __forceinline__ float rowmax(const f32x16&p0,const f32x16&p1){
  float a=max3f(p0[0],p0[1],p1[0]),b=max3f(p0[2],p0[3],p1[1]);a=max3f(a,p1[2],p1[3]);
  #pragma unroll
  for(int r=4;r<16;r+=4){a=max3f(a,p0[r],p0[r+1]);b=max3f(b,p0[r+2],p0[r+3]);a=max3f(a,p1[r],p1[r+1]);b=max3f(b,p1[r+2],p1[r+3]);}
  const float m=max2f(a,b);
  auto rr=__builtin_amdgcn_permlane32_swap(__float_as_uint(m),__float_as_uint(m),false,false);
  return max2f(__uint_as_float(rr[0]),__uint_as_float(rr[1]));
}
__device__ __forceinline__ void pv(f32x16*o,int vb,bf16x8 pa0,bf16x8 pa1,bf16x8 pa2,bf16x8 pa3){
  #pragma unroll
  for(int d0=0;d0<2;++d0){s16x4 lo[4],hi[4];
    #pragma unroll
    for(int ks=0;ks<4;++ks){
      asm volatile("ds_read_b64_tr_b16 %0,%1 offset:%c2":"=&v"(lo[ks]):"v"(vb),"i"(d0*4096+ks*1024):"memory");
      asm volatile("ds_read_b64_tr_b16 %0,%1 offset:%c2":"=&v"(hi[ks]):"v"(vb),"i"(d0*4096+ks*1024+512):"memory");}
    asm volatile("s_waitcnt lgkmcnt(0)":::"memory");SBAR();
    #define PK(k) (bf16x8){lo[k][0],lo[k][1],lo[k][2],lo[k][3],hi[k][0],hi[k][1],hi[k][2],hi[k][3]}
    o[d0]=__builtin_amdgcn_mfma_f32_32x32x16_bf16(pa0,PK(0),o[d0],0,0,0);
    o[d0]=__builtin_amdgcn_mfma_f32_32x32x16_bf16(pa1,PK(1),o[d0],0,0,0);
    o[d0]=__builtin_amdgcn_mfma_f32_32x32x16_bf16(pa2,PK(2),o[d0],0,0,0);
    o[d0]=__builtin_amdgcn_mfma_f32_32x32x16_bf16(pa3,PK(3),o[d0],0,0,0);
    #undef PK
  }
}

#ifndef ATTN_STORE16
#define ATTN_STORE16(p,v) (*(u32x4*)(p)=(v))
#endif
template<int THRL> __device__ __forceinline__ void attn_unit(int b,int h,int qb,const bf16*Q,const bf16*__restrict__ K,const bf16*__restrict__ V,bf16*O,const float*__restrict__ cum,char*shm){
  int tid_=threadIdx.x; asm volatile("":"+v"(tid_)); const int tid=tid_,lane=tid&63,r32=lane&31,hi=lane>>5; const int wid=__builtin_amdgcn_readfirstlane(tid>>6);
  const long rowbase=(long)b*SEQ; const int q0=qb*QB;
  const bf16*Qw=Q+(rowbase+q0+wid*QBLK)*DM+h*D;
  const bf16*Kh=K+rowbase*DM+h*D,*Vh=V+rowbase*DM+h*D;
  const unsigned lds0=(unsigned)(uintptr_t)shm;
  float*wsf=(float*)(shm+LDS_WS)+wid*64;
  const bf16*ksrc=Kh+(long)lane*DM+wid*8;
  const bf16*vsrc=Vh+(long)(16*(wid&3)+(lane>>2))*DM+(wid>>2)*32+(lane&3)*8;
  const unsigned kdst=lds0+LDS_K+wid*1024, vdst=lds0+LDS_V+wid*1024;
  #define DMA_K(t,slot) glds16(ksrc+(long)(t)*KVBLK*DM,(unsigned)__builtin_amdgcn_readfirstlane(kdst+(slot)))
  #define DMA_V(t,slot) glds16(vsrc+(long)(t)*KVBLK*DM,(unsigned)__builtin_amdgcn_readfirstlane(vdst+(slot)))
  const int vb0=(int)(lds0+LDS_V)+((lane>>4)&1)*32+(lane&3)*8+(4*hi+((lane&15)>>2))*64;
  const char*Kbase=shm+LDS_K; bf16x8 kf[8];
  const lds_cptr shm3=(lds_cptr)shm; const lds_cptr kp0=shm3+LDS_K+hi*1024+r32*16; const lds_cptr vp0=shm3+LDS_V+((lane>>4)&1)*32+(lane&3)*8+(4*hi+((lane&15)>>2))*64;
  const int NT=(q0+QB)/KVBLK;
  const __attribute__((address_space(3))) float* biasl=(const __attribute__((address_space(3))) float*)(shm3+LDS_BIAS);
  { __attribute__((address_space(3))) float* bw=(__attribute__((address_space(3))) float*)(shm3+LDS_BIAS);
    for(int i=tid*4;i<q0+QB;i+=NW*64*4){ f32x4v v=*reinterpret_cast<const f32x4v*>(cum+i); v=v*(-1.4426950408889634f); *(__attribute__((address_space(3))) f32x4v*)(bw+i)=v; }
    asm volatile("s_waitcnt vmcnt(0) lgkmcnt(0)\n\ts_barrier":::"memory"); }
  DMA_K(0,0);DMA_V(0,0);DMA_K(1,SLOTB);
  bf16x8 qr[4];
  #pragma unroll
  for(int d0=0;d0<4;++d0)qr[d0]=*reinterpret_cast<const bf16x8*>(&Qw[(long)r32*DM+d0*16+hi*8]);
  float mhat=0.f,l_reg=0.f;f32x16 o[2];o[0]=f32x16{};o[1]=f32x16{};
  #define BIASFILL(C0,C1,t) do{ const __attribute__((address_space(3))) float* bp_=biasl+64*(t)+4*hi; \
    _Pragma("unroll") for(int g_=0;g_<4;++g_){ const f32x4v v_=*(const __attribute__((address_space(3))) f32x4v*)(bp_+8*g_); const f32x4v w_=*(const __attribute__((address_space(3))) f32x4v*)(bp_+32+8*g_); \
      _Pragma("unroll") for(int i_=0;i_<4;++i_){ C0[4*g_+i_]=v_[i_]-mhat; C1[4*g_+i_]=w_[i_]-mhat; } } }while(0)
  const int qrel=wid*QBLK+r32;
  #define CMASK(P0,P1,t) do{int jb_=(t)-(NT-4); if(jb_>=0)cmask(P0,P1,jb_,qrel,hi);}while(0)
  bool resc=false;
  #define START(P0,P1) do{ const float rm=rowmax(P0,P1); resc=false; \
    { const float dl=rm; mhat=fadd_s(mhat,dl); \
      _Pragma("unroll") for(int r=0;r<16;++r){P0[r]=fsub_s(P0[r],dl);P1[r]=fsub_s(P1[r],dl);} \
      } \
    _Pragma("unroll") for(int r=0;r<16;++r)P0[r]=__builtin_amdgcn_exp2f(P0[r]); }while(0)
  #define RESC() do{ if(resc){ asm volatile("s_waitcnt lgkmcnt(0)":::"memory"); \
      _Pragma("unroll") for(int d_=0;d_<2;++d_) _Pragma("unroll") for(int r=0;r<16;++r)o[d_][r]*=wsf[crow(r,hi)]; } }while(0)
  f32x16 pA0,pA1,pB0,pB1;
  int sl_prev=0,sl_cur=0,sl_next=SLOTB;
  #define ROT() do{sl_prev=sl_cur;sl_cur=sl_next;sl_next=(sl_next==(NSLOT-1)*SLOTB)?0:sl_next+SLOTB;}while(0)
  DMA_K(2,2*SLOTB);
  WAIT_BAR(3);
  BIASFILL(pA0,pA1,0); qkt(pA0,pA1,Kbase,qr,r32,hi);asm volatile("s_nop 15\n\ts_nop 7":"+v"(pA0),"+v"(pA1));CMASK(pA0,pA1,0);
  START(pA0,pA1);
  _Pragma("unroll") for(int r=0;r<16;++r)pA1[r]=__builtin_amdgcn_exp2f(pA1[r]);
  WAIT_BAR(0);
  DMA_K(3,0);DMA_V(1,SLOTB);
  ROT();
  kload8(kf,kp0+sl_cur);
  WAIT_BAR(2);
  s16x4 vlo[8],vhi[8]; u32x4 pw0,pw1,pw2,pw3;
  #define PKW(P,B) cvtpk_s(P[B],P[B+1])
  #define PAF(k) __builtin_bit_cast(bf16x8,pw##k)
  #define VFR(i) (bf16x8){vlo[i][0],vlo[i][1],vlo[i][2],vlo[i][3],vhi[i][0],vhi[i][1],vhi[i][2],vhi[i][3]}
  #define PIN(x) asm volatile("":"+v"(x))
  #define MX3(a,b,c) __builtin_fmaxf(__builtin_fmaxf((a),(b)),(c))
  #define GAPA(MF,A0,A1,A2,A3,W0,W1,PW) do{ MF; sacc+=A0; sacc+=A1; sacc+=A2; sacc+=A3; PIN(sacc); W0; W1; PIN(PW); SBAR(); }while(0)
  #define EX(v) __builtin_amdgcn_exp2f(v)
  #define GAPB(MF,X,B) do{ MF; X[B]=EX(X[B]); X[B+1]=EX(X[B+1]); X[B+2]=EX(X[B+2]); X[B+3]=EX(X[B+3]); PIN(X); SBAR(); }while(0)
  #define VRD(i) do{ vlo[i]=vtr(vp_+(((i)>>2)*4096+((i)&3)*1024)); vhi[i]=vtr(vp_+(((i)>>2)*4096+((i)&3)*1024+512)); }while(0)
  #define KRD(G,j) do{ if(G){ kload2(kf,kp0+sl_next,j); SBAR(); } }while(0)
  #define STEP(C0,C1,P0,P1,t,GK,GV,GL) do{ SBAR(); \
    BIASFILL(C0,C1,t); SBAR(); \
    const lds_cptr vp_=vp0+sl_prev; \
    VRD(0); SBAR(); float sacc=(P0[0]+P0[1]); \
    GAPA(C0=__builtin_amdgcn_mfma_f32_32x32x16_bf16(kf[0],qr[0],C0,0,0,0), P0[2],P0[3],P0[4],P0[5],     pw0[0]=PKW(P0,0), pw0[1]=PKW(P0,2), pw0); \
    VRD(4); SBAR(); GAPA(C1=__builtin_amdgcn_mfma_f32_32x32x16_bf16(kf[1],qr[0],C1,0,0,0), P0[6],P0[7],P0[8],P0[9],     pw0[2]=PKW(P0,4), pw0[3]=PKW(P0,6), pw0); \
    VRD(1); SBAR(); GAPA(C0=__builtin_amdgcn_mfma_f32_32x32x16_bf16(kf[2],qr[1],C0,0,0,0),   P0[10],P0[11],P0[12],P0[13], pw1[0]=PKW(P0,8), pw1[1]=PKW(P0,10), pw1); \
    VRD(5); SBAR(); GAPA(C1=__builtin_amdgcn_mfma_f32_32x32x16_bf16(kf[3],qr[1],C1,0,0,0),   P0[14],P0[15],P1[0],P1[1],   pw1[2]=PKW(P0,12),pw1[3]=PKW(P0,14), pw1); \
    VRD(2); SBAR(); GAPA(C0=__builtin_amdgcn_mfma_f32_32x32x16_bf16(kf[4],qr[2],C0,0,0,0),   P1[2],P1[3],P1[4],P1[5],     pw2[0]=PKW(P1,0), pw2[1]=PKW(P1,2), pw2); \
    VRD(6); SBAR(); GAPA(C1=__builtin_amdgcn_mfma_f32_32x32x16_bf16(kf[5],qr[2],C1,0,0,0),   P1[6],P1[7],P1[8],P1[9],     pw2[2]=PKW(P1,4), pw2[3]=PKW(P1,6), pw2); \
    VRD(3); SBAR(); GAPA(C0=__builtin_amdgcn_mfma_f32_32x32x16_bf16(kf[6],qr[3],C0,0,0,0),   P1[10],P1[11],P1[12],P1[13], pw3[0]=PKW(P1,8), pw3[1]=PKW(P1,10), pw3); \
    VRD(7); SBAR(); GAPA(C1=__builtin_amdgcn_mfma_f32_32x32x16_bf16(kf[7],qr[3],C1,0,0,0),   P1[14],P1[15],0.f,0.f,       pw3[2]=PKW(P1,12),pw3[3]=PKW(P1,14), pw3); \
    l_reg+=sacc; \
    if(GK){DMA_K((t)+3,sl_cur);} if(GV){DMA_V((t)+1,sl_next);} \
    CMASK(C0,C1,t); \
    { float a=MX3(C0[0],C0[1],C1[0]),b=MX3(C0[2],C0[3],C1[1]); a=MX3(a,C1[2],C1[3]); \
      _Pragma("unroll") for(int r=4;r<16;r+=4){a=MX3(a,C0[r],C0[r+1]);b=MX3(b,C0[r+2],C0[r+3]);a=MX3(a,C1[r],C1[r+1]);b=MX3(b,C1[r+2],C1[r+3]);} \
      float rm=__builtin_fmaxf(a,b); { auto rr=__builtin_amdgcn_permlane32_swap(__float_as_uint(rm),__float_as_uint(rm),false,false); rm=__builtin_fmaxf(__uint_as_float(rr[0]),__uint_as_float(rr[1])); } \
      resc=false; \
      if(__builtin_expect(__any(rm>(float)THRL),0)){ const float dl=__builtin_fmaxf(rm,0.f); mhat+=dl; \
        _Pragma("unroll") for(int r=0;r<16;++r){C0[r]-=dl;C1[r]-=dl;} \
        const float f=__builtin_amdgcn_exp2f(-dl); l_reg*=f; if(hi==0)wsf[r32]=f; resc=true; } } \
    SBAR(); \
    GAPB(o[0]=__builtin_amdgcn_mfma_f32_32x32x16_bf16(PAF(0),VFR(0),o[0],0,0,0), C0,0); \
    GAPB(o[1]=__builtin_amdgcn_mfma_f32_32x32x16_bf16(PAF(0),VFR(4),o[1],0,0,0), C0,4); \
    KRD(GL,0); GAPB(o[0]=__builtin_amdgcn_mfma_f32_32x32x16_bf16(PAF(1),VFR(1),o[0],0,0,0), C0,8); \
    KRD(GL,1); GAPB(o[1]=__builtin_amdgcn_mfma_f32_32x32x16_bf16(PAF(1),VFR(5),o[1],0,0,0), C0,12); \
    KRD(GL,2); GAPB(o[0]=__builtin_amdgcn_mfma_f32_32x32x16_bf16(PAF(2),VFR(2),o[0],0,0,0), C1,0); \
    KRD(GL,3); GAPB(o[1]=__builtin_amdgcn_mfma_f32_32x32x16_bf16(PAF(2),VFR(6),o[1],0,0,0), C1,4); \
    GAPB(o[0]=__builtin_amdgcn_mfma_f32_32x32x16_bf16(PAF(3),VFR(3),o[0],0,0,0), C1,8); \
    GAPB(o[1]=__builtin_amdgcn_mfma_f32_32x32x16_bf16(PAF(3),VFR(7),o[1],0,0,0), C1,12); \
    }while(0)
  int t=1;
  #undef CMASK
  #define CMASK(P0,P1,t) do{}while(0)
  for(;t+5<NT;t+=2){
    STEP(pB0,pB1,pA0,pA1,t,true,true,true);     WAIT_BAR(2); RESC(); ROT();
    STEP(pA0,pA1,pB0,pB1,t+1,true,true,true);   WAIT_BAR(2); RESC(); ROT();
  }
  #undef CMASK
  #define CMASK(P0,P1,t) do{int jb_=(t)-(NT-4); if(jb_>=0)cmask(P0,P1,jb_,qrel,hi);}while(0)
  #define ENDW(tt) do{ if((tt)+3<NT){WAIT_BAR(2);} else if((tt)+2<NT){WAIT_BAR(1);} else {WAIT_BAR(0);} }while(0)
  for(;t+1<NT;t+=2){
    STEP(pB0,pB1,pA0,pA1,t,(t+3<NT),(t+1<NT),(t+1<NT));       ENDW(t);   RESC(); ROT();
    STEP(pA0,pA1,pB0,pB1,t+1,(t+4<NT),(t+2<NT),(t+2<NT));     ENDW(t+1); RESC(); ROT();
  }
  STEP(pB0,pB1,pA0,pA1,NT-1,false,false,false); RESC();
  { float sacc=pB0[0]+pB0[1]; _Pragma("unroll") for(int r=2;r<16;++r)sacc+=pB0[r]; _Pragma("unroll") for(int r=0;r<16;++r)sacc+=pB1[r]; l_reg+=sacc;
    pw0=(u32x4){PKW(pB0,0),PKW(pB0,2),PKW(pB0,4),PKW(pB0,6)};pw1=(u32x4){PKW(pB0,8),PKW(pB0,10),PKW(pB0,12),PKW(pB0,14)};pw2=(u32x4){PKW(pB1,0),PKW(pB1,2),PKW(pB1,4),PKW(pB1,6)};pw3=(u32x4){PKW(pB1,8),PKW(pB1,10),PKW(pB1,12),PKW(pB1,14)};
    SBAR(); pv(o,vb0+sl_cur,PAF(0),PAF(1),PAF(2),PAF(3)); }
  #undef PKW
  #undef PAF
  #undef VFR
  #undef PIN
  #undef MX3
  #undef GAPA
  #undef GAPB
  #undef EX
  #undef VRD
  #undef KRD
  #undef STEP
  #undef ENDW
  {auto rr=__builtin_amdgcn_permlane32_swap(__float_as_uint(l_reg),__float_as_uint(l_reg),false,false);l_reg=__uint_as_float(rr[0])+__uint_as_float(rr[1]);}
  if(hi==0)wsf[32+r32]=l_reg;asm volatile("s_waitcnt lgkmcnt(0)":::"memory");
  float rli[16];
  #pragma unroll
  for(int r=0;r<16;++r)rli[r]=__builtin_amdgcn_rcpf(wsf[32+crow(r,hi)]);
  bf16*Ow=O+(rowbase+q0+wid*QBLK)*DM+h*D;
  { bf16*stg=(bf16*)(shm+LDS_OST)+wid*2048;
    #pragma unroll
    for(int r=0;r<16;++r){const int orow=crow(r,hi);
      #pragma unroll
      for(int d0=0;d0<2;++d0)stg[orow*64+d0*32+r32]=__float2bfloat16(o[d0][r]*rli[r]);}
    asm volatile("s_waitcnt lgkmcnt(0)":::"memory");
    #pragma unroll
    for(int i=0;i<4;++i){const int row=i*8+(lane>>3),ch=lane&7; const u32x4 v=*(const u32x4*)(stg+row*64+ch*8); ATTN_STORE16(Ow+(long)row*DM+ch*8,v);} }
  asm volatile("s_waitcnt lgkmcnt(0)\n\ts_barrier":::"memory");
  #undef DMA_K
  #undef DMA_V
  #undef CMASK
  #undef START
  #undef RESC
  #undef ROT
  #undef BIASFILL
}
constexpr int ATTN_LDS_BYTES=LDS_BYTES;
#undef SBAR
#undef WAIT_BAR
}

constexpr size_t MiB = 1u << 20;
constexpr size_t WS_CTL = 0, CTL_BYTES = 1 * MiB;
constexpr int CW_QCTR = 0;
constexpr int CW_CNT = 1024;
constexpr int CW_KMEAN = 4096;
constexpr size_t WS_W = 1 * MiB;
constexpr size_t W_IN = 0, W_G = W_IN + (size_t)NQKV * 1024, W_PA = W_G + (size_t)NG * 1024, W_PB = W_PA + 1024 * 384, W_PC = W_PB + 1024 * 256,
                 W_O = W_PC + 1024 * 384, W_GU = W_O + 1024 * 1024, W_D = W_GU + (size_t)2 * DFF * 1024, W_LAYER = W_D + (size_t)1024 * DFF;
static_assert(WS_W + 2 * W_LAYER * 2 <= 69 * MiB, "weights");
constexpr size_t WS_ROPE = 69 * MiB;
constexpr size_t WS_LF = 70 * MiB;
constexpr size_t WS_CUM = 71 * MiB;
constexpr size_t WS_LSEB = 72 * MiB;
constexpr size_t WS_XB = 76 * MiB;
constexpr size_t WS_QA = 140 * MiB, WS_KA = 164 * MiB, WS_VA = 188 * MiB, WS_QB = 212 * MiB, WS_KB = 260 * MiB, WS_VB = 276 * MiB,
                 WS_QC = 292 * MiB, WS_KC = 316 * MiB, WS_VC = 340 * MiB;
constexpr size_t WS_H = 140 * MiB;
constexpr size_t WS_PO = 364 * MiB;
constexpr size_t WS_PLSE = 460 * MiB;
constexpr size_t WS_LIST = 463 * MiB;
constexpr size_t WS_GS = 364 * MiB;
constexpr size_t WS_MG = 428 * MiB;
constexpr size_t WS_END = 492 * MiB;
constexpr int LIST_PER_BH = 256 * 2016;
__device__ __forceinline__ int list_off(int bh, int n) { return bh * LIST_PER_BH + 256 * (63 * n - (n * (n - 1)) / 2); }

constexpr int LDS_QW = 150 * 1024;
constexpr int LDS_BYTES = 152 * 1024;
static_assert(attn_body::ATTN_LDS_BYTES <= LDS_QW && pg8::STAGE_BYTES <= LDS_QW, "lds");

__constant__ double ROPE_FR[8] = {0.15915494309189535, 0.03086376340470123, 0.005985185712713705, 0.0011606636412400608,
                                  0.00022507907903927653, 4.364795279280289e-05, 8.464330808241401e-06, 1.6414262627950345e-06};

struct Args { const float* in[16]; float* out; unsigned char* ws; };
typedef const __attribute__((address_space(4))) Args* CArgs;

__device__ __forceinline__ float wave_sum(float v) {
#pragma unroll
    for (int o = 1; o < 64; o <<= 1) v += __shfl_xor(v, o);
    return v;
}
__device__ __forceinline__ unsigned f2bf(float f) { unsigned u = __builtin_bit_cast(unsigned, f); return (u + 0x7fffu + ((u >> 16) & 1u)) >> 16; }
__device__ __forceinline__ unsigned pk2(float lo, float hi) { return f2bf(lo) | (f2bf(hi) << 16); }

__device__ __forceinline__ void transpose_item(const float* Wsrc, int ldw, bf16_t* dst, int ldk, LAS float* scr, int lane) {
#pragma unroll 8
    for (int i = 0; i < 32; ++i) { const int kk = 2 * i + (lane >> 5); scr[kk * 33 + (lane & 31)] = Wsrc[(size_t)kk * ldw + (lane & 31)]; }
    asm volatile("s_waitcnt lgkmcnt(0)" ::: "memory");
    const int c = lane & 7;
#pragma unroll
    for (int j = 0; j < 4; ++j) { const int n = (lane >> 3) + 8 * j; const LAS float* s = scr + (8 * c) * 33 + n;
        u32x4 o; o.x = pk2(s[0 * 33], s[1 * 33]); o.y = pk2(s[2 * 33], s[3 * 33]); o.z = pk2(s[4 * 33], s[5 * 33]); o.w = pk2(s[6 * 33], s[7 * 33]);
        *(u32x4*)(dst + (size_t)(n) * ldk + 8 * c) = o; }
    asm volatile("s_waitcnt lgkmcnt(0)" ::: "memory");
}
constexpr int IT_IN = 16 * 112, IT_G = 16 * 96, IT_PA = 6 * 32, IT_PB = 4 * 32, IT_PC = 6 * 32, IT_O = 16 * 32, IT_GU = 16 * 176, IT_D = 44 * 32;
constexpr int IT_LAYER = IT_IN + IT_G + IT_PA + IT_PB + IT_PC + IT_O + IT_GU + IT_D;
__device__ __forceinline__ void prologue_item(CArgs a, int it, LAS float* scr, int lane) {
    const int l = it / IT_LAYER; int r = it % IT_LAYER;
    bf16_t* WL = (bf16_t*)(a->ws + WS_W) + (size_t)l * W_LAYER;
    if (r < IT_IN) { const int kb = r / 112, nb = r % 112, k0 = 64 * kb, n0 = 32 * nb, c0 = n0 < 1152 ? n0 : n0 + 6;
        transpose_item(a->in[3] + (size_t)l * 1024 * DIN + (size_t)k0 * DIN + c0, DIN, WL + W_IN + (size_t)n0 * 1024 + k0, 1024, scr, lane); return; } r -= IT_IN;
    if (r < IT_G) { const int kb = r / 96, nb = r % 96, k0 = 64 * kb, n0 = 32 * nb, c0 = 3590 + n0;
        transpose_item(a->in[3] + (size_t)l * 1024 * DIN + (size_t)k0 * DIN + c0, DIN, WL + W_G + (size_t)n0 * 1024 + k0, 1024, scr, lane); return; } r -= IT_G;
    if (r < IT_PA) { const int kb = r / 32, nb = r % 32, k0 = 64 * kb, n0 = 32 * nb;
        transpose_item(a->in[5] + (size_t)l * 384 * 1024 + (size_t)k0 * 1024 + n0, 1024, WL + W_PA + (size_t)n0 * 384 + k0, 384, scr, lane); return; } r -= IT_PA;
    if (r < IT_PB) { const int kb = r / 32, nb = r % 32, k0 = 64 * kb, n0 = 32 * nb;
        transpose_item(a->in[6] + (size_t)l * 256 * 1024 + (size_t)k0 * 1024 + n0, 1024, WL + W_PB + (size_t)n0 * 256 + k0, 256, scr, lane); return; } r -= IT_PB;
    if (r < IT_PC) { const int kb = r / 32, nb = r % 32, k0 = 64 * kb, n0 = 32 * nb;
        transpose_item(a->in[7] + (size_t)l * 384 * 1024 + (size_t)k0 * 1024 + n0, 1024, WL + W_PC + (size_t)n0 * 384 + k0, 384, scr, lane); return; } r -= IT_PC;
    if (r < IT_O) { const int kb = r / 32, nb = r % 32, k0 = 64 * kb, n0 = 32 * nb;
        transpose_item(a->in[8] + (size_t)l * 1024 * 1024 + (size_t)k0 * 1024 + n0, 1024, WL + W_O + (size_t)n0 * 1024 + k0, 1024, scr, lane); return; } r -= IT_O;
    if (r < IT_GU) { const int kb = r / 176, nb = r % 176, k0 = 64 * kb, n0 = 32 * nb, pn = n0 >> 8, w = n0 & 255;
        const float* src = (w < 128) ? (a->in[11] + (size_t)l * 1024 * DFF + (size_t)k0 * DFF + 128 * pn + w) : (a->in[12] + (size_t)l * 1024 * DFF + (size_t)k0 * DFF + 128 * pn + (w - 128));
        transpose_item(src, DFF, WL + W_GU + (size_t)n0 * 1024 + k0, 1024, scr, lane); return; } r -= IT_GU;
    { const int kb = r / 32, nb = r % 32, k0 = 64 * kb, n0 = 32 * nb;
        transpose_item(a->in[13] + (size_t)l * DFF * 1024 + (size_t)k0 * 1024 + n0, 1024, WL + W_D + (size_t)n0 * DFF + k0, DFF, scr, lane); }
}

__device__ __forceinline__ void ln_phase(const float* src, const float* gam, const float* bet, float* XF, f32x2* ST, bf16_t* XB,
                                         const float* wfa, const float* bfl, float* LF, LAS unsigned char* lds, int tid, int lane, int wave) {
    asm volatile("" : "+v"(tid), "+v"(lane));
    LAS float* wl = (LAS float*)lds;
    if (wfa) { for (int i = tid; i < 6144; i += NWAVES * 64) { const int h = i % 6, k = i / 6; wl[h * 1024 + k] = wfa[(size_t)k * DIN + 1152 + h]; } }
    __syncthreads();
    f32x4 g4[4], b4[4];
#pragma unroll
    for (int j = 0; j < 4; ++j) { g4[j] = *(const f32x4*)(gam + 4 * lane + 256 * j); b4[j] = *(const f32x4*)(bet + 4 * lane + 256 * j); }
    const int NGW = gridDim.x * NWAVES;
    for (int row0 = blockIdx.x * NWAVES + wave; row0 < T; row0 += 2 * NGW) {
        f32x4 v[2][4]; float s[2]; bool ok[2];
#pragma unroll
        for (int u = 0; u < 2; ++u) { const int row = row0 + u * NGW; ok[u] = row < T; const f32x4* xr = (const f32x4*)(src + (size_t)(ok[u] ? row : row0) * DM) + lane; s[u] = 0.f;
#pragma unroll
            for (int j = 0; j < 4; ++j) v[u][j] = xr[64 * j]; }
#pragma unroll
        for (int u = 0; u < 2; ++u) {
#pragma unroll
            for (int j = 0; j < 4; ++j) s[u] += (v[u][j].x + v[u][j].y) + (v[u][j].z + v[u][j].w); }
        float mean[2], s2[2], rstd[2];
#pragma unroll
        for (int u = 0; u < 2; ++u) s[u] = wave_sum(s[u]);
#pragma unroll
        for (int u = 0; u < 2; ++u) { mean[u] = s[u] * (1.f / DM); s2[u] = 0.f;
#pragma unroll
            for (int j = 0; j < 4; ++j) { v[u][j] = v[u][j] - mean[u]; s2[u] += (v[u][j].x * v[u][j].x + v[u][j].y * v[u][j].y) + (v[u][j].z * v[u][j].z + v[u][j].w * v[u][j].w); } }
#pragma unroll
        for (int u = 0; u < 2; ++u) s2[u] = wave_sum(s2[u]);
#pragma unroll
        for (int u = 0; u < 2; ++u) { rstd[u] = 1.f / sqrtf(s2[u] * (1.f / DM) + LN_EPS);
            const int row = row0 + u * NGW;
            if (ok[u]) {
                f32x4* of = (f32x4*)(XF + (size_t)row * DM) + lane; u32x2* ob = (u32x2*)(XB + (size_t)row * DM) + lane;
                if (ST && lane == 0) ST[row] = (f32x2){mean[u], rstd[u]};
#pragma unroll
                for (int j = 0; j < 4; ++j) { v[u][j] = v[u][j] * rstd[u] * g4[j] + b4[j]; if (!ST) of[64 * j] = v[u][j]; u32x2 w; w.x = cvt_pk_bf16(v[u][j].x, v[u][j].y); w.y = cvt_pk_bf16(v[u][j].z, v[u][j].w); ob[64 * j] = w; }
            } }
        if (wfa) {
#pragma unroll
            for (int u = 0; u < 2; ++u) {
                const int row = row0 + u * NGW;
                float d[6];
#pragma unroll
                for (int h = 0; h < 6; ++h) { float acc = 0.f;
#pragma unroll
                    for (int j = 0; j < 4; ++j) { const f32x4 w = *(const LAS f32x4*)(wl + h * 1024 + 4 * lane + 256 * j); acc += (v[u][j].x * w.x + v[u][j].y * w.y) + (v[u][j].z * w.z + v[u][j].w * w.w); }
                    d[h] = wave_sum(acc); }
                if (lane < 6 && ok[u]) { float z = d[0];
#pragma unroll
                    for (int h = 1; h < 6; ++h) z = (lane == h) ? d[h] : z;
                    z += bfl[lane];
                    const float ls = fminf(z, 0.f) - log1pf(expf(-fabsf(z)));
                    const int b = row / SEQ, sidx = row % SEQ; LF[(size_t)(b * 6 + lane) * SEQ + sidx] = ls; }
            }
        }
    }
    __syncthreads();
}

__device__ __forceinline__ void scan_bh(const float* lf, float* cum, LAS unsigned char* lds, int tid, int lane, int wave) {
    asm volatile("" : "+v"(tid), "+v"(lane));
    LAS float* ws = (LAS float*)lds;
    f32x4 v[8]; const f32x4* p = (const f32x4*)(lf + tid * 32);
#pragma unroll
    for (int j = 0; j < 8; ++j) v[j] = p[j];
    float run = 0.f;
#pragma unroll
    for (int j = 0; j < 8; ++j) { run += v[j].x; v[j].x = run; run += v[j].y; v[j].y = run; run += v[j].z; v[j].z = run; run += v[j].w; v[j].w = run; }
    float inc = run;
#pragma unroll
    for (int o = 1; o < 64; o <<= 1) { const float t = __shfl_up(inc, o); if (lane >= o) inc += t; }
    if (lane == 63) ws[wave] = inc;
    __syncthreads();
    float base = inc - run;
    for (int w = 0; w < wave; ++w) base += ws[w];
    f32x4* q = (f32x4*)(cum + tid * 32);
#pragma unroll
    for (int j = 0; j < 8; ++j) q[j] = v[j] + base;
    __syncthreads();
}

__device__ __forceinline__ float sigmoidf_(float x) { return __builtin_amdgcn_rcpf(1.f + __builtin_amdgcn_exp2f(-x * LOG2E)); }

struct EpiInproj {
    static constexpr bool PERM = true;
    unsigned char* ws; const f32x2* rope; int* kmean;
    __device__ __forceinline__ void operator()(const f32x4 (&acc)[2][2][4][2], const pg8::Unit& u, int wr, int wc, int fr, int fq) const {
        const int row0 = u.pm * 256 + wr * 64 + fr;
#pragma unroll
        for (int bj = 0; bj < 2; ++bj) {
            const int cb = 2 * u.pn + bj;
            size_t base; int pitch, c0; bool rope_on = false, km = false; float sc = 1.f;
            if (cb < 3) { base = WS_QA; pitch = 384; c0 = cb * 128; sc = C2; }
            else if (cb < 6) { base = WS_KA; pitch = 384; c0 = (cb - 3) * 128; }
            else if (cb < 9) { base = WS_VA; pitch = 384; c0 = (cb - 6) * 128; }
            else if (cb < 15) { base = WS_QB; pitch = 768; c0 = (cb - 9) * 128; rope_on = true; sc = C2; }
            else if (cb < 17) { base = WS_KB; pitch = 256; c0 = (cb - 15) * 128; rope_on = true; }
            else if (cb < 19) { base = WS_VB; pitch = 256; c0 = (cb - 17) * 128; }
            else if (cb < 22) { base = WS_QC; pitch = 384; c0 = (cb - 19) * 128; rope_on = true; sc = C2; }
            else if (cb < 25) { base = WS_KC; pitch = 384; c0 = (cb - 22) * 128; rope_on = true; km = true; }
            else { base = WS_VC; pitch = 384; c0 = (cb - 25) * 128; }
            bf16_t* dst = (bf16_t*)(ws + base);
            const int colw = c0 + wc * 32 + 8 * fq;
            const bool rl = rope_on && ((wc & 1) == 0) && (fq < 2);
            float ks[8];
#pragma unroll
            for (int i = 0; i < 8; ++i) ks[i] = 0.f;
#pragma unroll
            for (int ai = 0; ai < 2; ++ai)
#pragma unroll
                for (int m = 0; m < 4; ++m) {
                    const int row = row0 + ai * 128 + m * 16;
                    f32x4 v0 = acc[ai][bj][m][0], v1 = acc[ai][bj][m][1];
                    if (rope_on) {
                        float own[8] = {v0.x, v0.y, v0.z, v0.w, v1.x, v1.y, v1.z, v1.w}, oth[8];
#pragma unroll
                        for (int i = 0; i < 8; ++i) oth[i] = __shfl_xor(own[i], 16);
                        if (rl) {
                            const f32x2* rp = rope + (size_t)(row % SEQ) * 8;
                            const float sg = (fq == 0) ? -1.f : 1.f;
#pragma unroll
                            for (int i = 0; i < 8; ++i) { const f32x2 cs = rp[i]; own[i] = own[i] * cs.x + sg * oth[i] * cs.y; }
                            v0 = (f32x4){own[0], own[1], own[2], own[3]}; v1 = (f32x4){own[4], own[5], own[6], own[7]};
                        }
                    }
                    if (km) { ks[0] += v0.x; ks[1] += v0.y; ks[2] += v0.z; ks[3] += v0.w; ks[4] += v1.x; ks[5] += v1.y; ks[6] += v1.z; ks[7] += v1.w; }
                    v0 = v0 * sc; v1 = v1 * sc;
                    u32x4 w; w.x = cvt_pk_bf16(v0.x, v0.y); w.y = cvt_pk_bf16(v0.z, v0.w); w.z = cvt_pk_bf16(v1.x, v1.y); w.w = cvt_pk_bf16(v1.z, v1.w);
                    *(u32x4*)(dst + (size_t)row * pitch + colw) = w;
                }
            if (km) {
#pragma unroll
                for (int i = 0; i < 8; ++i) { float s = ks[i]; s += __shfl_xor(s, 1); s += __shfl_xor(s, 2); s += __shfl_xor(s, 4); s += __shfl_xor(s, 8); ks[i] = s; }
                if (fr == 0) { const int b = u.pm >> 6, blk = u.pm & 63;
#pragma unroll
                    for (int i = 0; i < 8; ++i) { const int col = colw + i; atomicAdd(kmean + ((size_t)((b * 6 + (col >> 6)) * 64 + blk)) * 64 + (col & 63), __float2int_rn(ks[i] * 262144.f)); } }
            }
        }
    }
};

struct EpiSwiglu {
    static constexpr bool PERM = true;
    bf16_t* H;
    __device__ __forceinline__ void operator()(const f32x4 (&acc)[2][2][4][2], const pg8::Unit& u, int wr, int wc, int fr, int fq) const {
        const int row0 = u.pm * 256 + wr * 64 + fr, col0 = u.pn * 128 + wc * 32 + 8 * fq;
#pragma unroll
        for (int ai = 0; ai < 2; ++ai)
#pragma unroll
            for (int m = 0; m < 4; ++m) {
                float h[8];
#pragma unroll
                for (int n = 0; n < 2; ++n)
#pragma unroll
                    for (int i = 0; i < 4; ++i) { const float g = acc[ai][0][m][n][i], up = acc[ai][1][m][n][i]; h[4 * n + i] = g * sigmoidf_(g) * up; }
                u32x4 w; w.x = cvt_pk_bf16(h[0], h[1]); w.y = cvt_pk_bf16(h[2], h[3]); w.z = cvt_pk_bf16(h[4], h[5]); w.w = cvt_pk_bf16(h[6], h[7]);
                *(u32x4*)(H + (size_t)(row0 + ai * 128 + m * 16) * DFF + col0) = w;
                asm volatile("" ::: "memory");
            }
    }
};

struct EpiResid {
    static constexpr bool PERM = true;
    const float* src; float* X; const f32x2* ST; const float* gam; const float* bet;
    __device__ __forceinline__ void operator()(const f32x4 (&acc)[2][2][4][2], const pg8::Unit& u, int wr, int wc, int fr, int fq) const {
        const int row0 = u.pm * 256 + wr * 64 + fr, col0 = u.pn * 256 + wc * 32 + 8 * fq;
        f32x4 g[2][2], b[2][2];
#pragma unroll
        for (int bj = 0; bj < 2; ++bj)
#pragma unroll
            for (int n = 0; n < 2; ++n) { g[bj][n] = *(const f32x4*)(gam + col0 + bj * 128 + 4 * n); b[bj][n] = *(const f32x4*)(bet + col0 + bj * 128 + 4 * n); }
#pragma unroll
        for (int ai = 0; ai < 2; ++ai)
#pragma unroll
            for (int m = 0; m < 4; ++m) {
                const int row = row0 + ai * 128 + m * 16;
                const f32x2 st = ST[row];
#pragma unroll
                for (int bj = 0; bj < 2; ++bj) {
                    const size_t off = (size_t)row * DM + col0 + bj * 128;
                    const f32x4 s0 = *(const f32x4*)(src + off), s1 = *(const f32x4*)(src + off + 4);
                    const f32x4 x0 = (s0 - st.x) * st.y * g[bj][0] + b[bj][0], x1 = (s1 - st.x) * st.y * g[bj][1] + b[bj][1];
                    *(f32x4*)(X + off) = x0 * DN_ALPHA + acc[ai][bj][m][0]; *(f32x4*)(X + off + 4) = x1 * DN_ALPHA + acc[ai][bj][m][1];
                    asm volatile("" ::: "memory");
                }
            }
    }
};

struct EpiGate {
    static constexpr bool PERM = true;
    bf16_t* GS;
    __device__ __forceinline__ void operator()(const f32x4 (&acc)[2][2][4][2], const pg8::Unit& u, int wr, int wc, int fr, int fq) const {
        const int row0 = u.pm * 256 + wr * 64 + fr, col0 = u.pn * 256 + wc * 32 + 8 * fq;
#pragma unroll
        for (int ai = 0; ai < 2; ++ai)
#pragma unroll
            for (int m = 0; m < 4; ++m)
#pragma unroll
                for (int bj = 0; bj < 2; ++bj) {
                    const f32x4 a = acc[ai][bj][m][0], b = acc[ai][bj][m][1];
                    u32x4 w; w.x = cvt_pk_bf16(sigmoidf_(a.x), sigmoidf_(a.y)); w.y = cvt_pk_bf16(sigmoidf_(a.z), sigmoidf_(a.w));
                    w.z = cvt_pk_bf16(sigmoidf_(b.x), sigmoidf_(b.y)); w.w = cvt_pk_bf16(sigmoidf_(b.z), sigmoidf_(b.w));
                    *(u32x4*)(GS + (size_t)(row0 + ai * 128 + m * 16) * DM + col0 + bj * 128) = w;
                }
    }
};

template <int FIRST> struct EpiBranch {
    static constexpr bool PERM = true;
    const bf16_t* GS; bf16_t* MG;
    __device__ __forceinline__ void operator()(const f32x4 (&acc)[2][2][4][2], const pg8::Unit& u, int wr, int wc, int fr, int fq) const {
        const int row0 = u.pm * 256 + wr * 64 + fr, col0 = u.pn * 256 + wc * 32 + 8 * fq;
#pragma unroll
        for (int ai = 0; ai < 2; ++ai)
#pragma unroll
            for (int m = 0; m < 4; ++m)
#pragma unroll
                for (int bj = 0; bj < 2; ++bj) {
                    const size_t off = (size_t)(row0 + ai * 128 + m * 16) * DM + col0 + bj * 128;
                    const u32x4 gw = *(const u32x4*)(GS + off);
                    const f32x4 a = acc[ai][bj][m][0], b = acc[ai][bj][m][1];
                    float r[8] = {bflo(gw.x) * a.x, bfhi(gw.x) * a.y, bflo(gw.y) * a.z, bfhi(gw.y) * a.w, bflo(gw.z) * b.x, bfhi(gw.z) * b.y, bflo(gw.w) * b.z, bfhi(gw.w) * b.w};
                    if (!FIRST) { const u32x4 mw = *(const u32x4*)(MG + off);
                        r[0] += bflo(mw.x); r[1] += bfhi(mw.x); r[2] += bflo(mw.y); r[3] += bfhi(mw.y); r[4] += bflo(mw.z); r[5] += bfhi(mw.z); r[6] += bflo(mw.w); r[7] += bfhi(mw.w); }
                    u32x4 w; w.x = cvt_pk_bf16(r[0], r[1]); w.y = cvt_pk_bf16(r[2], r[3]); w.z = cvt_pk_bf16(r[4], r[5]); w.w = cvt_pk_bf16(r[6], r[7]);
                    *(u32x4*)(MG + off) = w;
                    asm volatile("" ::: "memory");
                }
    }
};

typedef short v4i16_t __attribute__((ext_vector_type(4)));
__device__ __forceinline__ int crow(int r, int hi) { return (r & 3) + 8 * (r >> 2) + 4 * hi; }
__device__ __forceinline__ float half_max(float m) { auto rr = __builtin_amdgcn_permlane32_swap(__float_as_uint(m), __float_as_uint(m), false, false); return fmaxf(__uint_as_float(rr[0]), __uint_as_float(rr[1])); }
__device__ __forceinline__ float half_sum(float m) { auto rr = __builtin_amdgcn_permlane32_swap(__float_as_uint(m), __float_as_uint(m), false, false); return __uint_as_float(rr[0]) + __uint_as_float(rr[1]); }

__device__ __forceinline__ void small_attn(const bf16_t* qrow, int ntiles, const bf16_t* Kb, const bf16_t* Vb, int pitch,
                                           int kc0, int kstride, int koff, int qc, int span, LAS unsigned char* vscr, int lane,
                                           f32x16 (&o)[2], float& lse2, const float* cumb = nullptr) {
    asm volatile("" : "+v"(lane));
    const int r32 = lane & 31, hi = lane >> 5;
    bf16x8 qr[4];
#pragma unroll
    for (int d0 = 0; d0 < 4; ++d0) qr[d0] = *(const bf16x8*)(qrow + d0 * 16 + hi * 8);
    o[0] = f32x16{}; o[1] = f32x16{};
    float m = -1e30f, l = 0.f;
    const int lr = lane >> 3, lc = lane & 7;
    LAS unsigned char* kscr = vscr + 4608;
    LAS unsigned char* kw = kscr + lr * 144 + lc * 16;
    LAS unsigned char* vw = vscr + lr * 144 + lc * 16;
    const LAS unsigned char* kfr = kscr + r32 * 144 + 16 * hi;
    const LAS unsigned char* vt = vscr + (4 * hi + ((lane & 15) >> 2)) * 144 + (16 * ((lane >> 4) & 1) + 4 * (lane & 3)) * 2;
#define SA_LOAD(KF, VV, tt) do { const int t_ = (tt) < ntiles ? (tt) : ntiles - 1; \
        _Pragma("unroll") for (int i_ = 0; i_ < 4; ++i_) { const int kk_ = kc0 + 32 * t_ + lr + 8 * i_; const size_t off_ = (size_t)((kk_ < 0 ? 0 : kk_) * kstride + koff) * pitch + 8 * lc; \
            KF[i_] = *(const bf16x8*)(Kb + off_); VV[i_] = *(const bf16x8*)(Vb + off_); } \
        __builtin_amdgcn_sched_barrier(0); } while (0)
#define SA_COMPUTE(KF, VV, tt) do { \
        _Pragma("unroll") for (int i_ = 0; i_ < 4; ++i_) { *(LAS bf16x8*)(kw + 8 * 144 * i_) = KF[i_]; *(LAS bf16x8*)(vw + 8 * 144 * i_) = VV[i_]; } \
        f32x16 p = f32x16{}; \
        _Pragma("unroll") for (int d0 = 0; d0 < 4; ++d0) { const bf16x8 kf_ = *(const LAS bf16x8*)(kfr + 32 * d0); p = __builtin_amdgcn_mfma_f32_32x32x16_bf16(kf_, qr[d0], p, 0, 0, 0); } \
        const int kcb = kc0 + 32 * (tt); \
        if (cumb) { _Pragma("unroll") for (int r = 0; r < 16; ++r) { const int kc = kcb + crow(r, hi); p[r] -= cumb[kc < 0 ? 0 : kc] * LOG2E; } } \
        if (!__all((kcb >= 0) && (kcb + 31 <= qc) && (qc - kcb <= span))) {     \
            _Pragma("unroll") for (int r = 0; r < 16; ++r) { const int kc = kcb + crow(r, hi); const bool ok = (kc >= 0) && (kc <= qc) && (qc - kc <= span); p[r] = ok ? p[r] : -INFINITY; } } \
        float rm = fmaxf(fmaxf(fmaxf(p[0], p[1]), fmaxf(p[2], p[3])), fmaxf(fmaxf(p[4], p[5]), fmaxf(p[6], p[7]))); \
        rm = fmaxf(rm, fmaxf(fmaxf(fmaxf(p[8], p[9]), fmaxf(p[10], p[11])), fmaxf(fmaxf(p[12], p[13]), fmaxf(p[14], p[15])))); \
        rm = half_max(rm); \
        const float mn = fmaxf(m, rm); const float f = __builtin_amdgcn_exp2f(m - mn); m = mn; \
        float ls = 0.f; \
        _Pragma("unroll") for (int r = 0; r < 16; ++r) { p[r] = __builtin_amdgcn_exp2f(p[r] - mn); ls += p[r]; } \
        l = l * f + ls; \
        if (!__all(f == 1.f)) { _Pragma("unroll") for (int r = 0; r < 16; ++r) { o[0][r] *= f; o[1][r] *= f; } } \
        u32x4 pw0, pw1; \
        pw0.x = cvt_pk_bf16(p[0], p[1]); pw0.y = cvt_pk_bf16(p[2], p[3]); pw0.z = cvt_pk_bf16(p[4], p[5]); pw0.w = cvt_pk_bf16(p[6], p[7]); \
        pw1.x = cvt_pk_bf16(p[8], p[9]); pw1.y = cvt_pk_bf16(p[10], p[11]); pw1.z = cvt_pk_bf16(p[12], p[13]); pw1.w = cvt_pk_bf16(p[14], p[15]); \
        const bf16x8 pb0 = __builtin_bit_cast(bf16x8, pw0), pb1 = __builtin_bit_cast(bf16x8, pw1); \
        _Pragma("unroll") for (int d0 = 0; d0 < 2; ++d0) { \
            _Pragma("unroll") for (int s_ = 0; s_ < 2; ++s_) { \
                const v4i16_t lo = __builtin_amdgcn_ds_read_tr16_b64_v4i16((LAS v4i16_t*)(vt + (16 * s_) * 144 + d0 * 64)); \
                const v4i16_t hh = __builtin_amdgcn_ds_read_tr16_b64_v4i16((LAS v4i16_t*)(vt + (16 * s_ + 8) * 144 + d0 * 64)); \
                const bf16x8 vf = (bf16x8){lo[0], lo[1], lo[2], lo[3], hh[0], hh[1], hh[2], hh[3]}; \
                o[d0] = __builtin_amdgcn_mfma_f32_32x32x16_bf16(vf, s_ == 0 ? pb0 : pb1, o[d0], 0, 0, 0); } } \
    } while (0)
    bf16x8 kA[4], vA[4], kB[4], vB[4], kC[4], vC[4];
    SA_LOAD(kA, vA, 0); SA_LOAD(kB, vB, 1);
    for (int t = 0; t < ntiles; t += 3) {
        SA_LOAD(kC, vC, t + 2); SA_COMPUTE(kA, vA, t);
        if (t + 1 >= ntiles) break;
        SA_LOAD(kA, vA, t + 3); SA_COMPUTE(kB, vB, t + 1);
        if (t + 2 >= ntiles) break;
        SA_LOAD(kB, vB, t + 4); SA_COMPUTE(kC, vC, t + 2);
    }
#undef SA_LOAD
#undef SA_COMPUTE
    l = half_sum(l);
    const float rl = 1.f / l;
#pragma unroll
    for (int r = 0; r < 16; ++r) { o[0][r] *= rl; o[1][r] *= rl; }
    lse2 = m + __builtin_amdgcn_logf(l);
}
__device__ __forceinline__ void small_store(bf16_t* orow, const f32x16 (&o)[2], int hi) {
#pragma unroll
    for (int d0 = 0; d0 < 2; ++d0)
#pragma unroll
        for (int g = 0; g < 4; ++g) { u32x2 w; w.x = cvt_pk_bf16(o[d0][4 * g], o[d0][4 * g + 1]); w.y = cvt_pk_bf16(o[d0][4 * g + 2], o[d0][4 * g + 3]);
            *(u32x2*)(orow + 32 * d0 + 8 * g + 4 * hi) = w; }
}

__device__ __forceinline__ void gating_phase(CArgs a, int layer, LAS unsigned char* lds, int tid) {
    asm volatile("" : "+v"(tid));
    unsigned* ctl = (unsigned*)(a->ws + WS_CTL);
    const int* kmean = (const int*)(ctl + CW_KMEAN + 49152 * layer);
    unsigned* cnt = ctl + CW_CNT + 1024 * layer;
    unsigned* list = (unsigned*)(a->ws + WS_LIST);
    const bf16_t* QC = (const bf16_t*)(a->ws + WS_QC);
    const int half = tid >> 8, ht = tid & 255;
    LAS float* km = (LAS float*)(lds + half * 16384);
    const bool g256 = gridDim.x == 256;
    for (int u0 = 0; u0 < 768; u0 += 2 * (int)gridDim.x) {
        int u = u0 + 2 * (int)blockIdx.x + half; const bool active = u < 768;
        if (g256 && u0 > 0 && active) { const int w = u - 512; u = 512 + (w & ~63) + (63 - (w & 63)); }
        const int bh = active ? (u >> 6) : 0, ob = active ? (u & 63) : 0;
        for (int i = ht; i < ob * 64; i += 256) km[i] = (float)kmean[bh * 4096 + i] * (1.f / 262144.f);
        __syncthreads();
        if (active && ob > 0) {
            const int b = bh / 6, h = bh % 6, t = ob * 256 + ht;
            const u32x4* qp = (const u32x4*)(QC + ((size_t)(b * SEQ + t)) * 384 + h * 64);
            float q[64];
#pragma unroll
            for (int i = 0; i < 8; ++i) { const u32x4 w = qp[i]; q[8 * i] = bflo(w.x); q[8 * i + 1] = bfhi(w.x); q[8 * i + 2] = bflo(w.y); q[8 * i + 3] = bfhi(w.y);
                q[8 * i + 4] = bflo(w.z); q[8 * i + 5] = bfhi(w.z); q[8 * i + 6] = bflo(w.w); q[8 * i + 7] = bfhi(w.w); }
            float v0 = -INFINITY, v1 = -INFINITY, v2 = -INFINITY; int i0 = 0, i1 = 0, i2 = 0;
            for (int n = 0; n < ob; ++n) {
                float d0 = 0.f, d1 = 0.f;
#pragma unroll
                for (int j = 0; j < 16; j += 2) { const f32x4 ka = *(const LAS f32x4*)(km + n * 64 + 4 * j), kb = *(const LAS f32x4*)(km + n * 64 + 4 * j + 4);
                    d0 += (q[4 * j] * ka.x + q[4 * j + 1] * ka.y) + (q[4 * j + 2] * ka.z + q[4 * j + 3] * ka.w);
                    d1 += (q[4 * j + 4] * kb.x + q[4 * j + 5] * kb.y) + (q[4 * j + 6] * kb.z + q[4 * j + 7] * kb.w); }
                const float dot = d0 + d1;
                if (dot > v2) {
                    if (dot > v1) { v2 = v1; i2 = i1; if (dot > v0) { v1 = v0; i1 = i0; v0 = dot; i0 = n; } else { v1 = dot; i1 = n; } }
                    else { v2 = dot; i2 = n; }
                }
            }
            const int nsel = ob < 3 ? ob : 3;
#pragma unroll
            for (int j = 0; j < 3; ++j) if (j < nsel) { const int n = (j == 0) ? i0 : (j == 1) ? i1 : i2;
                const unsigned pos = atomicAdd(cnt + bh * 64 + n, 1u);
                list[list_off(bh, n) + pos] = ((unsigned)t << 2) | (unsigned)j; }
        }
        __syncthreads();
    }
}

__device__ __forceinline__ unsigned my_xcc_id() { return (unsigned)__builtin_amdgcn_s_getreg((3 << 11) | 20) & 7u; }
constexpr int CW_XQ = 3072;
constexpr int PER_X_FOX = 96, PER_X_SEL = 96, PER_X_OWN = 48, PER_X_DIL = 48, PER_X = PER_X_FOX + PER_X_SEL + PER_X_OWN + PER_X_DIL;
constexpr int NU_FOX = 768, NU_SEL = 768, NU_OWN = 384, NU_DIL = 384, NU_TOTAL = NU_FOX + NU_SEL + NU_OWN + NU_DIL;
__device__ __forceinline__ void attention_phase(CArgs a, int layer, LAS unsigned char* lds, char* lds_gen, int tid, int lane, int wave) {
    asm volatile("" : "+v"(tid), "+v"(lane));
    unsigned* ctl = (unsigned*)(a->ws + WS_CTL);
    unsigned* qctr = ctl + CW_QCTR + 64 * layer;
    const unsigned* cnt = ctl + CW_CNT + 1024 * layer;
    const unsigned* list = (const unsigned*)(a->ws + WS_LIST);
    volatile LAS unsigned* qw = (volatile LAS unsigned*)(lds + LDS_QW);
    LAS unsigned char* vscr = lds + wave * 9216;
    bf16_t* QCp = (bf16_t*)(a->ws + WS_QC); const bf16_t* KCp = (const bf16_t*)(a->ws + WS_KC); const bf16_t* VCp = (const bf16_t*)(a->ws + WS_VC);
    bf16_t* PO = (bf16_t*)(a->ws + WS_PO); float* PLSE = (float*)(a->ws + WS_PLSE);
    for (;;) {
        __syncthreads();
        if (tid == 0) *qw = atomicAdd(qctr, 1u);
        __syncthreads();
        const int u = (int)*qw;
        if (u >= NU_TOTAL) break;
        int lane_ = lane; asm volatile("" : "+v"(lane_)); const int r32 = lane_ & 31, hi = lane_ >> 5;
        if (u < NU_FOX) {
            const int qb = 63 - u / 12, bh = u % 12, b = bh / 6, h = bh % 6;
#ifdef FOX_SIMPLE
            {   const int t = 256 * qb + 32 * wave + r32; const size_t tok = (size_t)(b * SEQ + t);
                bf16_t* qrow = (bf16_t*)(a->ws + WS_QA) + tok * 384 + h * 64;
                const bf16_t* Kb = (const bf16_t*)(a->ws + WS_KA) + (size_t)(b * SEQ) * 384 + h * 64; const bf16_t* Vb = (const bf16_t*)(a->ws + WS_VA) + (size_t)(b * SEQ) * 384 + h * 64;
                f32x16 o[2]; float lse2;
                small_attn(qrow, 8 * qb + wave + 1, Kb, Vb, 384, 0, 1, 0, t, 1 << 29, vscr, lane, o, lse2, (const float*)(a->ws + WS_CUM) + (size_t)bh * SEQ);
                small_store(qrow, o, hi); }
#elif !defined(NO_FOX)
#ifdef PROBE_FOX2
            attn_body::attn_unit<24>(b, h, qb, (const attn_body::bf16*)(a->ws + WS_QA), (const attn_body::bf16*)(a->ws + WS_KA), (const attn_body::bf16*)(a->ws + WS_VA),
                                    (attn_body::bf16*)(a->ws + 487 * MiB), (const float*)(a->ws + WS_CUM) + (size_t)bh * SEQ, lds_gen);
#endif
            attn_body::attn_unit<24>(b, h, qb, (const attn_body::bf16*)(a->ws + WS_QA), (const attn_body::bf16*)(a->ws + WS_KA), (const attn_body::bf16*)(a->ws + WS_VA),
                                    (attn_body::bf16*)(a->ws + WS_QA), (const float*)(a->ws + WS_CUM) + (size_t)bh * SEQ, lds_gen);
#endif
        } else if (u < NU_FOX + NU_SEL) {
            const int v = u - NU_FOX, n = v / 12, bh = v % 12, b = bh / 6, h = bh % 6;
            int cn = (int)cnt[bh * 64 + n]; const int cap = (63 - n) * 256; cn = cn < cap ? cn : cap;
            const unsigned* lp = list + list_off(bh, n);
            const bf16_t* Kb = KCp + (size_t)(b * SEQ) * 384 + h * 64; const bf16_t* Vb = VCp + (size_t)(b * SEQ) * 384 + h * 64;
#ifdef PROBE_SMALL2
            for (int rep_ = 0; rep_ < 2; ++rep_)
#endif
            for (int c = wave; c * 32 < cn; c += NWAVES) {
                const int e = c * 32 + r32; const bool valid = e < cn;
                const unsigned ent = lp[valid ? e : 0];
                const int t = (int)(ent >> 2), slot = (int)(ent & 3);
                const size_t tok = (size_t)(b * SEQ + t);
                f32x16 o[2]; float lse2;
                small_attn(QCp + tok * 384 + h * 64, 8, Kb, Vb, 384, 0, 1, 256 * n, 1 << 28, 1 << 29, vscr, lane, o, lse2);
                if (valid) { small_store(PO + ((tok * 6 + h) * 4 + slot) * 64, o, hi); if (hi == 0) PLSE[(tok * 6 + h) * 4 + slot] = lse2; }
            }
        } else if (u < NU_FOX + NU_SEL + NU_OWN) {
            const int v = u - NU_FOX - NU_SEL, bh = v / 32, pr = v % 32, b = bh / 6, h = bh % 6;
            const bf16_t* Kb = KCp + (size_t)(b * SEQ) * 384 + h * 64; const bf16_t* Vb = VCp + (size_t)(b * SEQ) * 384 + h * 64;
#ifdef PROBE_SMALL2
            for (int rep_ = 0; rep_ < 2; ++rep_)
#endif
            for (int s = 0; s < 2; ++s) {
                const int blk = 2 * pr + s, ch = s == 0 ? wave : 7 - wave;
                const int t = 256 * blk + 32 * ch + r32; const size_t tok = (size_t)(b * SEQ + t);
                f32x16 o[2]; float lse2;
                small_attn(QCp + tok * 384 + h * 64, ch + 1, Kb, Vb, 384, 0, 1, 256 * blk, 32 * ch + r32, 1 << 29, vscr, lane, o, lse2);
                small_store(PO + ((tok * 6 + h) * 4 + 3) * 64, o, hi); if (hi == 0) PLSE[(tok * 6 + h) * 4 + 3] = lse2;
            }
        } else {
            const int v = u - NU_FOX - NU_SEL - NU_OWN;
            for (int j4 = 0; j4 < 4; ++j4) {
            const int wu = (v * NWAVES + wave) * 4 + j4;
            const int c512 = wu & 511, rest = wu >> 9, kvh = rest & 3, g = (rest >> 2) % 3, b = rest / 12;
            const int dil = g == 0 ? 1 : (g == 1 ? 4 : 16), cpc = 512 / dil;
            const int res = c512 / cpc, cidx = c512 % cpc, qc0 = 32 * cidx, qc = qc0 + r32, tq = qc * dil + res;
            const size_t tok = (size_t)(b * SEQ + tq);
            bf16_t* qrow = (bf16_t*)(a->ws + WS_QB) + tok * 768 + (g * 4 + kvh) * 64;
            const bf16_t* Kb = (const bf16_t*)(a->ws + WS_KB) + (size_t)(b * SEQ) * 256 + kvh * 64; const bf16_t* Vb = (const bf16_t*)(a->ws + WS_VB) + (size_t)(b * SEQ) * 256 + kvh * 64;
            f32x16 o[2]; float lse2;
            small_attn(qrow, 5, Kb, Vb, 256, qc0 - 128, dil, res, qc, 128, vscr, lane, o, lse2);
            small_store(qrow, o, hi);
            if (hi == 0) ((float*)(a->ws + WS_LSEB))[((size_t)g * T + tok) * 4 + kvh] = lse2;
            }
        }
    }
}

__device__ __forceinline__ void combine_phase(CArgs a, int tid) {
    asm volatile("" : "+v"(tid));
    const size_t gt = (size_t)blockIdx.x * (NWAVES * 64) + tid, gs = (size_t)gridDim.x * (NWAVES * 64);
    bf16_t* QBp = (bf16_t*)(a->ws + WS_QB); const float* LSEB = (const float*)(a->ws + WS_LSEB);
    for (size_t i = gt; i < (size_t)T * 32; i += gs) {
        const int ch = (int)(i & 7), kvh = (int)((i >> 3) & 3); const size_t tok = i >> 5;
        float l[3], w[3];
#pragma unroll
        for (int g = 0; g < 3; ++g) l[g] = LSEB[((size_t)g * T + tok) * 4 + kvh];
        const float mx = fmaxf(l[0], fmaxf(l[1], l[2]));
        float ws_ = 0.f;
#pragma unroll
        for (int g = 0; g < 3; ++g) { w[g] = __builtin_amdgcn_exp2f(l[g] - mx); ws_ += w[g]; }
        const float inv = 1.f / ws_;
        float y[8] = {0.f, 0.f, 0.f, 0.f, 0.f, 0.f, 0.f, 0.f};
#pragma unroll
        for (int g = 0; g < 3; ++g) { const u32x4 ow = *(const u32x4*)(QBp + tok * 768 + (g * 4 + kvh) * 64 + ch * 8); const float wg = w[g] * inv;
            y[0] += wg * bflo(ow.x); y[1] += wg * bfhi(ow.x); y[2] += wg * bflo(ow.y); y[3] += wg * bfhi(ow.y); y[4] += wg * bflo(ow.z); y[5] += wg * bfhi(ow.z); y[6] += wg * bflo(ow.w); y[7] += wg * bfhi(ow.w); }
        u32x4 r; r.x = cvt_pk_bf16(y[0], y[1]); r.y = cvt_pk_bf16(y[2], y[3]); r.z = cvt_pk_bf16(y[4], y[5]); r.w = cvt_pk_bf16(y[6], y[7]);
        *(u32x4*)(QBp + tok * 768 + kvh * 64 + ch * 8) = r;
    }
    bf16_t* QCp = (bf16_t*)(a->ws + WS_QC); const bf16_t* PO = (const bf16_t*)(a->ws + WS_PO); const float* PLSE = (const float*)(a->ws + WS_PLSE);
    for (size_t i = gt; i < (size_t)T * 48; i += gs) {
        const int ch = (int)(i & 7); const size_t th = i >> 3; const int h = (int)(th % 6); const size_t tok = th / 6;
        const int ob = (int)((tok % SEQ) >> 8), nsel = ob < 3 ? ob : 3;
        float l[4], w[4];
#pragma unroll
        for (int j = 0; j < 4; ++j) l[j] = (j == 3 || j < nsel) ? PLSE[th * 4 + j] : -INFINITY;
        const float mx = fmaxf(fmaxf(l[0], l[1]), fmaxf(l[2], l[3]));
        float ws_ = 0.f;
#pragma unroll
        for (int j = 0; j < 4; ++j) { w[j] = __builtin_amdgcn_exp2f(l[j] - mx); ws_ += w[j]; }
        const float inv = 1.f / ws_;
        float y[8] = {0.f, 0.f, 0.f, 0.f, 0.f, 0.f, 0.f, 0.f};
#pragma unroll
        for (int j = 0; j < 4; ++j) if (j == 3 || j < nsel) { const u32x4 ow = *(const u32x4*)(PO + (th * 4 + j) * 64 + ch * 8); const float wg = w[j] * inv;
            y[0] += wg * bflo(ow.x); y[1] += wg * bfhi(ow.x); y[2] += wg * bflo(ow.y); y[3] += wg * bfhi(ow.y); y[4] += wg * bflo(ow.z); y[5] += wg * bfhi(ow.z); y[6] += wg * bflo(ow.w); y[7] += wg * bfhi(ow.w); }
        u32x4 r; r.x = cvt_pk_bf16(y[0], y[1]); r.y = cvt_pk_bf16(y[2], y[3]); r.z = cvt_pk_bf16(y[4], y[5]); r.w = cvt_pk_bf16(y[6], y[7]);
        *(u32x4*)(QCp + tok * 384 + h * 64 + ch * 8) = r;
    }
}

#ifndef MIXER_ON
#define MIXER_ON 1
#endif
#define XB_TMO      128
#define XB_XCNT(j)  (256  + 64 * (j))
#define XB_XSUB(j)  (1280 + 64 * (j))
#define XB_XGEN(j)  (2304 + 64 * (j))
#define XB_TOP      3328
#define XB_TOPGEN   3392
#define XCD_BAR_WORDS 3456
#define XB_SPIN_CAP (1u << 18)

__device__ __forceinline__ unsigned xb_ld(unsigned* p)              { return __hip_atomic_load(p, __ATOMIC_RELAXED, __HIP_MEMORY_SCOPE_AGENT); }
__device__ __forceinline__ unsigned xb_add(unsigned* p, unsigned v) { return __hip_atomic_fetch_add(p, v, __ATOMIC_RELAXED, __HIP_MEMORY_SCOPE_AGENT); }
__device__ __forceinline__ unsigned xb_xcc_id() { return (unsigned)__builtin_amdgcn_s_getreg((3 << 11) | 20) & 0xFu; }
#define XB_SPIN(cond, bar) do { unsigned _sp = 0; while (cond) { __builtin_amdgcn_s_sleep(1); \
    if ((++_sp & 255u) == 0u) { if (xb_ld(&(bar)[XB_TMO])) break; if (_sp > XB_SPIN_CAP) { atomicAdd(&(bar)[XB_TMO], 1u); break; } } } } while (0)

struct XcdBarrier {
    unsigned* bar; unsigned x;
    volatile LAS unsigned* st;
};

__device__ __forceinline__ XcdBarrier xcd_barrier_post(unsigned* bar, volatile LAS unsigned* st) {
    XcdBarrier b; b.bar = bar; b.x = xb_xcc_id(); b.st = st;
    if (threadIdx.x == 0) (void)xb_add(&bar[XB_XCNT(b.x)], 1u);
    return b;
}
__device__ __forceinline__ void xcd_barrier_complete(unsigned* bar, unsigned x, unsigned& nloc, unsigned& nx) {
    const unsigned G = gridDim.x * gridDim.y * gridDim.z;
    unsigned sum, cnt, mine, sp = 0u;
    for (;;) {
        sum = 0u; cnt = 0u; mine = 0u;
#pragma unroll
        for (unsigned j = 0; j < 16; ++j) { const unsigned c = xb_ld(&bar[XB_XCNT(j)]); sum += c; cnt += (c > 0u) ? 1u : 0u; mine = (j == x) ? c : mine; }
        if (sum == G) break;
        __builtin_amdgcn_s_sleep(1);
        if ((++sp & 255u) == 0u) { if (xb_ld(&bar[XB_TMO])) break; if (sp > XB_SPIN_CAP) { atomicAdd(&bar[XB_TMO], 1u); break; } }
    }
    nloc = mine > 0u ? mine : 1u; nx = cnt > 0u ? cnt : 1u;
}

__device__ __forceinline__ void xcd_barrier(const XcdBarrier& b) {
    asm volatile("s_waitcnt vmcnt(0)" ::: "memory");
    __syncthreads();
    if (threadIdx.x == 0) {
        unsigned* bar = b.bar;
        __builtin_amdgcn_s_waitcnt(0);
        unsigned nloc = b.st[0], nx = b.st[1];
        if (nloc == 0u) { xcd_barrier_complete(bar, b.x, nloc, nx); b.st[0] = nloc; b.st[1] = nx; }
        const unsigned old = xb_add(&bar[XB_XSUB(b.x)], 1u);
        const unsigned gen = old / nloc;
        if (old + 1u == (gen + 1u) * nloc) {
            __builtin_amdgcn_fence(__ATOMIC_RELEASE, "agent");
            asm volatile("s_waitcnt vmcnt(0)" ::: "memory");
            const unsigned og = xb_add(&bar[XB_TOP], 1u);
            const unsigned tg = og / nx;
            if (og + 1u == (tg + 1u) * nx) xb_add(&bar[XB_TOPGEN], 1u);
            else XB_SPIN(xb_ld(&bar[XB_TOPGEN]) == tg, bar);
            __builtin_amdgcn_fence(__ATOMIC_ACQUIRE, "agent");
            xb_add(&bar[XB_XGEN(b.x)], 1u);
            asm volatile("s_waitcnt vmcnt(0)" ::: "memory");
        } else {
            XB_SPIN(xb_ld(&bar[XB_XGEN(b.x)]) == gen, bar);
            __builtin_amdgcn_fence(__ATOMIC_ACQUIRE, "agent");
            asm volatile("s_waitcnt vmcnt(0)" ::: "memory");
        }
    }
    __syncthreads();
}

constexpr int CW_BAR = 110016;
static_assert((CW_BAR + XCD_BAR_WORDS) * 4 <= (int)CTL_BYTES, "ctl");
#define GBX() int G = gridDim.x, bx = blockIdx.x; asm volatile("" : "+s"(G), "+s"(bx))
#define AP() ({ CArgs p_ = kp; asm volatile("" : "+s"(p_)); p_; }); GBX()
#define TIDS() int tid_ = threadIdx.x; asm volatile("" : "+v"(tid_)); const int tid = tid_, lane = tid & 63, wave = __builtin_amdgcn_readfirstlane(tid >> 6); (void)lane; (void)wave
#define XBP(a) ((bf16_t*)((a)->ws + WS_XB))
#define LFP(a) ((float*)((a)->ws + WS_LF))
#define STP(a) ((f32x2*)((a)->ws + 74 * MiB))
#define WLP(a) ((const bf16_t*)((a)->ws + WS_W) + (size_t)layer * W_LAYER)
template <int layer> __device__ __forceinline__ void layer_body(const CArgs kp, LAS unsigned char* lds, unsigned char* lds_raw, const XcdBarrier& bar) {
#if MIXER_ON
        { const CArgs a = AP(); TIDS(); if (bx < 12) scan_bh(LFP(a) + (size_t)bx * SEQ, (float*)(a->ws + WS_CUM) + (size_t)bx * SEQ, lds, tid, lane, wave); }
#ifndef NO_INPROJ
        { const CArgs a = AP(); pg8::StaticOrder S; pg8::Gemm g{XBP(a), WLP(a) + W_IN, 1024, 1024, 1024}; S.init(T, NQKV, G, bx);
          EpiInproj E{a->ws, (const f32x2*)(a->ws + WS_ROPE), (int*)((unsigned*)(a->ws + WS_CTL) + CW_KMEAN + 49152 * layer)};
          pg8::gemm_phase<EpiInproj, true>(lds, g, S, E);
#ifdef PROBE_DUP
          pg8::gemm_phase<EpiInproj, true>(lds, g, S, E);
#endif
 }
#endif
        xcd_barrier(bar);
#ifdef PROBE_BAR2
        xcd_barrier(bar);
#endif
#ifndef NO_GATING
        { const CArgs a = AP(); TIDS(); gating_phase(a, layer, lds, tid); }
#endif
        xcd_barrier(bar);
#ifdef PROBE_BAR2
        xcd_barrier(bar);
#endif
        { const CArgs a = AP(); TIDS(); attention_phase(a, layer, lds, (char*)lds_raw, tid, lane, wave); }
        xcd_barrier(bar);
#ifdef PROBE_BAR2
        xcd_barrier(bar);
#endif
        { const CArgs a = AP(); TIDS(); combine_phase(a, tid); }
        xcd_barrier(bar);
#ifdef PROBE_BAR2
        xcd_barrier(bar);
#endif
        {
            pg8::StaticOrder S; { GBX(); S.init(T, 1024, G, bx); }
            { const CArgs a = AP(); pg8::Gemm g{XBP(a), WLP(a) + W_G, 1024, 1024, 1024}; EpiGate E{(bf16_t*)(a->ws + WS_GS)}; pg8::gemm_phase<EpiGate, true>(lds, g, S, E); }
            { const CArgs a = AP(); pg8::Gemm g{(const bf16_t*)(a->ws + WS_QA), WLP(a) + W_PA, 384, 384, 384}; EpiBranch<1> E{(const bf16_t*)(a->ws + WS_GS), (bf16_t*)(a->ws + WS_MG)}; pg8::gemm_phase<EpiBranch<1>, true>(lds, g, S, E); }
#ifndef ONLY_A
            { const CArgs a = AP(); pg8::Gemm g{XBP(a), WLP(a) + W_G + (size_t)1024 * 1024, 1024, 1024, 1024}; EpiGate E{(bf16_t*)(a->ws + WS_GS)}; pg8::gemm_phase<EpiGate, true>(lds, g, S, E); }
            { const CArgs a = AP(); pg8::Gemm g{(const bf16_t*)(a->ws + WS_QB), WLP(a) + W_PB, 768, 256, 256}; EpiBranch<0> E{(const bf16_t*)(a->ws + WS_GS), (bf16_t*)(a->ws + WS_MG)}; pg8::gemm_phase<EpiBranch<0>, true>(lds, g, S, E); }
            { const CArgs a = AP(); pg8::Gemm g{XBP(a), WLP(a) + W_G + (size_t)2048 * 1024, 1024, 1024, 1024}; EpiGate E{(bf16_t*)(a->ws + WS_GS)}; pg8::gemm_phase<EpiGate, true>(lds, g, S, E); }
            { const CArgs a = AP(); pg8::Gemm g{(const bf16_t*)(a->ws + WS_QC), WLP(a) + W_PC, 384, 384, 384}; EpiBranch<0> E{(const bf16_t*)(a->ws + WS_GS), (bf16_t*)(a->ws + WS_MG)}; pg8::gemm_phase<EpiBranch<0>, true>(lds, g, S, E); }
#endif
        }
#ifdef PROBE_P5
        {
            pg8::StaticOrder S; { GBX(); S.init(T, 1024, G, bx); }
            { const CArgs a = AP(); pg8::Gemm g{XBP(a), WLP(a) + W_G, 1024, 1024, 1024}; EpiGate E{(bf16_t*)(a->ws + WS_GS)}; pg8::gemm_phase<EpiGate, true>(lds, g, S, E); }
            { const CArgs a = AP(); pg8::Gemm g{(const bf16_t*)(a->ws + WS_QA), WLP(a) + W_PA, 384, 384, 384}; EpiBranch<1> E{(const bf16_t*)(a->ws + WS_GS), (bf16_t*)(a->ws + WS_MG)}; pg8::gemm_phase<EpiBranch<1>, true>(lds, g, S, E); }
#ifndef ONLY_A
            { const CArgs a = AP(); pg8::Gemm g{XBP(a), WLP(a) + W_G + (size_t)1024 * 1024, 1024, 1024, 1024}; EpiGate E{(bf16_t*)(a->ws + WS_GS)}; pg8::gemm_phase<EpiGate, true>(lds, g, S, E); }
            { const CArgs a = AP(); pg8::Gemm g{(const bf16_t*)(a->ws + WS_QB), WLP(a) + W_PB, 768, 256, 256}; EpiBranch<0> E{(const bf16_t*)(a->ws + WS_GS), (bf16_t*)(a->ws + WS_MG)}; pg8::gemm_phase<EpiBranch<0>, true>(lds, g, S, E); }
            { const CArgs a = AP(); pg8::Gemm g{XBP(a), WLP(a) + W_G + (size_t)2048 * 1024, 1024, 1024, 1024}; EpiGate E{(bf16_t*)(a->ws + WS_GS)}; pg8::gemm_phase<EpiGate, true>(lds, g, S, E); }
            { const CArgs a = AP(); pg8::Gemm g{(const bf16_t*)(a->ws + WS_QC), WLP(a) + W_PC, 384, 384, 384}; EpiBranch<0> E{(const bf16_t*)(a->ws + WS_GS), (bf16_t*)(a->ws + WS_MG)}; pg8::gemm_phase<EpiBranch<0>, true>(lds, g, S, E); }
#endif
        }
#endif
        xcd_barrier(bar);
#ifdef PROBE_BAR2
        xcd_barrier(bar);
#endif
        { const CArgs a = AP(); pg8::StaticOrder S; pg8::Gemm g{(const bf16_t*)(a->ws + WS_MG), WLP(a) + W_O, 1024, 1024, 1024}; S.init(T, 1024, G, bx);
          EpiResid E{layer == 0 ? a->in[0] : (const float*)a->out, a->out, STP(a), layer == 0 ? a->in[1] : a->in[14] + (layer - 1) * DM, layer == 0 ? a->in[2] : a->in[15] + (layer - 1) * DM};
          pg8::gemm_phase<EpiResid, true>(lds, g, S, E); }
        xcd_barrier(bar);
#ifdef PROBE_BAR2
        xcd_barrier(bar);
#endif
#else
        {
            const CArgs a = AP(); TIDS();
            for (size_t i = (size_t)bx * 512 + tid; i < (size_t)T * DM / 4; i += (size_t)G * 512) { f32x4* p = (f32x4*)a->out + i; *p = *p * DN_ALPHA; }
        }
        xcd_barrier(bar);
#ifdef PROBE_BAR2
        xcd_barrier(bar);
#endif
#endif
        { const CArgs a = AP(); TIDS(); ln_phase(a->out, a->in[9] + layer * DM, a->in[10] + layer * DM, a->out, STP(a), XBP(a), nullptr, nullptr, nullptr, lds, tid, lane, wave);
#ifdef PROBE_P0LN
          ln_phase(a->out, a->in[9] + layer * DM, a->in[10] + layer * DM, a->out, STP(a), XBP(a), nullptr, nullptr, nullptr, lds, tid, lane, wave);
#endif
 }
        xcd_barrier(bar);
#ifdef PROBE_BAR2
        xcd_barrier(bar);
#endif
#ifndef NO_P8
        { const CArgs a = AP(); pg8::StaticOrder S; pg8::Gemm g{XBP(a), WLP(a) + W_GU, 1024, 1024, 1024}; S.init(T, 2 * DFF, G, bx); EpiSwiglu E{(bf16_t*)(a->ws + WS_H)}; pg8::gemm_phase<EpiSwiglu, true>(lds, g, S, E);
#ifdef PROBE_DUP
          pg8::gemm_phase<EpiSwiglu, true>(lds, g, S, E);
#endif
 }
#endif
        xcd_barrier(bar);
#ifdef PROBE_BAR2
        xcd_barrier(bar);
#endif
#ifndef NO_P9
        { const CArgs a = AP(); pg8::StaticOrder S; pg8::Gemm g{(const bf16_t*)(a->ws + WS_H), WLP(a) + W_D, DFF, DFF, DFF}; S.init(T, 1024, G, bx); EpiResid E{a->out, a->out, STP(a), a->in[9] + layer * DM, a->in[10] + layer * DM}; pg8::gemm_phase<EpiResid, true>(lds, g, S, E); }
#endif
        xcd_barrier(bar);
#ifdef PROBE_BAR2
        xcd_barrier(bar);
#endif
        if (layer + 1 < DEPTH) {
            { const CArgs a = AP(); TIDS(); ln_phase(a->out, a->in[14] + layer * DM, a->in[15] + layer * DM, a->out, STP(a), XBP(a), a->in[3] + (size_t)(layer + 1) * 1024 * DIN, a->in[4] + (layer + 1) * 6, LFP(a), lds, tid, lane, wave);
#ifdef PROBE_P0LN
              ln_phase(a->out, a->in[14] + layer * DM, a->in[15] + layer * DM, a->out, STP(a), XBP(a), a->in[3] + (size_t)(layer + 1) * 1024 * DIN, a->in[4] + (layer + 1) * 6, LFP(a), lds, tid, lane, wave);
#endif
 }
            xcd_barrier(bar);
#ifdef PROBE_BAR2
        xcd_barrier(bar);
#endif
        } else {
            const CArgs a = AP(); TIDS(); ln_phase(a->out, a->in[14] + layer * DM, a->in[15] + layer * DM, a->out, nullptr, XBP(a), nullptr, nullptr, nullptr, lds, tid, lane, wave);
        }
}

__global__ void __launch_bounds__(NWAVES * 64, 2) fwd_kernel(Args a_unused) {
    extern __shared__ __attribute__((aligned(16))) unsigned char lds_raw[];
    cg::grid_group grid = cg::this_grid();
    LAS unsigned char* lds = (LAS unsigned char*)lds_raw;
    const CArgs kp = (CArgs)__builtin_amdgcn_kernarg_segment_ptr();
    if (threadIdx.x < 16) ((LAS unsigned*)(lds + LDS_QW + 64))[threadIdx.x] = 0u;
    __syncthreads();
    const XcdBarrier bar = xcd_barrier_post((unsigned*)(kp->ws + WS_CTL) + CW_BAR, (volatile LAS unsigned*)(lds + LDS_QW + 64));

    {
        const CArgs a = AP(); TIDS();
        LAS float* scr = (LAS float*)(lds + wave * 16384);
        for (int it = bx * NWAVES + wave; it < 2 * IT_LAYER; it += G * NWAVES) prologue_item(a, it, scr, lane);
        f32x2* rope = (f32x2*)(a->ws + WS_ROPE);
        for (int i = bx * (NWAVES * 64) + tid; i < SEQ * 8; i += G * NWAVES * 64) {
            const int pos = i >> 3, fi = i & 7; double t = (double)pos * ROPE_FR[fi]; t -= floor(t); const float fr = (float)t;
            rope[i] = (f32x2){__builtin_amdgcn_cosf(fr), __builtin_amdgcn_sinf(fr)};
        }
        __syncthreads();
        ln_phase(a->in[0], a->in[1], a->in[2], a->out, STP(a), XBP(a), a->in[3], a->in[4], LFP(a), lds, tid, lane, wave);
#ifdef PROBE_P0LN
        for (int it = bx * NWAVES + wave; it < 2 * IT_LAYER; it += G * NWAVES) prologue_item(a, it, scr, lane);
        __syncthreads();
        ln_phase(a->in[0], a->in[1], a->in[2], a->out, STP(a), XBP(a), a->in[3], a->in[4], LFP(a), lds, tid, lane, wave);
#endif
    }
    grid.sync();

    layer_body<0>(kp, lds, lds_raw, bar);
    layer_body<1>(kp, lds, lds_raw, bar);
}

extern "C" void kernel_launch(void* const* d_in, const int* in_sizes, int n_in, void* d_out, int out_size, void* d_ws, size_t ws_size, hipStream_t stream) {
    static int grid = 0;
    if (grid == 0) {
        if (n_in != 16 || in_sizes[0] != T * DM || out_size != T * DM || ws_size < WS_END) {
            fprintf(stderr, "kernel_launch: unexpected problem geometry (n_in %d, in0 %d, out %d, ws %zu)\n", n_in, n_in > 0 ? in_sizes[0] : -1, out_size, ws_size); grid = -1; return; }
        int dev = 0, cus = 0, per_cu = 0;
        (void)hipGetDevice(&dev); (void)hipDeviceGetAttribute(&cus, hipDeviceAttributeMultiprocessorCount, dev);
        if (hipFuncSetAttribute((const void*)fwd_kernel, hipFuncAttributeMaxDynamicSharedMemorySize, LDS_BYTES) != hipSuccess) { fprintf(stderr, "kernel_launch: hipFuncSetAttribute failed\n"); grid = -1; return; }
        if (hipOccupancyMaxActiveBlocksPerMultiprocessor(&per_cu, (const void*)fwd_kernel, NWAVES * 64, LDS_BYTES) != hipSuccess || per_cu < 1) { fprintf(stderr, "kernel_launch: occupancy query says %d\n", per_cu); per_cu = 1; }
        (void)hipGetLastError();
        grid = cus * 1;
        if (grid % 8 != 0 || grid <= 0) grid = 256;
    }
    if (grid < 0) return;
    (void)hipMemsetAsync((char*)d_ws + WS_CTL, 0, CTL_BYTES, stream);
    Args a{};
    for (int i = 0; i < 16; ++i) a.in[i] = (const float*)d_in[i];
    a.out = (float*)d_out; a.ws = (unsigned char*)d_ws;
    void* args[] = {&a};
    const hipError_t e = hipLaunchCooperativeKernel((const void*)fwd_kernel, dim3(grid), dim3(NWAVES * 64), args, LDS_BYTES, stream);
    if (e != hipSuccess) fprintf(stderr, "kernel_launch: cooperative launch failed: %s (grid %d)\n", hipGetErrorString(e), grid);
}
```

```cpp
#include <hip/hip_runtime.h>
#include <hip/hip_cooperative_groups.h>
#include <hip/hip_bf16.h>
#include <cstdio>
#include <cstdint>
#include <cmath>
namespace cg = cooperative_groups;

#define LAS __attribute__((address_space(3)))
typedef unsigned short bf16_t;
typedef short bf16x8 __attribute__((ext_vector_type(8)));
typedef short s16x4 __attribute__((ext_vector_type(4)));
typedef float f32x2 __attribute__((ext_vector_type(2)));
typedef float f32x4 __attribute__((ext_vector_type(4)));
typedef float f32x16 __attribute__((ext_vector_type(16)));
typedef unsigned u32x4 __attribute__((ext_vector_type(4)));
typedef unsigned u32x2 __attribute__((ext_vector_type(2)));

constexpr int BATCH = 2, SEQ = 16384, DM = 1024, T = BATCH * SEQ, DEPTH = 2, DFF = 2816, DIN = 6662;
constexpr int NQKV = 3584, NG = 3072;
constexpr float LN_EPS = 1e-5f;
constexpr float DN_ALPHA = 1.4142135623730951f;
constexpr float LOG2E = 1.4426950408889634f;
constexpr float C2 = 0.125f * LOG2E;
constexpr int NWAVES = 8;

typedef __bf16 bf16x2_t __attribute__((ext_vector_type(2)));
__device__ __forceinline__ unsigned cvt_pk_bf16(float lo, float hi) { f32x2 v = {lo, hi}; bf16x2_t b = __builtin_convertvector(v, bf16x2_t); return __builtin_bit_cast(unsigned, b); }
__device__ __forceinline__ float bf2f(unsigned short b) { return __uint_as_float(((unsigned)b) << 16); }
__device__ __forceinline__ float bflo(unsigned w) { return __uint_as_float(w << 16); }
__device__ __forceinline__ float bfhi(unsigned w) { return __uint_as_float(w & 0xffff0000u); }

namespace pg8 {
constexpr int BM = 256, BK = 64, HALF = 128, HTB = HALF * BK * 2, STAGE_BYTES = 8 * HTB, NXCD = 8, WGM = 8;
__host__ __device__ __forceinline__ int lds_byte(int r, int c) { const int st = (r >> 4) * 2 + (c >> 5), rr = r & 15, cc = c & 31, ob = rr * 64 + cc * 2; return st * 1024 + (ob ^ (((ob >> 9) & 1) << 5)); }
__host__ __device__ __forceinline__ void stage_rc(int b, int& R, int& C) { const int st = b / 1024, sb = b % 1024, swz = sb ^ (((sb >> 9) & 1) << 5); R = (st >> 1) * 16 + swz / 64; C = (st & 1) * 32 + (swz % 64) / 2; }
__host__ __device__ __forceinline__ int perm32(int rho) { const int n = rho >> 4, i = rho & 15; return 8 * (i >> 2) + 4 * n + (i & 3); }

struct Unit { int pm, pn; };
struct Gemm { const bf16_t* A; const bf16_t* Bt; int lda, ldb, K; };

struct StaticOrder {
    int nM, nN, nwg, G, c;
    __host__ __device__ void init(int M, int N, int G_, int c_) { nM = M / BM; nN = N / BM; nwg = nM * nN; G = G_; c = c_; }
    __host__ __device__ bool next(int i, Unit& u) const {
        const long L = (long)i * G + c; if (L >= nwg) return false;
        int wgid = (int)L; { const int q = nwg / NXCD, r = nwg % NXCD, xcd = wgid % NXCD, off = wgid / NXCD; wgid = (xcd < r ? xcd * (q + 1) : r * (q + 1) + (xcd - r) * q) + off; }
        const int nig = WGM * nN, gid = wgid / nig, fm = gid * WGM, gsz = (nM - fm) < WGM ? (nM - fm) : WGM;
        u.pm = fm + ((wgid % nig) % gsz); u.pn = (wgid % nig) / gsz; return true;
    }
};

template <class Epi, bool ALIGN_EPI>
__device__ __forceinline__ void gemm_phase(LAS unsigned char* lds, const Gemm g, const StaticOrder& S, const Epi& E) {
    int tid_ = threadIdx.x; asm volatile("" : "+v"(tid_));
    const int tid = tid_, wid = __builtin_amdgcn_readfirstlane(tid >> 6), lane = tid & 63, wr = wid >> 2, wc = wid & 3, fr = lane & 15, fq = lane >> 4;
    const int nt = g.K / BK;
    unsigned voffA[2], voffB[2];
#pragma unroll
    for (int i = 0; i < 2; ++i) { int R, C; stage_rc(tid * 16 + i * 8192, R, C); const int Rb = (R & ~31) + perm32(R & 31);
        voffA[i] = (unsigned)(R * g.lda + C) * 2u; voffB[i] = (unsigned)(Rb * g.ldb + C) * 2u; }
    const size_t kstep = (size_t)(BK * 2);
    const size_t hA = (size_t)HALF * g.lda * 2, hB = (size_t)HALF * g.ldb * 2;
    const size_t tA = 2 * hA, tB = 2 * hB;
    const unsigned ldsw = (unsigned)wid * 1024u;
    const int aoff = lds_byte(wr * 64 + fr, fq * 8), boff = lds_byte(wc * 32 + fr, fq * 8);
#define PG8_SA(b, h) (((b) * 2 + (h)) * HTB)
#define PG8_SB(b, h) ((4 + (b) * 2 + (h)) * HTB)
#define PG8_STAGE(bufoff, gbase, voff) do { _Pragma("unroll") for (int _i = 0; _i < 2; ++_i) \
        __builtin_amdgcn_global_load_lds((const unsigned*)((const char*)(gbase) + (voff)[_i]), (LAS unsigned*)(lds + (bufoff) + ldsw + _i * 8192), 16, 0, 0); } while (0)
#define PG8_LDA(dst, b, h) do { _Pragma("unroll") for (int m = 0; m < 4; ++m) _Pragma("unroll") for (int k = 0; k < 2; ++k) dst[m][k] = *(const LAS bf16x8*)(lds + PG8_SA(b, h) + aoff + m * 2048 + k * 1024); } while (0)
#define PG8_LDB(dst, b, h) do { _Pragma("unroll") for (int n = 0; n < 2; ++n) _Pragma("unroll") for (int k = 0; k < 2; ++k) dst[n][k] = *(const LAS bf16x8*)(lds + PG8_SB(b, h) + boff + n * 2048 + k * 1024); } while (0)
#define PG8_MMA(ai, bj, At, Bt) do { __builtin_amdgcn_s_setprio(1); _Pragma("unroll") for (int m = 0; m < 4; ++m) _Pragma("unroll") for (int n = 0; n < 2; ++n) _Pragma("unroll") for (int k = 0; k < 2; ++k) \
        acc[ai][bj][m][n] = __builtin_amdgcn_mfma_f32_16x16x32_bf16(Bt[n][k], At[m][k], acc[ai][bj][m][n], 0, 0, 0); __builtin_amdgcn_s_setprio(0); } while (0)
#define PG8_WAIT_V(n) asm volatile("s_waitcnt vmcnt(" #n ")" ::: "memory")
#define PG8_WAIT_L(n) asm volatile("s_waitcnt lgkmcnt(" #n ")" ::: "memory")
#define PG8_BAR __builtin_amdgcn_s_barrier()
#define PG8_SCHED __builtin_amdgcn_sched_barrier(0)
    Unit cur, nxt; int ui = 0;
    if (!S.next(0, cur)) return;
    f32x4 acc[2][2][4][2];
#pragma unroll
    for (int a = 0; a < 2; ++a)
#pragma unroll
        for (int b = 0; b < 2; ++b)
#pragma unroll
            for (int m = 0; m < 4; ++m)
#pragma unroll
                for (int n = 0; n < 2; ++n) acc[a][b][m][n] = (f32x4){0.f, 0.f, 0.f, 0.f};
    bf16x8 At[4][2], B0[2][2], B1[2][2];
    const char* cA = (const char*)g.A + (size_t)cur.pm * tA; const char* cB = (const char*)g.Bt + (size_t)cur.pn * tB;
    PG8_STAGE(PG8_SB(0, 0), cB, voffB); PG8_STAGE(PG8_SB(0, 1), cB + hB, voffB); PG8_STAGE(PG8_SA(0, 0), cA, voffA); PG8_STAGE(PG8_SA(0, 1), cA + hA, voffA);
    if (wr == 1) PG8_BAR;
    PG8_WAIT_V(2); PG8_BAR;
    PG8_STAGE(PG8_SB(1, 0), cB + kstep, voffB); PG8_STAGE(PG8_SA(1, 0), cA + kstep, voffA); PG8_STAGE(PG8_SB(1, 1), cB + hB + kstep, voffB);
    PG8_WAIT_V(6); PG8_BAR;
    for (;;) {
        const bool has_next = S.next(ui + 1, nxt);
        const char* nA = has_next ? (const char*)g.A + (size_t)nxt.pm * tA : cA; const char* nB = has_next ? (const char*)g.Bt + (size_t)nxt.pn * tB : cB;
        for (int t = 0; t < nt; t += 2) {
            const bool last = (t == nt - 2);
            const char* a1 = cA + (size_t)(t + 1) * kstep;
            const char* a2 = last ? nA : cA + (size_t)(t + 2) * kstep; const char* b2 = last ? nB : cB + (size_t)(t + 2) * kstep;
            const char* a3 = a2 + kstep; const char* b3 = b2 + kstep;
            PG8_LDB(B0, 0, 0); PG8_LDB(B1, 0, 1); PG8_SCHED; PG8_LDA(At, 0, 0); PG8_STAGE(PG8_SA(1, 1), a1 + hA, voffA);
            PG8_WAIT_V(8); PG8_WAIT_L(0); PG8_BAR; PG8_MMA(0, 0, At, B0); PG8_MMA(0, 1, At, B1); PG8_BAR; PG8_SCHED;
            PG8_LDA(At, 0, 1); PG8_STAGE(PG8_SB(0, 0), b2, voffB); PG8_STAGE(PG8_SB(0, 1), b2 + hB, voffB); PG8_STAGE(PG8_SA(0, 0), a2, voffA);
            PG8_WAIT_V(8); PG8_WAIT_L(0); PG8_BAR; PG8_MMA(1, 0, At, B0); PG8_MMA(1, 1, At, B1); PG8_BAR; PG8_SCHED;
            PG8_LDB(B0, 1, 0); PG8_LDB(B1, 1, 1); PG8_SCHED; PG8_LDA(At, 1, 0); PG8_STAGE(PG8_SA(0, 1), a2 + hA, voffA);
            PG8_WAIT_V(8); PG8_WAIT_L(0); PG8_BAR; PG8_MMA(0, 0, At, B0); PG8_MMA(0, 1, At, B1); PG8_BAR; PG8_SCHED;
            PG8_LDA(At, 1, 1); PG8_STAGE(PG8_SB(1, 0), b3, voffB); PG8_STAGE(PG8_SB(1, 1), b3 + hB, voffB); PG8_STAGE(PG8_SA(1, 0), a3, voffA);
            PG8_WAIT_V(8); PG8_WAIT_L(0); PG8_BAR; PG8_MMA(1, 0, At, B0); PG8_MMA(1, 1, At, B1); PG8_BAR; PG8_SCHED;
        }
        if constexpr (ALIGN_EPI) { if (wr == 0) PG8_BAR; }
        E(acc, cur, wr, wc, fr, fq);
        if (!has_next) break;
#pragma unroll
        for (int a = 0; a < 2; ++a)
#pragma unroll
            for (int b = 0; b < 2; ++b)
#pragma unroll
                for (int m = 0; m < 4; ++m)
#pragma unroll
                    for (int n = 0; n < 2; ++n) acc[a][b][m][n] = (f32x4){0.f, 0.f, 0.f, 0.f};
        cur = nxt; cA = nA; cB = nB; ++ui;
        if constexpr (ALIGN_EPI) { if (wr == 1) PG8_BAR; }
    }
    PG8_WAIT_V(0);
    if constexpr (!ALIGN_EPI) { if (wr == 0) PG8_BAR; }
    PG8_BAR;
#undef PG8_SA
#undef PG8_SB
#undef PG8_STAGE
#undef PG8_LDA
#undef PG8_LDB
#undef PG8_MMA
#undef PG8_WAIT_V
#undef PG8_WAIT_L
#undef PG8_BAR
#undef PG8_SCHED
}
}
namespace attn_body {
using bf16=__hip_bfloat16;
using bf16x8=__attribute__((ext_vector_type(8)))short;
using s16x4=__attribute__((ext_vector_type(4)))short;
using f32x16=__attribute__((ext_vector_type(16)))float;
using u32x4=__attribute__((ext_vector_type(4)))unsigned;
using f32x4v=__attribute__((ext_vector_type(4)))float;
constexpr int BATCH=2,NHEAD=6,SEQ=16384,D=64,DM=NHEAD*D;
constexpr int NW=8,QBLK=32,QB=QBLK*NW,KVBLK=64,NQB=SEQ/QB;
constexpr int ATTN_PITCH=DM, ATTN_UNIT_ROWS=QB;
__device__ __forceinline__ int crow(int r,int hi){return (r&3)+8*(r>>2)+4*hi;}
#define SBAR() __builtin_amdgcn_sched_barrier(0)
__device__ __forceinline__ void cmask(f32x16&p0,f32x16&p1,int jb,int qrel,int hi){
  const float NEG=-INFINITY; int kb=64*jb+4*hi;
  #pragma unroll
  for(int r=0;r<16;++r){int kv=kb+(r&3)+8*(r>>2); if(kv>qrel)p0[r]=NEG; if(kv+32>qrel)p1[r]=NEG;}
}

constexpr int NSLOT=3, SLOTB=8192;
constexpr int LDS_K=0, LDS_V=NSLOT*SLOTB, LDS_WS=2*NSLOT*SLOTB, LDS_OST=LDS_WS+NW*64*4, LDS_BIAS=LDS_OST+NW*4096, LDS_BYTES=LDS_BIAS+SEQ*4;
constexpr float C2=0.125f*1.4426950408889634f;
__device__ __forceinline__ void glds16(const void*gsrc,unsigned lds_dst){unsigned keep;
  asm volatile("s_mov_b32 %0, m0\n\ts_mov_b32 m0, %2\n\ts_nop 0\n\tglobal_load_lds_dwordx4 %1, off\n\ts_mov_b32 m0, %0":"=&s"(keep):"v"(gsrc),"s"(lds_dst):"memory");}
__device__ __forceinline__ float max3f(float a,float b,float c){float r;asm("v_max3_f32 %0, %1, %2, %3":"=v"(r):"v"(a),"v"(b),"v"(c));return r;}
__device__ __forceinline__ float max2f(float a,float b){float r;asm("v_max_f32_e32 %0, %1, %2":"=v"(r):"v"(a),"v"(b));return r;}
__device__ __forceinline__ float fadd_s(float a,float b){float r;asm("v_add_f32_e32 %0, %1, %2":"=v"(r):"v"(a),"v"(b));return r;}
__device__ __forceinline__ float fsub_s(float a,float b){float r;asm("v_sub_f32_e32 %0, %1, %2":"=v"(r):"v"(a),"v"(b));return r;}
typedef float f32x2_t __attribute__((ext_vector_type(2))); typedef __bf16 bf16x2_t __attribute__((ext_vector_type(2)));
__device__ __forceinline__ unsigned cvtpk_s(float lo,float hi){f32x2_t v={lo,hi};bf16x2_t b=__builtin_convertvector(v,bf16x2_t);return __builtin_bit_cast(unsigned,b);}
#define WAIT_BAR(N) asm volatile("s_waitcnt vmcnt(" #N ") lgkmcnt(0)\n\ts_barrier":::"memory")

__device__ __forceinline__ void qkt(f32x16&p0,f32x16&p1,const char*Kslot,const bf16x8*qr,int r32,int hi){
  const char*kb=Kslot+hi*1024+r32*16;
  #pragma unroll
  for(int d0=0;d0<4;++d0){
    const bf16x8 b0=*reinterpret_cast<const bf16x8*>(kb+d0*2048);
    const bf16x8 b1=*reinterpret_cast<const bf16x8*>(kb+d0*2048+512);
    {p0=__builtin_amdgcn_mfma_f32_32x32x16_bf16(b0,qr[d0],p0,0,0,0);p1=__builtin_amdgcn_mfma_f32_32x32x16_bf16(b1,qr[d0],p1,0,0,0);}}
}
typedef __attribute__((address_space(3))) const char* lds_cptr;
typedef short v4i16_t __attribute__((ext_vector_type(4)));
__device__ __forceinline__ void kload8(bf16x8*kf,lds_cptr kp){
  kf[0]=*(const __attribute__((address_space(3))) bf16x8*)(kp);      kf[1]=*(const __attribute__((address_space(3))) bf16x8*)(kp+512);
  kf[2]=*(const __attribute__((address_space(3))) bf16x8*)(kp+2048); kf[3]=*(const __attribute__((address_space(3))) bf16x8*)(kp+2560);
  kf[4]=*(const __attribute__((address_space(3))) bf16x8*)(kp+4096); kf[5]=*(const __attribute__((address_space(3))) bf16x8*)(kp+4608);
  kf[6]=*(const __attribute__((address_space(3))) bf16x8*)(kp+6144); kf[7]=*(const __attribute__((address_space(3))) bf16x8*)(kp+6656);
}
__device__ __forceinline__ void kload2(bf16x8*kf,lds_cptr kp,int j){ kf[2*j]=*(const __attribute__((address_space(3))) bf16x8*)(kp+j*2048); kf[2*j+1]=*(const __attribute__((address_space(3))) bf16x8*)(kp+j*2048+512); }
__device__ __forceinline__ s16x4 vtr(lds_cptr p){ return __builtin_bit_cast(s16x4,__builtin_amdgcn_ds_read_tr16_b64_v4i16((__attribute__((address_space(3))) v4i16_t*)p)); }
__device__ __forceinline__ float rowmax(const f32x16&p0,const f32x16&p1){
  float a=max3f(p0[0],p0[1],p1[0]),b=max3f(p0[2],p0[3],p1[1]);a=max3f(a,p1[2],p1[3]);
  #pragma unroll
  for(int r=4;r<16;r+=4){a=max3f(a,p0[r],p0[r+1]);b=max3f(b,p0[r+2],p0[r+3]);a=max3f(a,p1[r],p1[r+1]);b=max3f(b,p1[r+2],p1[r+3]);}
  const float m=max2f(a,b);
  auto rr=__builtin_amdgcn_permlane32_swap(__float_as_uint(m),__float_as_uint(m),false,false);
  return max2f(__uint_as_float(rr[0]),__uint_as_float(rr[1]));
}
__device__ __forceinline__ void pv(f32x16*o,int vb,bf16x8 pa0,bf16x8 pa1,bf16x8 pa2,bf16x8 pa3){
  #pragma unroll
  for(int d0=0;d0<2;++d0){s16x4 lo[4],hi[4];
    #pragma unroll
    for(int ks=0;ks<4;++ks){
      asm volatile("ds_read_b64_tr_b16 %0,%1 offset:%c2":"=&v"(lo[ks]):"v"(vb),"i"(d0*4096+ks*1024):"memory");
      asm volatile("ds_read_b64_tr_b16 %0,%1 offset:%c2":"=&v"(hi[ks]):"v"(vb),"i"(d0*4096+ks*1024+512):"memory");}
    asm volatile("s_waitcnt lgkmcnt(0)":::"memory");SBAR();
    #define PK(k) (bf16x8){lo[k][0],lo[k][1],lo[k][2],lo[k][3],hi[k][0],hi[k][1],hi[k][2],hi[k][3]}
    o[d0]=__builtin_amdgcn_mfma_f32_32x32x16_bf16(pa0,PK(0),o[d0],0,0,0);
    o[d0]=__builtin_amdgcn_mfma_f32_32x32x16_bf16(pa1,PK(1),o[d0],0,0,0);
    o[d0]=__builtin_amdgcn_mfma_f32_32x32x16_bf16(pa2,PK(2),o[d0],0,0,0);
    o[d0]=__builtin_amdgcn_mfma_f32_32x32x16_bf16(pa3,PK(3),o[d0],0,0,0);
    #undef PK
  }
}

#ifndef ATTN_STORE16
#define ATTN_STORE16(p,v) (*(u32x4*)(p)=(v))
#endif
template<int THRL> __device__ __forceinline__ void attn_unit(int b,int h,int qb,const bf16*Q,const bf16*__restrict__ K,const bf16*__restrict__ V,bf16*O,const float*__restrict__ cum,char*shm){
  int tid_=threadIdx.x; asm volatile("":"+v"(tid_)); const int tid=tid_,lane=tid&63,r32=lane&31,hi=lane>>5; const int wid=__builtin_amdgcn_readfirstlane(tid>>6);
  const long rowbase=(long)b*SEQ; const int q0=qb*QB;
  const bf16*Qw=Q+(rowbase+q0+wid*QBLK)*DM+h*D;
  const bf16*Kh=K+rowbase*DM+h*D,*Vh=V+rowbase*DM+h*D;
  const unsigned lds0=(unsigned)(uintptr_t)shm;
  float*wsf=(float*)(shm+LDS_WS)+wid*64;
  const bf16*ksrc=Kh+(long)lane*DM+wid*8;
  const bf16*vsrc=Vh+(long)(16*(wid&3)+(lane>>2))*DM+(wid>>2)*32+(lane&3)*8;
  const unsigned kdst=lds0+LDS_K+wid*1024, vdst=lds0+LDS_V+wid*1024;
  #define DMA_K(t,slot) glds16(ksrc+(long)(t)*KVBLK*DM,(unsigned)__builtin_amdgcn_readfirstlane(kdst+(slot)))
  #define DMA_V(t,slot) glds16(vsrc+(long)(t)*KVBLK*DM,(unsigned)__builtin_amdgcn_readfirstlane(vdst+(slot)))
  const int vb0=(int)(lds0+LDS_V)+((lane>>4)&1)*32+(lane&3)*8+(4*hi+((lane&15)>>2))*64;
  const char*Kbase=shm+LDS_K; bf16x8 kf[8];
  const lds_cptr shm3=(lds_cptr)shm; const lds_cptr kp0=shm3+LDS_K+hi*1024+r32*16; const lds_cptr vp0=shm3+LDS_V+((lane>>4)&1)*32+(lane&3)*8+(4*hi+((lane&15)>>2))*64;
  const int NT=(q0+QB)/KVBLK;
  const __attribute__((address_space(3))) float* biasl=(const __attribute__((address_space(3))) float*)(shm3+LDS_BIAS);
  { __attribute__((address_space(3))) float* bw=(__attribute__((address_space(3))) float*)(shm3+LDS_BIAS);
    for(int i=tid*4;i<q0+QB;i+=NW*64*4){ f32x4v v=*reinterpret_cast<const f32x4v*>(cum+i); v=v*(-1.4426950408889634f); *(__attribute__((address_space(3))) f32x4v*)(bw+i)=v; }
    asm volatile("s_waitcnt vmcnt(0) lgkmcnt(0)\n\ts_barrier":::"memory"); }
  DMA_K(0,0);DMA_V(0,0);DMA_K(1,SLOTB);
  bf16x8 qr[4];
  #pragma unroll
  for(int d0=0;d0<4;++d0)qr[d0]=*reinterpret_cast<const bf16x8*>(&Qw[(long)r32*DM+d0*16+hi*8]);
  float mhat=0.f,l_reg=0.f;f32x16 o[2];o[0]=f32x16{};o[1]=f32x16{};
  #define BIASFILL(C0,C1,t) do{ const __attribute__((address_space(3))) float* bp_=biasl+64*(t)+4*hi; \
    _Pragma("unroll") for(int g_=0;g_<4;++g_){ const f32x4v v_=*(const __attribute__((address_space(3))) f32x4v*)(bp_+8*g_); const f32x4v w_=*(const __attribute__((address_space(3))) f32x4v*)(bp_+32+8*g_); \
      _Pragma("unroll") for(int i_=0;i_<4;++i_){ C0[4*g_+i_]=v_[i_]-mhat; C1[4*g_+i_]=w_[i_]-mhat; } } }while(0)
  const int qrel=wid*QBLK+r32;
  #define CMASK(P0,P1,t) do{int jb_=(t)-(NT-4); if(jb_>=0)cmask(P0,P1,jb_,qrel,hi);}while(0)
  bool resc=false;
  #define START(P0,P1) do{ const float rm=rowmax(P0,P1); resc=false; \
    { const float dl=rm; mhat=fadd_s(mhat,dl); \
      _Pragma("unroll") for(int r=0;r<16;++r){P0[r]=fsub_s(P0[r],dl);P1[r]=fsub_s(P1[r],dl);} \
      } \
    _Pragma("unroll") for(int r=0;r<16;++r)P0[r]=__builtin_amdgcn_exp2f(P0[r]); }while(0)
  #define RESC() do{ if(resc){ asm volatile("s_waitcnt lgkmcnt(0)":::"memory"); \
      _Pragma("unroll") for(int d_=0;d_<2;++d_) _Pragma("unroll") for(int r=0;r<16;++r)o[d_][r]*=wsf[crow(r,hi)]; } }while(0)
  f32x16 pA0,pA1,pB0,pB1;
  int sl_prev=0,sl_cur=0,sl_next=SLOTB;
  #define ROT() do{sl_prev=sl_cur;sl_cur=sl_next;sl_next=(sl_next==(NSLOT-1)*SLOTB)?0:sl_next+SLOTB;}while(0)
  DMA_K(2,2*SLOTB);
  WAIT_BAR(3);
  BIASFILL(pA0,pA1,0); qkt(pA0,pA1,Kbase,qr,r32,hi);asm volatile("s_nop 15\n\ts_nop 7":"+v"(pA0),"+v"(pA1));CMASK(pA0,pA1,0);
  START(pA0,pA1);
  _Pragma("unroll") for(int r=0;r<16;++r)pA1[r]=__builtin_amdgcn_exp2f(pA1[r]);
  WAIT_BAR(0);
  DMA_K(3,0);DMA_V(1,SLOTB);
  ROT();
  kload8(kf,kp0+sl_cur);
  WAIT_BAR(2);
  s16x4 vlo[8],vhi[8]; u32x4 pw0,pw1,pw2,pw3;
  #define PKW(P,B) cvtpk_s(P[B],P[B+1])
  #define PAF(k) __builtin_bit_cast(bf16x8,pw##k)
  #define VFR(i) (bf16x8){vlo[i][0],vlo[i][1],vlo[i][2],vlo[i][3],vhi[i][0],vhi[i][1],vhi[i][2],vhi[i][3]}
  #define PIN(x) asm volatile("":"+v"(x))
  #define MX3(a,b,c) __builtin_fmaxf(__builtin_fmaxf((a),(b)),(c))
  #define GAPA(MF,A0,A1,A2,A3,W0,W1,PW) do{ MF; sacc+=A0; sacc+=A1; sacc+=A2; sacc+=A3; PIN(sacc); W0; W1; PIN(PW); SBAR(); }while(0)
  #define EX(v) __builtin_amdgcn_exp2f(v)
  #define GAPB(MF,X,B) do{ MF; X[B]=EX(X[B]); X[B+1]=EX(X[B+1]); X[B+2]=EX(X[B+2]); X[B+3]=EX(X[B+3]); PIN(X); SBAR(); }while(0)
  #define VRD(i) do{ vlo[i]=vtr(vp_+(((i)>>2)*4096+((i)&3)*1024)); vhi[i]=vtr(vp_+(((i)>>2)*4096+((i)&3)*1024+512)); }while(0)
  #define KRD(G,j) do{ if(G){ kload2(kf,kp0+sl_next,j); SBAR(); } }while(0)
  #define STEP(C0,C1,P0,P1,t,GK,GV,GL) do{ SBAR(); \
    BIASFILL(C0,C1,t); SBAR(); \
    const lds_cptr vp_=vp0+sl_prev; \
    VRD(0); SBAR(); float sacc=(P0[0]+P0[1]); \
    GAPA(C0=__builtin_amdgcn_mfma_f32_32x32x16_bf16(kf[0],qr[0],C0,0,0,0), P0[2],P0[3],P0[4],P0[5],     pw0[0]=PKW(P0,0), pw0[1]=PKW(P0,2), pw0); \
    VRD(4); SBAR(); GAPA(C1=__builtin_amdgcn_mfma_f32_32x32x16_bf16(kf[1],qr[0],C1,0,0,0), P0[6],P0[7],P0[8],P0[9],     pw0[2]=PKW(P0,4), pw0[3]=PKW(P0,6), pw0); \
    VRD(1); SBAR(); GAPA(C0=__builtin_amdgcn_mfma_f32_32x32x16_bf16(kf[2],qr[1],C0,0,0,0),   P0[10],P0[11],P0[12],P0[13], pw1[0]=PKW(P0,8), pw1[1]=PKW(P0,10), pw1); \
    VRD(5); SBAR(); GAPA(C1=__builtin_amdgcn_mfma_f32_32x32x16_bf16(kf[3],qr[1],C1,0,0,0),   P0[14],P0[15],P1[0],P1[1],   pw1[2]=PKW(P0,12),pw1[3]=PKW(P0,14), pw1); \
    VRD(2); SBAR(); GAPA(C0=__builtin_amdgcn_mfma_f32_32x32x16_bf16(kf[4],qr[2],C0,0,0,0),   P1[2],P1[3],P1[4],P1[5],     pw2[0]=PKW(P1,0), pw2[1]=PKW(P1,2), pw2); \
    VRD(6); SBAR(); GAPA(C1=__builtin_amdgcn_mfma_f32_32x32x16_bf16(kf[5],qr[2],C1,0,0,0),   P1[6],P1[7],P1[8],P1[9],     pw2[2]=PKW(P1,4), pw2[3]=PKW(P1,6), pw2); \
    VRD(3); SBAR(); GAPA(C0=__builtin_amdgcn_mfma_f32_32x32x16_bf16(kf[6],qr[3],C0,0,0,0),   P1[10],P1[11],P1[12],P1[13], pw3[0]=PKW(P1,8), pw3[1]=PKW(P1,10), pw3); \
    VRD(7); SBAR(); GAPA(C1=__builtin_amdgcn_mfma_f32_32x32x16_bf16(kf[7],qr[3],C1,0,0,0),   P1[14],P1[15],0.f,0.f,       pw3[2]=PKW(P1,12),pw3[3]=PKW(P1,14), pw3); \
    l_reg+=sacc; \
    if(GK){DMA_K((t)+3,sl_cur);} if(GV){DMA_V((t)+1,sl_next);} \
    CMASK(C0,C1,t); \
    { float a=MX3(C0[0],C0[1],C1[0]),b=MX3(C0[2],C0[3],C1[1]); a=MX3(a,C1[2],C1[3]); \
      _Pragma("unroll") for(int r=4;r<16;r+=4){a=MX3(a,C0[r],C0[r+1]);b=MX3(b,C0[r+2],C0[r+3]);a=MX3(a,C1[r],C1[r+1]);b=MX3(b,C1[r+2],C1[r+3]);} \
      float rm=__builtin_fmaxf(a,b); { auto rr=__builtin_amdgcn_permlane32_swap(__float_as_uint(rm),__float_as_uint(rm),false,false); rm=__builtin_fmaxf(__uint_as_float(rr[0]),__uint_as_float(rr[1])); } \
      resc=false; \
      if(__builtin_expect(__any(rm>(float)THRL),0)){ const float dl=__builtin_fmaxf(rm,0.f); mhat+=dl; \
        _Pragma("unroll") for(int r=0;r<16;++r){C0[r]-=dl;C1[r]-=dl;} \
        const float f=__builtin_amdgcn_exp2f(-dl); l_reg*=f; if(hi==0)wsf[r32]=f; resc=true; } } \
    SBAR(); \
    GAPB(o[0]=__builtin_amdgcn_mfma_f32_32x32x16_bf16(PAF(0),VFR(0),o[0],0,0,0), C0,0); \
    GAPB(o[1]=__builtin_amdgcn_mfma_f32_32x32x16_bf16(PAF(0),VFR(4),o[1],0,0,0), C0,4); \
    KRD(GL,0); GAPB(o[0]=__builtin_amdgcn_mfma_f32_32x32x16_bf16(PAF(1),VFR(1),o[0],0,0,0), C0,8); \
    KRD(GL,1); GAPB(o[1]=__builtin_amdgcn_mfma_f32_32x32x16_bf16(PAF(1),VFR(5),o[1],0,0,0), C0,12); \
    KRD(GL,2); GAPB(o[0]=__builtin_amdgcn_mfma_f32_32x32x16_bf16(PAF(2),VFR(2),o[0],0,0,0), C1,0); \
    KRD(GL,3); GAPB(o[1]=__builtin_amdgcn_mfma_f32_32x32x16_bf16(PAF(2),VFR(6),o[1],0,0,0), C1,4); \
    GAPB(o[0]=__builtin_amdgcn_mfma_f32_32x32x16_bf16(PAF(3),VFR(3),o[0],0,0,0), C1,8); \
    GAPB(o[1]=__builtin_amdgcn_mfma_f32_32x32x16_bf16(PAF(3),VFR(7),o[1],0,0,0), C1,12); \
    }while(0)
  int t=1;
  #undef CMASK
  #define CMASK(P0,P1,t) do{}while(0)
  for(;t+5<NT;t+=2){
    STEP(pB0,pB1,pA0,pA1,t,true,true,true);     WAIT_BAR(2); RESC(); ROT();
    STEP(pA0,pA1,pB0,pB1,t+1,true,true,true);   WAIT_BAR(2); RESC(); ROT();
  }
  #undef CMASK
  #define CMASK(P0,P1,t) do{int jb_=(t)-(NT-4); if(jb_>=0)cmask(P0,P1,jb_,qrel,hi);}while(0)
  #define ENDW(tt) do{ if((tt)+3<NT){WAIT_BAR(2);} else if((tt)+2<NT){WAIT_BAR(1);} else {WAIT_BAR(0);} }while(0)
  for(;t+1<NT;t+=2){
    STEP(pB0,pB1,pA0,pA1,t,(t+3<NT),(t+1<NT),(t+1<NT));       ENDW(t);   RESC(); ROT();
    STEP(pA0,pA1,pB0,pB1,t+1,(t+4<NT),(t+2<NT),(t+2<NT));     ENDW(t+1); RESC(); ROT();
  }
  STEP(pB0,pB1,pA0,pA1,NT-1,false,false,false); RESC();
  { float sacc=pB0[0]+pB0[1]; _Pragma("unroll") for(int r=2;r<16;++r)sacc+=pB0[r]; _Pragma("unroll") for(int r=0;r<16;++r)sacc+=pB1[r]; l_reg+=sacc;
    pw0=(u32x4){PKW(pB0,0),PKW(pB0,2),PKW(pB0,4),PKW(pB0,6)};pw1=(u32x4){PKW(pB0,8),PKW(pB0,10),PKW(pB0,12),PKW(pB0,14)};pw2=(u32x4){PKW(pB1,0),PKW(pB1,2),PKW(pB1,4),PKW(pB1,6)};pw3=(u32x4){PKW(pB1,8),PKW(pB1,10),PKW(pB1,12),PKW(pB1,14)};
    SBAR(); pv(o,vb0+sl_cur,PAF(0),PAF(1),PAF(2),PAF(3)); }
  #undef PKW
  #undef PAF
  #undef VFR
  #undef PIN
  #undef MX3
  #undef GAPA
  #undef GAPB
  #undef EX
  #undef VRD
  #undef KRD
  #undef STEP
  #undef ENDW
  {auto rr=__builtin_amdgcn_permlane32_swap(__float_as_uint(l_reg),__float_as_uint(l_reg),false,false);l_reg=__uint_as_float(rr[0])+__uint_as_float(rr[1]);}
  if(hi==0)wsf[32+r32]=l_reg;asm volatile("s_waitcnt lgkmcnt(0)":::"memory");
  float rli[16];
  #pragma unroll
  for(int r=0;r<16;++r)rli[r]=__builtin_amdgcn_rcpf(wsf[32+crow(r,hi)]);
  bf16*Ow=O+(rowbase+q0+wid*QBLK)*DM+h*D;
  { bf16*stg=(bf16*)(shm+LDS_OST)+wid*2048;
    #pragma unroll
    for(int r=0;r<16;++r){const int orow=crow(r,hi);
      #pragma unroll
      for(int d0=0;d0<2;++d0)stg[orow*64+d0*32+r32]=__float2bfloat16(o[d0][r]*rli[r]);}
    asm volatile("s_waitcnt lgkmcnt(0)":::"memory");
    #pragma unroll
    for(int i=0;i<4;++i){const int row=i*8+(lane>>3),ch=lane&7; const u32x4 v=*(const u32x4*)(stg+row*64+ch*8); ATTN_STORE16(Ow+(long)row*DM+ch*8,v);} }
  asm volatile("s_waitcnt lgkmcnt(0)\n\ts_barrier":::"memory");
  #undef DMA_K
  #undef DMA_V
  #undef CMASK
  #undef START
  #undef RESC
  #undef ROT
  #undef BIASFILL
}
constexpr int ATTN_LDS_BYTES=LDS_BYTES;
#undef SBAR
#undef WAIT_BAR
}

constexpr size_t MiB = 1u << 20;
constexpr size_t WS_CTL = 0, CTL_BYTES = 1 * MiB;
constexpr int CW_QCTR = 0;
constexpr int CW_CNT = 1024;
constexpr int CW_KMEAN = 4096;
constexpr size_t WS_W = 1 * MiB;
constexpr size_t W_IN = 0, W_G = W_IN + (size_t)NQKV * 1024, W_PA = W_G + (size_t)NG * 1024, W_PB = W_PA + 1024 * 384, W_PC = W_PB + 1024 * 256,
                 W_O = W_PC + 1024 * 384, W_GU = W_O + 1024 * 1024, W_D = W_GU + (size_t)2 * DFF * 1024, W_LAYER = W_D + (size_t)1024 * DFF;
static_assert(WS_W + 2 * W_LAYER * 2 <= 69 * MiB, "weights");
constexpr size_t WS_ROPE = 69 * MiB;
constexpr size_t WS_LF = 70 * MiB;
constexpr size_t WS_CUM = 71 * MiB;
constexpr size_t WS_LSEB = 72 * MiB;
constexpr size_t WS_XB = 76 * MiB;
constexpr size_t WS_QA = 140 * MiB, WS_KA = 164 * MiB, WS_VA = 188 * MiB, WS_QB = 212 * MiB, WS_KB = 260 * MiB, WS_VB = 276 * MiB,
                 WS_QC = 292 * MiB, WS_KC = 316 * MiB, WS_VC = 340 * MiB;
constexpr size_t WS_H = 140 * MiB;
constexpr size_t WS_PO = 364 * MiB;
constexpr size_t WS_PLSE = 460 * MiB;
constexpr size_t WS_LIST = 463 * MiB;
constexpr size_t WS_GS = 364 * MiB;
constexpr size_t WS_MG = 428 * MiB;
constexpr size_t WS_END = 492 * MiB;
constexpr int LIST_PER_BH = 256 * 2016;
__device__ __forceinline__ int list_off(int bh, int n) { return bh * LIST_PER_BH + 256 * (63 * n - (n * (n - 1)) / 2); }

constexpr int LDS_QW = 150 * 1024;
constexpr int LDS_BYTES = 152 * 1024;
static_assert(attn_body::ATTN_LDS_BYTES <= LDS_QW && pg8::STAGE_BYTES <= LDS_QW, "lds");

__constant__ double ROPE_FR[8] = {0.15915494309189535, 0.03086376340470123, 0.005985185712713705, 0.0011606636412400608,
                                  0.00022507907903927653, 4.364795279280289e-05, 8.464330808241401e-06, 1.6414262627950345e-06};

struct Args { const float* in[16]; float* out; unsigned char* ws; };
typedef const __attribute__((address_space(4))) Args* CArgs;

__device__ __forceinline__ float wave_sum(float v) {
#pragma unroll
    for (int o = 1; o < 64; o <<= 1) v += __shfl_xor(v, o);
    return v;
}
__device__ __forceinline__ unsigned f2bf(float f) { unsigned u = __builtin_bit_cast(unsigned, f); return (u + 0x7fffu + ((u >> 16) & 1u)) >> 16; }
__device__ __forceinline__ unsigned pk2(float lo, float hi) { return f2bf(lo) | (f2bf(hi) << 16); }

__device__ __forceinline__ void transpose_item(const float* Wsrc, int ldw, bf16_t* dst, int ldk, LAS float* scr, int lane) {
#pragma unroll 8
    for (int i = 0; i < 32; ++i) { const int kk = 2 * i + (lane >> 5); scr[kk * 33 + (lane & 31)] = Wsrc[(size_t)kk * ldw + (lane & 31)]; }
    asm volatile("s_waitcnt lgkmcnt(0)" ::: "memory");
    const int c = lane & 7;
#pragma unroll
    for (int j = 0; j < 4; ++j) { const int n = (lane >> 3) + 8 * j; const LAS float* s = scr + (8 * c) * 33 + n;
        u32x4 o; o.x = pk2(s[0 * 33], s[1 * 33]); o.y = pk2(s[2 * 33], s[3 * 33]); o.z = pk2(s[4 * 33], s[5 * 33]); o.w = pk2(s[6 * 33], s[7 * 33]);
        *(u32x4*)(dst + (size_t)(n) * ldk + 8 * c) = o; }
    asm volatile("s_waitcnt lgkmcnt(0)" ::: "memory");
}
constexpr int IT_IN = 16 * 112, IT_G = 16 * 96, IT_PA = 6 * 32, IT_PB = 4 * 32, IT_PC = 6 * 32, IT_O = 16 * 32, IT_GU = 16 * 176, IT_D = 44 * 32;
constexpr int IT_LAYER = IT_IN + IT_G + IT_PA + IT_PB + IT_PC + IT_O + IT_GU + IT_D;
__device__ __forceinline__ void prologue_item(CArgs a, int it, LAS float* scr, int lane) {
    const int l = it / IT_LAYER; int r = it % IT_LAYER;
    bf16_t* WL = (bf16_t*)(a->ws + WS_W) + (size_t)l * W_LAYER;
    if (r < IT_IN) { const int kb = r / 112, nb = r % 112, k0 = 64 * kb, n0 = 32 * nb, c0 = n0 < 1152 ? n0 : n0 + 6;
        transpose_item(a->in[3] + (size_t)l * 1024 * DIN + (size_t)k0 * DIN + c0, DIN, WL + W_IN + (size_t)n0 * 1024 + k0, 1024, scr, lane); return; } r -= IT_IN;
    if (r < IT_G) { const int kb = r / 96, nb = r % 96, k0 = 64 * kb, n0 = 32 * nb, c0 = 3590 + n0;
        transpose_item(a->in[3] + (size_t)l * 1024 * DIN + (size_t)k0 * DIN + c0, DIN, WL + W_G + (size_t)n0 * 1024 + k0, 1024, scr, lane); return; } r -= IT_G;
    if (r < IT_PA) { const int kb = r / 32, nb = r % 32, k0 = 64 * kb, n0 = 32 * nb;
        transpose_item(a->in[5] + (size_t)l * 384 * 1024 + (size_t)k0 * 1024 + n0, 1024, WL + W_PA + (size_t)n0 * 384 + k0, 384, scr, lane); return; } r -= IT_PA;
    if (r < IT_PB) { const int kb = r / 32, nb = r % 32, k0 = 64 * kb, n0 = 32 * nb;
        transpose_item(a->in[6] + (size_t)l * 256 * 1024 + (size_t)k0 * 1024 + n0, 1024, WL + W_PB + (size_t)n0 * 256 + k0, 256, scr, lane); return; } r -= IT_PB;
    if (r < IT_PC) { const int kb = r / 32, nb = r % 32, k0 = 64 * kb, n0 = 32 * nb;
        transpose_item(a->in[7] + (size_t)l * 384 * 1024 + (size_t)k0 * 1024 + n0, 1024, WL + W_PC + (size_t)n0 * 384 + k0, 384, scr, lane); return; } r -= IT_PC;
    if (r < IT_O) { const int kb = r / 32, nb = r % 32, k0 = 64 * kb, n0 = 32 * nb;
        transpose_item(a->in[8] + (size_t)l * 1024 * 1024 + (size_t)k0 * 1024 + n0, 1024, WL + W_O + (size_t)n0 * 1024 + k0, 1024, scr, lane); return; } r -= IT_O;
    if (r < IT_GU) { const int kb = r / 176, nb = r % 176, k0 = 64 * kb, n0 = 32 * nb, pn = n0 >> 8, w = n0 & 255;
        const float* src = (w < 128) ? (a->in[11] + (size_t)l * 1024 * DFF + (size_t)k0 * DFF + 128 * pn + w) : (a->in[12] + (size_t)l * 1024 * DFF + (size_t)k0 * DFF + 128 * pn + (w - 128));
        transpose_item(src, DFF, WL + W_GU + (size_t)n0 * 1024 + k0, 1024, scr, lane); return; } r -= IT_GU;
    { const int kb = r / 32, nb = r % 32, k0 = 64 * kb, n0 = 32 * nb;
        transpose_item(a->in[13] + (size_t)l * DFF * 1024 + (size_t)k0 * 1024 + n0, 1024, WL + W_D + (size_t)n0 * DFF + k0, DFF, scr, lane); }
}

__device__ __forceinline__ void ln_phase(const float* src, const float* gam, const float* bet, float* XF, f32x2* ST, bf16_t* XB,
                                         const float* wfa, const float* bfl, float* LF, LAS unsigned char* lds, int tid, int lane, int wave) {
    asm volatile("" : "+v"(tid), "+v"(lane));
    LAS float* wl = (LAS float*)lds;
    if (wfa) { for (int i = tid; i < 6144; i += NWAVES * 64) { const int h = i % 6, k = i / 6; wl[h * 1024 + k] = wfa[(size_t)k * DIN + 1152 + h]; } }
    __syncthreads();
    f32x4 g4[4], b4[4];
#pragma unroll
    for (int j = 0; j < 4; ++j) { g4[j] = *(const f32x4*)(gam + 4 * lane + 256 * j); b4[j] = *(const f32x4*)(bet + 4 * lane + 256 * j); }
    const int NGW = gridDim.x * NWAVES;
    for (int row0 = blockIdx.x * NWAVES + wave; row0 < T; row0 += 2 * NGW) {
        f32x4 v[2][4]; float s[2]; bool ok[2];
#pragma unroll
        for (int u = 0; u < 2; ++u) { const int row = row0 + u * NGW; ok[u] = row < T; const f32x4* xr = (const f32x4*)(src + (size_t)(ok[u] ? row : row0) * DM) + lane; s[u] = 0.f;
#pragma unroll
            for (int j = 0; j < 4; ++j) v[u][j] = xr[64 * j]; }
#pragma unroll
        for (int u = 0; u < 2; ++u) {
#pragma unroll
            for (int j = 0; j < 4; ++j) s[u] += (v[u][j].x + v[u][j].y) + (v[u][j].z + v[u][j].w); }
        float mean[2], s2[2], rstd[2];
#pragma unroll
        for (int u = 0; u < 2; ++u) s[u] = wave_sum(s[u]);
#pragma unroll
        for (int u = 0; u < 2; ++u) { mean[u] = s[u] * (1.f / DM); s2[u] = 0.f;
#pragma unroll
            for (int j = 0; j < 4; ++j) { v[u][j] = v[u][j] - mean[u]; s2[u] += (v[u][j].x * v[u][j].x + v[u][j].y * v[u][j].y) + (v[u][j].z * v[u][j].z + v[u][j].w * v[u][j].w); } }
#pragma unroll
        for (int u = 0; u < 2; ++u) s2[u] = wave_sum(s2[u]);
#pragma unroll
        for (int u = 0; u < 2; ++u) { rstd[u] = 1.f / sqrtf(s2[u] * (1.f / DM) + LN_EPS);
            const int row = row0 + u * NGW;
            if (ok[u]) {
                f32x4* of = (f32x4*)(XF + (size_t)row * DM) + lane; u32x2* ob = (u32x2*)(XB + (size_t)row * DM) + lane;
                if (ST && lane == 0) ST[row] = (f32x2){mean[u], rstd[u]};
#pragma unroll
                for (int j = 0; j < 4; ++j) { v[u][j] = v[u][j] * rstd[u] * g4[j] + b4[j]; if (!ST) of[64 * j] = v[u][j]; u32x2 w; w.x = cvt_pk_bf16(v[u][j].x, v[u][j].y); w.y = cvt_pk_bf16(v[u][j].z, v[u][j].w); ob[64 * j] = w; }
            } }
        if (wfa) {
#pragma unroll
            for (int u = 0; u < 2; ++u) {
                const int row = row0 + u * NGW;
                float d[6];
#pragma unroll
                for (int h = 0; h < 6; ++h) { float acc = 0.f;
#pragma unroll
                    for (int j = 0; j < 4; ++j) { const f32x4 w = *(const LAS f32x4*)(wl + h * 1024 + 4 * lane + 256 * j); acc += (v[u][j].x * w.x + v[u][j].y * w.y) + (v[u][j].z * w.z + v[u][j].w * w.w); }
                    d[h] = wave_sum(acc); }
                if (lane < 6 && ok[u]) { float z = d[0];
#pragma unroll
                    for (int h = 1; h < 6; ++h) z = (lane == h) ? d[h] : z;
                    z += bfl[lane];
                    const float ls = fminf(z, 0.f) - log1pf(expf(-fabsf(z)));
                    const int b = row / SEQ, sidx = row % SEQ; LF[(size_t)(b * 6 + lane) * SEQ + sidx] = ls; }
            }
        }
    }
    __syncthreads();
}

__device__ __forceinline__ void scan_bh(const float* lf, float* cum, LAS unsigned char* lds, int tid, int lane, int wave) {
    asm volatile("" : "+v"(tid), "+v"(lane));
    LAS float* ws = (LAS float*)lds;
    f32x4 v[8]; const f32x4* p = (const f32x4*)(lf + tid * 32);
#pragma unroll
    for (int j = 0; j < 8; ++j) v[j] = p[j];
    float run = 0.f;
#pragma unroll
    for (int j = 0; j < 8; ++j) { run += v[j].x; v[j].x = run; run += v[j].y; v[j].y = run; run += v[j].z; v[j].z = run; run += v[j].w; v[j].w = run; }
    float inc = run;
#pragma unroll
    for (int o = 1; o < 64; o <<= 1) { const float t = __shfl_up(inc, o); if (lane >= o) inc += t; }
    if (lane == 63) ws[wave] = inc;
    __syncthreads();
    float base = inc - run;
    for (int w = 0; w < wave; ++w) base += ws[w];
    f32x4* q = (f32x4*)(cum + tid * 32);
#pragma unroll
    for (int j = 0; j < 8; ++j) q[j] = v[j] + base;
    __syncthreads();
}

__device__ __forceinline__ float sigmoidf_(float x) { return __builtin_amdgcn_rcpf(1.f + __builtin_amdgcn_exp2f(-x * LOG2E)); }

struct EpiInproj {
    static constexpr bool PERM = true;
    unsigned char* ws; const f32x2* rope; int* kmean;
    __device__ __forceinline__ void operator()(const f32x4 (&acc)[2][2][4][2], const pg8::Unit& u, int wr, int wc, int fr, int fq) const {
        const int row0 = u.pm * 256 + wr * 64 + fr;
#pragma unroll
        for (int bj = 0; bj < 2; ++bj) {
            const int cb = 2 * u.pn + bj;
            size_t base; int pitch, c0; bool rope_on = false, km = false; float sc = 1.f;
            if (cb < 3) { base = WS_QA; pitch = 384; c0 = cb * 128; sc = C2; }
            else if (cb < 6) { base = WS_KA; pitch = 384; c0 = (cb - 3) * 128; }
            else if (cb < 9) { base = WS_VA; pitch = 384; c0 = (cb - 6) * 128; }
            else if (cb < 15) { base = WS_QB; pitch = 768; c0 = (cb - 9) * 128; rope_on = true; sc = C2; }
            else if (cb < 17) { base = WS_KB; pitch = 256; c0 = (cb - 15) * 128; rope_on = true; }
            else if (cb < 19) { base = WS_VB; pitch = 256; c0 = (cb - 17) * 128; }
            else if (cb < 22) { base = WS_QC; pitch = 384; c0 = (cb - 19) * 128; rope_on = true; sc = C2; }
            else if (cb < 25) { base = WS_KC; pitch = 384; c0 = (cb - 22) * 128; rope_on = true; km = true; }
            else { base = WS_VC; pitch = 384; c0 = (cb - 25) * 128; }
            bf16_t* dst = (bf16_t*)(ws + base);
            const int colw = c0 + wc * 32 + 8 * fq;
            const bool rl = rope_on && ((wc & 1) == 0) && (fq < 2);
            float ks[8];
#pragma unroll
            for (int i = 0; i < 8; ++i) ks[i] = 0.f;
#pragma unroll
            for (int ai = 0; ai < 2; ++ai)
#pragma unroll
                for (int m = 0; m < 4; ++m) {
                    const int row = row0 + ai * 128 + m * 16;
                    f32x4 v0 = acc[ai][bj][m][0], v1 = acc[ai][bj][m][1];
                    if (rope_on) {
                        float own[8] = {v0.x, v0.y, v0.z, v0.w, v1.x, v1.y, v1.z, v1.w}, oth[8];
#pragma unroll
                        for (int i = 0; i < 8; ++i) oth[i] = __shfl_xor(own[i], 16);
                        if (rl) {
                            const f32x2* rp = rope + (size_t)(row % SEQ) * 8;
                            const float sg = (fq == 0) ? -1.f : 1.f;
#pragma unroll
                            for (int i = 0; i < 8; ++i) { const f32x2 cs = rp[i]; own[i] = own[i] * cs.x + sg * oth[i] * cs.y; }
                            v0 = (f32x4){own[0], own[1], own[2], own[3]}; v1 = (f32x4){own[4], own[5], own[6], own[7]};
                        }
                    }
                    if (km) { ks[0] += v0.x; ks[1] += v0.y; ks[2] += v0.z; ks[3] += v0.w; ks[4] += v1.x; ks[5] += v1.y; ks[6] += v1.z; ks[7] += v1.w; }
                    v0 = v0 * sc; v1 = v1 * sc;
                    u32x4 w; w.x = cvt_pk_bf16(v0.x, v0.y); w.y = cvt_pk_bf16(v0.z, v0.w); w.z = cvt_pk_bf16(v1.x, v1.y); w.w = cvt_pk_bf16(v1.z, v1.w);
                    *(u32x4*)(dst + (size_t)row * pitch + colw) = w;
                }
            if (km) {
#pragma unroll
                for (int i = 0; i < 8; ++i) { float s = ks[i]; s += __shfl_xor(s, 1); s += __shfl_xor(s, 2); s += __shfl_xor(s, 4); s += __shfl_xor(s, 8); ks[i] = s; }
                if (fr == 0) { const int b = u.pm >> 6, blk = u.pm & 63;
#pragma unroll
                    for (int i = 0; i < 8; ++i) { const int col = colw + i; atomicAdd(kmean + ((size_t)((b * 6 + (col >> 6)) * 64 + blk)) * 64 + (col & 63), __float2int_rn(ks[i] * 262144.f)); } }
            }
        }
    }
};

struct EpiSwiglu {
    static constexpr bool PERM = true;
    bf16_t* H;
    __device__ __forceinline__ void operator()(const f32x4 (&acc)[2][2][4][2], const pg8::Unit& u, int wr, int wc, int fr, int fq) const {
        const int row0 = u.pm * 256 + wr * 64 + fr, col0 = u.pn * 128 + wc * 32 + 8 * fq;
#pragma unroll
        for (int ai = 0; ai < 2; ++ai)
#pragma unroll
            for (int m = 0; m < 4; ++m) {
                float h[8];
#pragma unroll
                for (int n = 0; n < 2; ++n)
#pragma unroll
                    for (int i = 0; i < 4; ++i) { const float g = acc[ai][0][m][n][i], up = acc[ai][1][m][n][i]; h[4 * n + i] = g * sigmoidf_(g) * up; }
                u32x4 w; w.x = cvt_pk_bf16(h[0], h[1]); w.y = cvt_pk_bf16(h[2], h[3]); w.z = cvt_pk_bf16(h[4], h[5]); w.w = cvt_pk_bf16(h[6], h[7]);
                *(u32x4*)(H + (size_t)(row0 + ai * 128 + m * 16) * DFF + col0) = w;
                asm volatile("" ::: "memory");
            }
    }
};

struct EpiResid {
    static constexpr bool PERM = true;
    const float* src; float* X; const f32x2* ST; const float* gam; const float* bet;
    __device__ __forceinline__ void operator()(const f32x4 (&acc)[2][2][4][2], const pg8::Unit& u, int wr, int wc, int fr, int fq) const {
        const int row0 = u.pm * 256 + wr * 64 + fr, col0 = u.pn * 256 + wc * 32 + 8 * fq;
        f32x4 g[2][2], b[2][2];
#pragma unroll
        for (int bj = 0; bj < 2; ++bj)
#pragma unroll
            for (int n = 0; n < 2; ++n) { g[bj][n] = *(const f32x4*)(gam + col0 + bj * 128 + 4 * n); b[bj][n] = *(const f32x4*)(bet + col0 + bj * 128 + 4 * n); }
#pragma unroll
        for (int ai = 0; ai < 2; ++ai)
#pragma unroll
            for (int m = 0; m < 4; ++m) {
                const int row = row0 + ai * 128 + m * 16;
                const f32x2 st = ST[row];
#pragma unroll
                for (int bj = 0; bj < 2; ++bj) {
                    const size_t off = (size_t)row * DM + col0 + bj * 128;
                    const f32x4 s0 = *(const f32x4*)(src + off), s1 = *(const f32x4*)(src + off + 4);
                    const f32x4 x0 = (s0 - st.x) * st.y * g[bj][0] + b[bj][0], x1 = (s1 - st.x) * st.y * g[bj][1] + b[bj][1];
                    *(f32x4*)(X + off) = x0 * DN_ALPHA + acc[ai][bj][m][0]; *(f32x4*)(X + off + 4) = x1 * DN_ALPHA + acc[ai][bj][m][1];
                    asm volatile("" ::: "memory");
                }
            }
    }
};

struct EpiGate {
    static constexpr bool PERM = true;
    bf16_t* GS;
    __device__ __forceinline__ void operator()(const f32x4 (&acc)[2][2][4][2], const pg8::Unit& u, int wr, int wc, int fr, int fq) const {
        const int row0 = u.pm * 256 + wr * 64 + fr, col0 = u.pn * 256 + wc * 32 + 8 * fq;
#pragma unroll
        for (int ai = 0; ai < 2; ++ai)
#pragma unroll
            for (int m = 0; m < 4; ++m)
#pragma unroll
                for (int bj = 0; bj < 2; ++bj) {
                    const f32x4 a = acc[ai][bj][m][0], b = acc[ai][bj][m][1];
                    u32x4 w; w.x = cvt_pk_bf16(sigmoidf_(a.x), sigmoidf_(a.y)); w.y = cvt_pk_bf16(sigmoidf_(a.z), sigmoidf_(a.w));
                    w.z = cvt_pk_bf16(sigmoidf_(b.x), sigmoidf_(b.y)); w.w = cvt_pk_bf16(sigmoidf_(b.z), sigmoidf_(b.w));
                    *(u32x4*)(GS + (size_t)(row0 + ai * 128 + m * 16) * DM + col0 + bj * 128) = w;
                }
    }
};

template <int FIRST> struct EpiBranch {
    static constexpr bool PERM = true;
    const bf16_t* GS; bf16_t* MG;
    __device__ __forceinline__ void operator()(const f32x4 (&acc)[2][2][4][2], const pg8::Unit& u, int wr, int wc, int fr, int fq) const {
        const int row0 = u.pm * 256 + wr * 64 + fr, col0 = u.pn * 256 + wc * 32 + 8 * fq;
#pragma unroll
        for (int ai = 0; ai < 2; ++ai)
#pragma unroll
            for (int m = 0; m < 4; ++m)
#pragma unroll
                for (int bj = 0; bj < 2; ++bj) {
                    const size_t off = (size_t)(row0 + ai * 128 + m * 16) * DM + col0 + bj * 128;
                    const u32x4 gw = *(const u32x4*)(GS + off);
                    const f32x4 a = acc[ai][bj][m][0], b = acc[ai][bj][m][1];
                    float r[8] = {bflo(gw.x) * a.x, bfhi(gw.x) * a.y, bflo(gw.y) * a.z, bfhi(gw.y) * a.w, bflo(gw.z) * b.x, bfhi(gw.z) * b.y, bflo(gw.w) * b.z, bfhi(gw.w) * b.w};
                    if (!FIRST) { const u32x4 mw = *(const u32x4*)(MG + off);
                        r[0] += bflo(mw.x); r[1] += bfhi(mw.x); r[2] += bflo(mw.y); r[3] += bfhi(mw.y); r[4] += bflo(mw.z); r[5] += bfhi(mw.z); r[6] += bflo(mw.w); r[7] += bfhi(mw.w); }
                    u32x4 w; w.x = cvt_pk_bf16(r[0], r[1]); w.y = cvt_pk_bf16(r[2], r[3]); w.z = cvt_pk_bf16(r[4], r[5]); w.w = cvt_pk_bf16(r[6], r[7]);
                    *(u32x4*)(MG + off) = w;
                    asm volatile("" ::: "memory");
                }
    }
};

typedef short v4i16_t __attribute__((ext_vector_type(4)));
__device__ __forceinline__ int crow(int r, int hi) { return (r & 3) + 8 * (r >> 2) + 4 * hi; }
__device__ __forceinline__ float half_max(float m) { auto rr = __builtin_amdgcn_permlane32_swap(__float_as_uint(m), __float_as_uint(m), false, false); return fmaxf(__uint_as_float(rr[0]), __uint_as_float(rr[1])); }
__device__ __forceinline__ float half_sum(float m) { auto rr = __builtin_amdgcn_permlane32_swap(__float_as_uint(m), __float_as_uint(m), false, false); return __uint_as_float(rr[0]) + __uint_as_float(rr[1]); }

__device__ __forceinline__ void small_attn(const bf16_t* qrow, int ntiles, const bf16_t* Kb, const bf16_t* Vb, int pitch,
                                           int kc0, int kstride, int koff, int qc, int span, LAS unsigned char* vscr, int lane,
                                           f32x16 (&o)[2], float& lse2, const float* cumb = nullptr) {
    asm volatile("" : "+v"(lane));
    const int r32 = lane & 31, hi = lane >> 5;
    bf16x8 qr[4];
#pragma unroll
    for (int d0 = 0; d0 < 4; ++d0) qr[d0] = *(const bf16x8*)(qrow + d0 * 16 + hi * 8);
    o[0] = f32x16{}; o[1] = f32x16{};
    float m = -1e30f, l = 0.f;
    const int lr = lane >> 3, lc = lane & 7;
    LAS unsigned char* kscr = vscr + 4608;
    LAS unsigned char* kw = kscr + lr * 144 + lc * 16;
    LAS unsigned char* vw = vscr + lr * 144 + lc * 16;
    const LAS unsigned char* kfr = kscr + r32 * 144 + 16 * hi;
    const LAS unsigned char* vt = vscr + (4 * hi + ((lane & 15) >> 2)) * 144 + (16 * ((lane >> 4) & 1) + 4 * (lane & 3)) * 2;
#define SA_LOAD(KF, VV, tt) do { const int t_ = (tt) < ntiles ? (tt) : ntiles - 1; \
        _Pragma("unroll") for (int i_ = 0; i_ < 4; ++i_) { const int kk_ = kc0 + 32 * t_ + lr + 8 * i_; const size_t off_ = (size_t)((kk_ < 0 ? 0 : kk_) * kstride + koff) * pitch + 8 * lc; \
            KF[i_] = *(const bf16x8*)(Kb + off_); VV[i_] = *(const bf16x8*)(Vb + off_); } \
        __builtin_amdgcn_sched_barrier(0); } while (0)
#define SA_COMPUTE(KF, VV, tt) do { \
        _Pragma("unroll") for (int i_ = 0; i_ < 4; ++i_) { *(LAS bf16x8*)(kw + 8 * 144 * i_) = KF[i_]; *(LAS bf16x8*)(vw + 8 * 144 * i_) = VV[i_]; } \
        f32x16 p = f32x16{}; \
        _Pragma("unroll") for (int d0 = 0; d0 < 4; ++d0) { const bf16x8 kf_ = *(const LAS bf16x8*)(kfr + 32 * d0); p = __builtin_amdgcn_mfma_f32_32x32x16_bf16(kf_, qr[d0], p, 0, 0, 0); } \
        const int kcb = kc0 + 32 * (tt); \
        if (cumb) { _Pragma("unroll") for (int r = 0; r < 16; ++r) { const int kc = kcb + crow(r, hi); p[r] -= cumb[kc < 0 ? 0 : kc] * LOG2E; } } \
        if (!__all((kcb >= 0) && (kcb + 31 <= qc) && (qc - kcb <= span))) {     \
            _Pragma("unroll") for (int r = 0; r < 16; ++r) { const int kc = kcb + crow(r, hi); const bool ok = (kc >= 0) && (kc <= qc) && (qc - kc <= span); p[r] = ok ? p[r] : -INFINITY; } } \
        float rm = fmaxf(fmaxf(fmaxf(p[0], p[1]), fmaxf(p[2], p[3])), fmaxf(fmaxf(p[4], p[5]), fmaxf(p[6], p[7]))); \
        rm = fmaxf(rm, fmaxf(fmaxf(fmaxf(p[8], p[9]), fmaxf(p[10], p[11])), fmaxf(fmaxf(p[12], p[13]), fmaxf(p[14], p[15])))); \
        rm = half_max(rm); \
        const float mn = fmaxf(m, rm); const float f = __builtin_amdgcn_exp2f(m - mn); m = mn; \
        float ls = 0.f; \
        _Pragma("unroll") for (int r = 0; r < 16; ++r) { p[r] = __builtin_amdgcn_exp2f(p[r] - mn); ls += p[r]; } \
        l = l * f + ls; \
        if (!__all(f == 1.f)) { _Pragma("unroll") for (int r = 0; r < 16; ++r) { o[0][r] *= f; o[1][r] *= f; } } \
        u32x4 pw0, pw1; \
        pw0.x = cvt_pk_bf16(p[0], p[1]); pw0.y = cvt_pk_bf16(p[2], p[3]); pw0.z = cvt_pk_bf16(p[4], p[5]); pw0.w = cvt_pk_bf16(p[6], p[7]); \
        pw1.x = cvt_pk_bf16(p[8], p[9]); pw1.y = cvt_pk_bf16(p[10], p[11]); pw1.z = cvt_pk_bf16(p[12], p[13]); pw1.w = cvt_pk_bf16(p[14], p[15]); \
        const bf16x8 pb0 = __builtin_bit_cast(bf16x8, pw0), pb1 = __builtin_bit_cast(bf16x8, pw1); \
        _Pragma("unroll") for (int d0 = 0; d0 < 2; ++d0) { \
            _Pragma("unroll") for (int s_ = 0; s_ < 2; ++s_) { \
                const v4i16_t lo = __builtin_amdgcn_ds_read_tr16_b64_v4i16((LAS v4i16_t*)(vt + (16 * s_) * 144 + d0 * 64)); \
                const v4i16_t hh = __builtin_amdgcn_ds_read_tr16_b64_v4i16((LAS v4i16_t*)(vt + (16 * s_ + 8) * 144 + d0 * 64)); \
                const bf16x8 vf = (bf16x8){lo[0], lo[1], lo[2], lo[3], hh[0], hh[1], hh[2], hh[3]}; \
                o[d0] = __builtin_amdgcn_mfma_f32_32x32x16_bf16(vf, s_ == 0 ? pb0 : pb1, o[d0], 0, 0, 0); } } \
    } while (0)
    bf16x8 kA[4], vA[4], kB[4], vB[4], kC[4], vC[4];
    SA_LOAD(kA, vA, 0); SA_LOAD(kB, vB, 1);
    for (int t = 0; t < ntiles; t += 3) {
        SA_LOAD(kC, vC, t + 2); SA_COMPUTE(kA, vA, t);
        if (t + 1 >= ntiles) break;
        SA_LOAD(kA, vA, t + 3); SA_COMPUTE(kB, vB, t + 1);
        if (t + 2 >= ntiles) break;
        SA_LOAD(kB, vB, t + 4); SA_COMPUTE(kC, vC, t + 2);
    }
#undef SA_LOAD
#undef SA_COMPUTE
    l = half_sum(l);
    const float rl = 1.f / l;
#pragma unroll
    for (int r = 0; r < 16; ++r) { o[0][r] *= rl; o[1][r] *= rl; }
    lse2 = m + __builtin_amdgcn_logf(l);
}
__device__ __forceinline__ void small_attn2(const bf16_t* qrowA, const bf16_t* qrowB, int ntiles, const bf16_t* Kb, const bf16_t* Vb, int pitch,
                                            int kc0, int kstride, int koff, int qcA, int qcB, int span, LAS unsigned char* vscr, int lane,
                                            f32x16 (&oA)[2], f32x16 (&oB)[2], float& lseA, float& lseB) {
    asm volatile("" : "+v"(lane));
    const int r32 = lane & 31, hi = lane >> 5;
    bf16x8 qa[4], qb[4];
#pragma unroll
    for (int d0 = 0; d0 < 4; ++d0) { qa[d0] = *(const bf16x8*)(qrowA + d0 * 16 + hi * 8); qb[d0] = *(const bf16x8*)(qrowB + d0 * 16 + hi * 8); }
    oA[0] = f32x16{}; oA[1] = f32x16{}; oB[0] = f32x16{}; oB[1] = f32x16{};
    float mA = -1e30f, lA = 0.f, mB = -1e30f, lB = 0.f;
    const int lr = lane >> 3, lc = lane & 7;
    LAS unsigned char* kscr = vscr + 4608;
    LAS unsigned char* kw = kscr + lr * 144 + lc * 16;
    LAS unsigned char* vw = vscr + lr * 144 + lc * 16;
    const LAS unsigned char* kfr = kscr + r32 * 144 + 16 * hi;
    const LAS unsigned char* vt = vscr + (4 * hi + ((lane & 15) >> 2)) * 144 + (16 * ((lane >> 4) & 1) + 4 * (lane & 3)) * 2;
    bf16x8 KF[4], VV[4];
#define SA2_LOAD(tt) do { const int t_ = (tt) < ntiles ? (tt) : ntiles - 1; \
        _Pragma("unroll") for (int i_ = 0; i_ < 4; ++i_) { const int kk_ = kc0 + 32 * t_ + lr + 8 * i_; const size_t off_ = (size_t)((kk_ < 0 ? 0 : kk_) * kstride + koff) * pitch + 8 * lc; \
            KF[i_] = *(const bf16x8*)(Kb + off_); VV[i_] = *(const bf16x8*)(Vb + off_); } } while (0)
#define SA2_SOFTMAX(P, QC, M, L, O, PW0, PW1) do { \
        if (!__all((kcb >= 0) && (kcb + 31 <= (QC)) && ((QC) - kcb <= span))) { \
            _Pragma("unroll") for (int r = 0; r < 16; ++r) { const int kc = kcb + crow(r, hi); const bool ok = (kc >= 0) && (kc <= (QC)) && ((QC) - kc <= span); P[r] = ok ? P[r] : -INFINITY; } } \
        float rm = fmaxf(fmaxf(fmaxf(P[0], P[1]), fmaxf(P[2], P[3])), fmaxf(fmaxf(P[4], P[5]), fmaxf(P[6], P[7]))); \
        rm = fmaxf(rm, fmaxf(fmaxf(fmaxf(P[8], P[9]), fmaxf(P[10], P[11])), fmaxf(fmaxf(P[12], P[13]), fmaxf(P[14], P[15])))); \
        rm = half_max(rm); \
        const float mn = fmaxf(M, rm); const float f = __builtin_amdgcn_exp2f(M - mn); M = mn; \
        float ls = 0.f; \
        _Pragma("unroll") for (int r = 0; r < 16; ++r) { P[r] = __builtin_amdgcn_exp2f(P[r] - mn); ls += P[r]; } \
        L = L * f + ls; \
        if (!__all(f == 1.f)) { _Pragma("unroll") for (int r = 0; r < 16; ++r) { O[0][r] *= f; O[1][r] *= f; } } \
        PW0.x = cvt_pk_bf16(P[0], P[1]); PW0.y = cvt_pk_bf16(P[2], P[3]); PW0.z = cvt_pk_bf16(P[4], P[5]); PW0.w = cvt_pk_bf16(P[6], P[7]); \
        PW1.x = cvt_pk_bf16(P[8], P[9]); PW1.y = cvt_pk_bf16(P[10], P[11]); PW1.z = cvt_pk_bf16(P[12], P[13]); PW1.w = cvt_pk_bf16(P[14], P[15]); } while (0)
    SA2_LOAD(0);
    for (int t = 0; t < ntiles; ++t) {
#pragma unroll
        for (int i_ = 0; i_ < 4; ++i_) { *(LAS bf16x8*)(kw + 8 * 144 * i_) = KF[i_]; *(LAS bf16x8*)(vw + 8 * 144 * i_) = VV[i_]; }
        SA2_LOAD(t + 1);
        __builtin_amdgcn_sched_barrier(0);
        f32x16 pA = f32x16{}, pB = f32x16{};
#pragma unroll
        for (int d0 = 0; d0 < 4; ++d0) { const bf16x8 kf_ = *(const LAS bf16x8*)(kfr + 32 * d0);
            pA = __builtin_amdgcn_mfma_f32_32x32x16_bf16(kf_, qa[d0], pA, 0, 0, 0); pB = __builtin_amdgcn_mfma_f32_32x32x16_bf16(kf_, qb[d0], pB, 0, 0, 0); }
        const int kcb = kc0 + 32 * t;
        u32x4 wA0, wA1, wB0, wB1;
        SA2_SOFTMAX(pA, qcA, mA, lA, oA, wA0, wA1);
        SA2_SOFTMAX(pB, qcB, mB, lB, oB, wB0, wB1);
        const bf16x8 a0 = __builtin_bit_cast(bf16x8, wA0), a1 = __builtin_bit_cast(bf16x8, wA1), b0 = __builtin_bit_cast(bf16x8, wB0), b1 = __builtin_bit_cast(bf16x8, wB1);
#pragma unroll
        for (int d0 = 0; d0 < 2; ++d0) {
#pragma unroll
            for (int s_ = 0; s_ < 2; ++s_) {
                const v4i16_t lo = __builtin_amdgcn_ds_read_tr16_b64_v4i16((LAS v4i16_t*)(vt + (16 * s_) * 144 + d0 * 64));
                const v4i16_t hh = __builtin_amdgcn_ds_read_tr16_b64_v4i16((LAS v4i16_t*)(vt + (16 * s_ + 8) * 144 + d0 * 64));
                const bf16x8 vf = (bf16x8){lo[0], lo[1], lo[2], lo[3], hh[0], hh[1], hh[2], hh[3]};
                oA[d0] = __builtin_amdgcn_mfma_f32_32x32x16_bf16(vf, s_ == 0 ? a0 : a1, oA[d0], 0, 0, 0);
                oB[d0] = __builtin_amdgcn_mfma_f32_32x32x16_bf16(vf, s_ == 0 ? b0 : b1, oB[d0], 0, 0, 0);
            }
        }
    }
#undef SA2_LOAD
#undef SA2_SOFTMAX
    lA = half_sum(lA); lB = half_sum(lB);
    const float rA = 1.f / lA, rB = 1.f / lB;
#pragma unroll
    for (int r = 0; r < 16; ++r) { oA[0][r] *= rA; oA[1][r] *= rA; oB[0][r] *= rB; oB[1][r] *= rB; }
    lseA = mA + __builtin_amdgcn_logf(lA); lseB = mB + __builtin_amdgcn_logf(lB);
}
__device__ __forceinline__ void small_store(bf16_t* orow, const f32x16 (&o)[2], int hi) {
#pragma unroll
    for (int d0 = 0; d0 < 2; ++d0)
#pragma unroll
        for (int g = 0; g < 4; ++g) { u32x2 w; w.x = cvt_pk_bf16(o[d0][4 * g], o[d0][4 * g + 1]); w.y = cvt_pk_bf16(o[d0][4 * g + 2], o[d0][4 * g + 3]);
            *(u32x2*)(orow + 32 * d0 + 8 * g + 4 * hi) = w; }
}

__device__ __forceinline__ void gating_phase(CArgs a, int layer, LAS unsigned char* lds, int tid) {
    asm volatile("" : "+v"(tid));
    unsigned* ctl = (unsigned*)(a->ws + WS_CTL);
    const int* kmean = (const int*)(ctl + CW_KMEAN + 49152 * layer);
    unsigned* cnt = ctl + CW_CNT + 1024 * layer;
    unsigned* list = (unsigned*)(a->ws + WS_LIST);
    const bf16_t* QC = (const bf16_t*)(a->ws + WS_QC);
    const int half = tid >> 8, ht = tid & 255;
    LAS float* km = (LAS float*)(lds + half * 16384);
    const bool g256 = gridDim.x == 256;
    for (int u0 = 0; u0 < 768; u0 += 2 * (int)gridDim.x) {
        int u = u0 + 2 * (int)blockIdx.x + half; const bool active = u < 768;
        if (g256 && u0 > 0 && active) { const int w = u - 512; u = 512 + (w & ~63) + (63 - (w & 63)); }
        const int bh = active ? (u >> 6) : 0, ob = active ? (u & 63) : 0;
        for (int i = ht; i < ob * 64; i += 256) km[i] = (float)kmean[bh * 4096 + i] * (1.f / 262144.f);
        __syncthreads();
        if (active && ob > 0) {
            const int b = bh / 6, h = bh % 6, t = ob * 256 + ht;
            const u32x4* qp = (const u32x4*)(QC + ((size_t)(b * SEQ + t)) * 384 + h * 64);
            float q[64];
#pragma unroll
            for (int i = 0; i < 8; ++i) { const u32x4 w = qp[i]; q[8 * i] = bflo(w.x); q[8 * i + 1] = bfhi(w.x); q[8 * i + 2] = bflo(w.y); q[8 * i + 3] = bfhi(w.y);
                q[8 * i + 4] = bflo(w.z); q[8 * i + 5] = bfhi(w.z); q[8 * i + 6] = bflo(w.w); q[8 * i + 7] = bfhi(w.w); }
            float v0 = -INFINITY, v1 = -INFINITY, v2 = -INFINITY; int i0 = 0, i1 = 0, i2 = 0;
            for (int n = 0; n < ob; ++n) {
                float d0 = 0.f, d1 = 0.f;
#pragma unroll
                for (int j = 0; j < 16; j += 2) { const f32x4 ka = *(const LAS f32x4*)(km + n * 64 + 4 * j), kb = *(const LAS f32x4*)(km + n * 64 + 4 * j + 4);
                    d0 += (q[4 * j] * ka.x + q[4 * j + 1] * ka.y) + (q[4 * j + 2] * ka.z + q[4 * j + 3] * ka.w);
                    d1 += (q[4 * j + 4] * kb.x + q[4 * j + 5] * kb.y) + (q[4 * j + 6] * kb.z + q[4 * j + 7] * kb.w); }
                const float dot = d0 + d1;
                if (dot > v2) {
                    if (dot > v1) { v2 = v1; i2 = i1; if (dot > v0) { v1 = v0; i1 = i0; v0 = dot; i0 = n; } else { v1 = dot; i1 = n; } }
                    else { v2 = dot; i2 = n; }
                }
            }
            const int nsel = ob < 3 ? ob : 3;
#pragma unroll
            for (int j = 0; j < 3; ++j) if (j < nsel) { const int n = (j == 0) ? i0 : (j == 1) ? i1 : i2;
                const unsigned pos = atomicAdd(cnt + bh * 64 + n, 1u);
                list[list_off(bh, n) + pos] = ((unsigned)t << 2) | (unsigned)j; }
        }
        __syncthreads();
    }
}

__device__ __forceinline__ unsigned my_xcc_id() { return (unsigned)__builtin_amdgcn_s_getreg((3 << 11) | 20) & 7u; }
constexpr int CW_XQ = 3072;
constexpr int PER_X_FOX = 96, PER_X_SEL = 96, PER_X_OWN = 48, PER_X_DIL = 48, PER_X = PER_X_FOX + PER_X_SEL + PER_X_OWN + PER_X_DIL;
constexpr int NU_FOX = 768, NU_SEL = 768, NU_OWN = 384, NU_DIL = 384, NU_TOTAL = NU_FOX + NU_SEL + NU_OWN + NU_DIL;
__device__ __forceinline__ void attention_phase(CArgs a, int layer, LAS unsigned char* lds, char* lds_gen, int tid, int lane, int wave) {
    asm volatile("" : "+v"(tid), "+v"(lane));
    unsigned* ctl = (unsigned*)(a->ws + WS_CTL);
    unsigned* qctr = ctl + CW_QCTR + 64 * layer;
    const unsigned* cnt = ctl + CW_CNT + 1024 * layer;
    const unsigned* list = (const unsigned*)(a->ws + WS_LIST);
    volatile LAS unsigned* qw = (volatile LAS unsigned*)(lds + LDS_QW);
    LAS unsigned char* vscr = lds + wave * 9216;
    bf16_t* QCp = (bf16_t*)(a->ws + WS_QC); const bf16_t* KCp = (const bf16_t*)(a->ws + WS_KC); const bf16_t* VCp = (const bf16_t*)(a->ws + WS_VC);
    bf16_t* PO = (bf16_t*)(a->ws + WS_PO); float* PLSE = (float*)(a->ws + WS_PLSE);
    for (;;) {
        __syncthreads();
        if (tid == 0) *qw = atomicAdd(qctr, 1u);
        __syncthreads();
        const int u = (int)*qw;
        if (u >= NU_TOTAL) break;
        int lane_ = lane; asm volatile("" : "+v"(lane_)); const int r32 = lane_ & 31, hi = lane_ >> 5;
        if (u < NU_FOX) {
            const int qb = 63 - u / 12, bh = u % 12, b = bh / 6, h = bh % 6;
#ifdef FOX_SIMPLE
            {   const int t = 256 * qb + 32 * wave + r32; const size_t tok = (size_t)(b * SEQ + t);
                bf16_t* qrow = (bf16_t*)(a->ws + WS_QA) + tok * 384 + h * 64;
                const bf16_t* Kb = (const bf16_t*)(a->ws + WS_KA) + (size_t)(b * SEQ) * 384 + h * 64; const bf16_t* Vb = (const bf16_t*)(a->ws + WS_VA) + (size_t)(b * SEQ) * 384 + h * 64;
                f32x16 o[2]; float lse2;
                small_attn(qrow, 8 * qb + wave + 1, Kb, Vb, 384, 0, 1, 0, t, 1 << 29, vscr, lane, o, lse2, (const float*)(a->ws + WS_CUM) + (size_t)bh * SEQ);
                small_store(qrow, o, hi); }
#elif !defined(NO_FOX)
#ifdef PROBE_FOX2
            attn_body::attn_unit<24>(b, h, qb, (const attn_body::bf16*)(a->ws + WS_QA), (const attn_body::bf16*)(a->ws + WS_KA), (const attn_body::bf16*)(a->ws + WS_VA),
                                    (attn_body::bf16*)(a->ws + 487 * MiB), (const float*)(a->ws + WS_CUM) + (size_t)bh * SEQ, lds_gen);
#endif
            attn_body::attn_unit<24>(b, h, qb, (const attn_body::bf16*)(a->ws + WS_QA), (const attn_body::bf16*)(a->ws + WS_KA), (const attn_body::bf16*)(a->ws + WS_VA),
                                    (attn_body::bf16*)(a->ws + WS_QA), (const float*)(a->ws + WS_CUM) + (size_t)bh * SEQ, lds_gen);
#endif
        } else if (u < NU_FOX + NU_SEL) {
            const int v = u - NU_FOX, n = v / 12, bh = v % 12, b = bh / 6, h = bh % 6;
            int cn = (int)cnt[bh * 64 + n]; const int cap = (63 - n) * 256; cn = cn < cap ? cn : cap;
            const unsigned* lp = list + list_off(bh, n);
            const bf16_t* Kb = KCp + (size_t)(b * SEQ) * 384 + h * 64; const bf16_t* Vb = VCp + (size_t)(b * SEQ) * 384 + h * 64;
#ifdef PROBE_SMALL2
            for (int rep_ = 0; rep_ < 2; ++rep_)
#endif
            for (int c = wave; c * 64 < cn; c += NWAVES) {
                const int eA = c * 64 + r32, eB = eA + 32; const bool vA = eA < cn, vB = eB < cn;
                const unsigned entA = lp[vA ? eA : 0], entB = lp[vB ? eB : 0];
                const size_t tokA = (size_t)(b * SEQ + (int)(entA >> 2)), tokB = (size_t)(b * SEQ + (int)(entB >> 2)); const int slA = (int)(entA & 3), slB = (int)(entB & 3);
                f32x16 oA[2], oB[2]; float lsA, lsB;
                small_attn2(QCp + tokA * 384 + h * 64, QCp + tokB * 384 + h * 64, 8, Kb, Vb, 384, 0, 1, 256 * n, 1 << 28, 1 << 28, 1 << 29, vscr, lane, oA, oB, lsA, lsB);
                if (vA) { small_store(PO + ((tokA * 6 + h) * 4 + slA) * 64, oA, hi); if (hi == 0) PLSE[(tokA * 6 + h) * 4 + slA] = lsA; }
                if (vB) { small_store(PO + ((tokB * 6 + h) * 4 + slB) * 64, oB, hi); if (hi == 0) PLSE[(tokB * 6 + h) * 4 + slB] = lsB; }
            }
        } else if (u < NU_FOX + NU_SEL + NU_OWN) {
            const int v = u - NU_FOX - NU_SEL, bh = v / 32, pr = v % 32, b = bh / 6, h = bh % 6;
            const bf16_t* Kb = KCp + (size_t)(b * SEQ) * 384 + h * 64; const bf16_t* Vb = VCp + (size_t)(b * SEQ) * 384 + h * 64;
#ifdef PROBE_SMALL2
            for (int rep_ = 0; rep_ < 2; ++rep_)
#endif
            {
                const int blk = 2 * pr + (wave >> 2), w4 = wave & 3, chA = w4, chB = 7 - w4;
                const size_t tokA = (size_t)(b * SEQ + 256 * blk + 32 * chA + r32), tokB = (size_t)(b * SEQ + 256 * blk + 32 * chB + r32);
                f32x16 oA[2], oB[2]; float lsA, lsB;
                small_attn2(QCp + tokA * 384 + h * 64, QCp + tokB * 384 + h * 64, chB + 1, Kb, Vb, 384, 0, 1, 256 * blk, 32 * chA + r32, 32 * chB + r32, 1 << 29, vscr, lane, oA, oB, lsA, lsB);
                small_store(PO + ((tokA * 6 + h) * 4 + 3) * 64, oA, hi); if (hi == 0) PLSE[(tokA * 6 + h) * 4 + 3] = lsA;
                small_store(PO + ((tokB * 6 + h) * 4 + 3) * 64, oB, hi); if (hi == 0) PLSE[(tokB * 6 + h) * 4 + 3] = lsB;
            }
        } else {
            const int v = u - NU_FOX - NU_SEL - NU_OWN;
            for (int j2 = 0; j2 < 2; ++j2) {
            const int wu = ((v * NWAVES + wave) * 2 + j2) * 2;
            const int c512 = wu & 511, rest = wu >> 9, kvh = rest & 3, g = (rest >> 2) % 3, b = rest / 12;
            const int dil = g == 0 ? 1 : (g == 1 ? 4 : 16), cpc = 512 / dil;
            const int res = c512 / cpc, cidx = c512 % cpc, qc0 = 32 * cidx, qcA = qc0 + r32, qcB = qcA + 32;
            const size_t tokA = (size_t)(b * SEQ + qcA * dil + res), tokB = (size_t)(b * SEQ + qcB * dil + res);
            bf16_t* qrowA = (bf16_t*)(a->ws + WS_QB) + tokA * 768 + (g * 4 + kvh) * 64; bf16_t* qrowB = (bf16_t*)(a->ws + WS_QB) + tokB * 768 + (g * 4 + kvh) * 64;
            const bf16_t* Kb = (const bf16_t*)(a->ws + WS_KB) + (size_t)(b * SEQ) * 256 + kvh * 64; const bf16_t* Vb = (const bf16_t*)(a->ws + WS_VB) + (size_t)(b * SEQ) * 256 + kvh * 64;
            f32x16 oA[2], oB[2]; float lsA, lsB;
            small_attn2(qrowA, qrowB, 6, Kb, Vb, 256, qc0 - 128, dil, res, qcA, qcB, 128, vscr, lane, oA, oB, lsA, lsB);
            small_store(qrowA, oA, hi); small_store(qrowB, oB, hi);
            if (hi == 0) { float* L = (float*)(a->ws + WS_LSEB); L[((size_t)g * T + tokA) * 4 + kvh] = lsA; L[((size_t)g * T + tokB) * 4 + kvh] = lsB; }
            }
        }
    }
}

__device__ __forceinline__ void combine_phase(CArgs a, int tid) {
    asm volatile("" : "+v"(tid));
    const size_t gt = (size_t)blockIdx.x * (NWAVES * 64) + tid, gs = (size_t)gridDim.x * (NWAVES * 64);
    bf16_t* QBp = (bf16_t*)(a->ws + WS_QB); const float* LSEB = (const float*)(a->ws + WS_LSEB);
    for (size_t i = gt; i < (size_t)T * 32; i += gs) {
        const int ch = (int)(i & 7), kvh = (int)((i >> 3) & 3); const size_t tok = i >> 5;
        float l[3], w[3];
#pragma unroll
        for (int g = 0; g < 3; ++g) l[g] = LSEB[((size_t)g * T + tok) * 4 + kvh];
        const float mx = fmaxf(l[0], fmaxf(l[1], l[2]));
        float ws_ = 0.f;
#pragma unroll
        for (int g = 0; g < 3; ++g) { w[g] = __builtin_amdgcn_exp2f(l[g] - mx); ws_ += w[g]; }
        const float inv = 1.f / ws_;
        float y[8] = {0.f, 0.f, 0.f, 0.f, 0.f, 0.f, 0.f, 0.f};
#pragma unroll
        for (int g = 0; g < 3; ++g) { const u32x4 ow = *(const u32x4*)(QBp + tok * 768 + (g * 4 + kvh) * 64 + ch * 8); const float wg = w[g] * inv;
            y[0] += wg * bflo(ow.x); y[1] += wg * bfhi(ow.x); y[2] += wg * bflo(ow.y); y[3] += wg * bfhi(ow.y); y[4] += wg * bflo(ow.z); y[5] += wg * bfhi(ow.z); y[6] += wg * bflo(ow.w); y[7] += wg * bfhi(ow.w); }
        u32x4 r; r.x = cvt_pk_bf16(y[0], y[1]); r.y = cvt_pk_bf16(y[2], y[3]); r.z = cvt_pk_bf16(y[4], y[5]); r.w = cvt_pk_bf16(y[6], y[7]);
        *(u32x4*)(QBp + tok * 768 + kvh * 64 + ch * 8) = r;
    }
    bf16_t* QCp = (bf16_t*)(a->ws + WS_QC); const bf16_t* PO = (const bf16_t*)(a->ws + WS_PO); const float* PLSE = (const float*)(a->ws + WS_PLSE);
    for (size_t i = gt; i < (size_t)T * 48; i += gs) {
        const int ch = (int)(i & 7); const size_t th = i >> 3; const int h = (int)(th % 6); const size_t tok = th / 6;
        const int ob = (int)((tok % SEQ) >> 8), nsel = ob < 3 ? ob : 3;
        float l[4], w[4];
#pragma unroll
        for (int j = 0; j < 4; ++j) l[j] = (j == 3 || j < nsel) ? PLSE[th * 4 + j] : -INFINITY;
        const float mx = fmaxf(fmaxf(l[0], l[1]), fmaxf(l[2], l[3]));
        float ws_ = 0.f;
#pragma unroll
        for (int j = 0; j < 4; ++j) { w[j] = __builtin_amdgcn_exp2f(l[j] - mx); ws_ += w[j]; }
        const float inv = 1.f / ws_;
        float y[8] = {0.f, 0.f, 0.f, 0.f, 0.f, 0.f, 0.f, 0.f};
#pragma unroll
        for (int j = 0; j < 4; ++j) if (j == 3 || j < nsel) { const u32x4 ow = *(const u32x4*)(PO + (th * 4 + j) * 64 + ch * 8); const float wg = w[j] * inv;
            y[0] += wg * bflo(ow.x); y[1] += wg * bfhi(ow.x); y[2] += wg * bflo(ow.y); y[3] += wg * bfhi(ow.y); y[4] += wg * bflo(ow.z); y[5] += wg * bfhi(ow.z); y[6] += wg * bflo(ow.w); y[7] += wg * bfhi(ow.w); }
        u32x4 r; r.x = cvt_pk_bf16(y[0], y[1]); r.y = cvt_pk_bf16(y[2], y[3]); r.z = cvt_pk_bf16(y[4], y[5]); r.w = cvt_pk_bf16(y[6], y[7]);
        *(u32x4*)(QCp + tok * 384 + h * 64 + ch * 8) = r;
    }
}

#ifndef MIXER_ON
#define MIXER_ON 1
#endif
#define XB_TMO      128
#define XB_XCNT(j)  (256  + 64 * (j))
#define XB_XSUB(j)  (1280 + 64 * (j))
#define XB_XGEN(j)  (2304 + 64 * (j))
#define XB_TOP      3328
#define XB_TOPGEN   3392
#define XCD_BAR_WORDS 3456
#define XB_SPIN_CAP (1u << 18)

__device__ __forceinline__ unsigned xb_ld(unsigned* p)              { return __hip_atomic_load(p, __ATOMIC_RELAXED, __HIP_MEMORY_SCOPE_AGENT); }
__device__ __forceinline__ unsigned xb_add(unsigned* p, unsigned v) { return __hip_atomic_fetch_add(p, v, __ATOMIC_RELAXED, __HIP_MEMORY_SCOPE_AGENT); }
__device__ __forceinline__ unsigned xb_xcc_id() { return (unsigned)__builtin_amdgcn_s_getreg((3 << 11) | 20) & 0xFu; }
#define XB_SPIN(cond, bar) do { unsigned _sp = 0; while (cond) { __builtin_amdgcn_s_sleep(1); \
    if ((++_sp & 255u) == 0u) { if (xb_ld(&(bar)[XB_TMO])) break; if (_sp > XB_SPIN_CAP) { atomicAdd(&(bar)[XB_TMO], 1u); break; } } } } while (0)

struct XcdBarrier {
    unsigned* bar; unsigned x;
    volatile LAS unsigned* st;
};

__device__ __forceinline__ XcdBarrier xcd_barrier_post(unsigned* bar, volatile LAS unsigned* st) {
    XcdBarrier b; b.bar = bar; b.x = xb_xcc_id(); b.st = st;
    if (threadIdx.x == 0) (void)xb_add(&bar[XB_XCNT(b.x)], 1u);
    return b;
}
__device__ __forceinline__ void xcd_barrier_complete(unsigned* bar, unsigned x, unsigned& nloc, unsigned& nx) {
    const unsigned G = gridDim.x * gridDim.y * gridDim.z;
    unsigned sum, cnt, mine, sp = 0u;
    for (;;) {
        sum = 0u; cnt = 0u; mine = 0u;
#pragma unroll
        for (unsigned j = 0; j < 16; ++j) { const unsigned c = xb_ld(&bar[XB_XCNT(j)]); sum += c; cnt += (c > 0u) ? 1u : 0u; mine = (j == x) ? c : mine; }
        if (sum == G) break;
        __builtin_amdgcn_s_sleep(1);
        if ((++sp & 255u) == 0u) { if (xb_ld(&bar[XB_TMO])) break; if (sp > XB_SPIN_CAP) { atomicAdd(&bar[XB_TMO], 1u); break; } }
    }
    nloc = mine > 0u ? mine : 1u; nx = cnt > 0u ? cnt : 1u;
}

__device__ __forceinline__ void xcd_barrier(const XcdBarrier& b) {
    asm volatile("s_waitcnt vmcnt(0)" ::: "memory");
    __syncthreads();
    if (threadIdx.x == 0) {
        unsigned* bar = b.bar;
        __builtin_amdgcn_s_waitcnt(0);
        unsigned nloc = b.st[0], nx = b.st[1];
        if (nloc == 0u) { xcd_barrier_complete(bar, b.x, nloc, nx); b.st[0] = nloc; b.st[1] = nx; }
        const unsigned old = xb_add(&bar[XB_XSUB(b.x)], 1u);
        const unsigned gen = old / nloc;
        if (old + 1u == (gen + 1u) * nloc) {
            __builtin_amdgcn_fence(__ATOMIC_RELEASE, "agent");
            asm volatile("s_waitcnt vmcnt(0)" ::: "memory");
            const unsigned og = xb_add(&bar[XB_TOP], 1u);
            const unsigned tg = og / nx;
            if (og + 1u == (tg + 1u) * nx) xb_add(&bar[XB_TOPGEN], 1u);
            else XB_SPIN(xb_ld(&bar[XB_TOPGEN]) == tg, bar);
            __builtin_amdgcn_fence(__ATOMIC_ACQUIRE, "agent");
            xb_add(&bar[XB_XGEN(b.x)], 1u);
            asm volatile("s_waitcnt vmcnt(0)" ::: "memory");
        } else {
            XB_SPIN(xb_ld(&bar[XB_XGEN(b.x)]) == gen, bar);
            __builtin_amdgcn_fence(__ATOMIC_ACQUIRE, "agent");
            asm volatile("s_waitcnt vmcnt(0)" ::: "memory");
        }
    }
    __syncthreads();
}

constexpr int CW_BAR = 110016;
static_assert((CW_BAR + XCD_BAR_WORDS) * 4 <= (int)CTL_BYTES, "ctl");
#define GBX() int G = gridDim.x, bx = blockIdx.x; asm volatile("" : "+s"(G), "+s"(bx))
#define AP() ({ CArgs p_ = kp; asm volatile("" : "+s"(p_)); p_; }); GBX()
#define TIDS() int tid_ = threadIdx.x; asm volatile("" : "+v"(tid_)); const int tid = tid_, lane = tid & 63, wave = __builtin_amdgcn_readfirstlane(tid >> 6); (void)lane; (void)wave
#define XBP(a) ((bf16_t*)((a)->ws + WS_XB))
#define LFP(a) ((float*)((a)->ws + WS_LF))
#define STP(a) ((f32x2*)((a)->ws + 74 * MiB))
#define WLP(a) ((const bf16_t*)((a)->ws + WS_W) + (size_t)layer * W_LAYER)
template <int layer> __device__ __forceinline__ void layer_body(const CArgs kp, LAS unsigned char* lds, unsigned char* lds_raw, const XcdBarrier& bar) {
#if MIXER_ON
        { const CArgs a = AP(); TIDS(); if (bx < 12) scan_bh(LFP(a) + (size_t)bx * SEQ, (float*)(a->ws + WS_CUM) + (size_t)bx * SEQ, lds, tid, lane, wave); }
#ifndef NO_INPROJ
        { const CArgs a = AP(); pg8::StaticOrder S; pg8::Gemm g{XBP(a), WLP(a) + W_IN, 1024, 1024, 1024}; S.init(T, NQKV, G, bx);
          EpiInproj E{a->ws, (const f32x2*)(a->ws + WS_ROPE), (int*)((unsigned*)(a->ws + WS_CTL) + CW_KMEAN + 49152 * layer)};
          pg8::gemm_phase<EpiInproj, true>(lds, g, S, E);
#ifdef PROBE_DUP
          pg8::gemm_phase<EpiInproj, true>(lds, g, S, E);
#endif
 }
#endif
        xcd_barrier(bar);
#ifdef PROBE_BAR2
        xcd_barrier(bar);
#endif
#ifndef NO_GATING
        { const CArgs a = AP(); TIDS(); gating_phase(a, layer, lds, tid); }
#endif
        xcd_barrier(bar);
#ifdef PROBE_BAR2
        xcd_barrier(bar);
#endif
        { const CArgs a = AP(); TIDS(); attention_phase(a, layer, lds, (char*)lds_raw, tid, lane, wave); }
        xcd_barrier(bar);
#ifdef PROBE_BAR2
        xcd_barrier(bar);
#endif
        { const CArgs a = AP(); TIDS(); combine_phase(a, tid); }
        xcd_barrier(bar);
#ifdef PROBE_BAR2
        xcd_barrier(bar);
#endif
        {
            pg8::StaticOrder S; { GBX(); S.init(T, 1024, G, bx); }
            { const CArgs a = AP(); pg8::Gemm g{XBP(a), WLP(a) + W_G, 1024, 1024, 1024}; EpiGate E{(bf16_t*)(a->ws + WS_GS)}; pg8::gemm_phase<EpiGate, true>(lds, g, S, E); }
            { const CArgs a = AP(); pg8::Gemm g{(const bf16_t*)(a->ws + WS_QA), WLP(a) + W_PA, 384, 384, 384}; EpiBranch<1> E{(const bf16_t*)(a->ws + WS_GS), (bf16_t*)(a->ws + WS_MG)}; pg8::gemm_phase<EpiBranch<1>, true>(lds, g, S, E); }
#ifndef ONLY_A
            { const CArgs a = AP(); pg8::Gemm g{XBP(a), WLP(a) + W_G + (size_t)1024 * 1024, 1024, 1024, 1024}; EpiGate E{(bf16_t*)(a->ws + WS_GS)}; pg8::gemm_phase<EpiGate, true>(lds, g, S, E); }
            { const CArgs a = AP(); pg8::Gemm g{(const bf16_t*)(a->ws + WS_QB), WLP(a) + W_PB, 768, 256, 256}; EpiBranch<0> E{(const bf16_t*)(a->ws + WS_GS), (bf16_t*)(a->ws + WS_MG)}; pg8::gemm_phase<EpiBranch<0>, true>(lds, g, S, E); }
            { const CArgs a = AP(); pg8::Gemm g{XBP(a), WLP(a) + W_G + (size_t)2048 * 1024, 1024, 1024, 1024}; EpiGate E{(bf16_t*)(a->ws + WS_GS)}; pg8::gemm_phase<EpiGate, true>(lds, g, S, E); }
            { const CArgs a = AP(); pg8::Gemm g{(const bf16_t*)(a->ws + WS_QC), WLP(a) + W_PC, 384, 384, 384}; EpiBranch<0> E{(const bf16_t*)(a->ws + WS_GS), (bf16_t*)(a->ws + WS_MG)}; pg8::gemm_phase<EpiBranch<0>, true>(lds, g, S, E); }
#endif
        }
#ifdef PROBE_P5
        {
            pg8::StaticOrder S; { GBX(); S.init(T, 1024, G, bx); }
            { const CArgs a = AP(); pg8::Gemm g{XBP(a), WLP(a) + W_G, 1024, 1024, 1024}; EpiGate E{(bf16_t*)(a->ws + WS_GS)}; pg8::gemm_phase<EpiGate, true>(lds, g, S, E); }
            { const CArgs a = AP(); pg8::Gemm g{(const bf16_t*)(a->ws + WS_QA), WLP(a) + W_PA, 384, 384, 384}; EpiBranch<1> E{(const bf16_t*)(a->ws + WS_GS), (bf16_t*)(a->ws + WS_MG)}; pg8::gemm_phase<EpiBranch<1>, true>(lds, g, S, E); }
#ifndef ONLY_A
            { const CArgs a = AP(); pg8::Gemm g{XBP(a), WLP(a) + W_G + (size_t)1024 * 1024, 1024, 1024, 1024}; EpiGate E{(bf16_t*)(a->ws + WS_GS)}; pg8::gemm_phase<EpiGate, true>(lds, g, S, E); }
            { const CArgs a = AP(); pg8::Gemm g{(const bf16_t*)(a->ws + WS_QB), WLP(a) + W_PB, 768, 256, 256}; EpiBranch<0> E{(const bf16_t*)(a->ws + WS_GS), (bf16_t*)(a->ws + WS_MG)}; pg8::gemm_phase<EpiBranch<0>, true>(lds, g, S, E); }
            { const CArgs a = AP(); pg8::Gemm g{XBP(a), WLP(a) + W_G + (size_t)2048 * 1024, 1024, 1024, 1024}; EpiGate E{(bf16_t*)(a->ws + WS_GS)}; pg8::gemm_phase<EpiGate, true>(lds, g, S, E); }
            { const CArgs a = AP(); pg8::Gemm g{(const bf16_t*)(a->ws + WS_QC), WLP(a) + W_PC, 384, 384, 384}; EpiBranch<0> E{(const bf16_t*)(a->ws + WS_GS), (bf16_t*)(a->ws + WS_MG)}; pg8::gemm_phase<EpiBranch<0>, true>(lds, g, S, E); }
#endif
        }
#endif
        xcd_barrier(bar);
#ifdef PROBE_BAR2
        xcd_barrier(bar);
#endif
        { const CArgs a = AP(); pg8::StaticOrder S; pg8::Gemm g{(const bf16_t*)(a->ws + WS_MG), WLP(a) + W_O, 1024, 1024, 1024}; S.init(T, 1024, G, bx);
          EpiResid E{layer == 0 ? a->in[0] : (const float*)a->out, a->out, STP(a), layer == 0 ? a->in[1] : a->in[14] + (layer - 1) * DM, layer == 0 ? a->in[2] : a->in[15] + (layer - 1) * DM};
          pg8::gemm_phase<EpiResid, true>(lds, g, S, E); }
        xcd_barrier(bar);
#ifdef PROBE_BAR2
        xcd_barrier(bar);
#endif
#else
        {
            const CArgs a = AP(); TIDS();
            for (size_t i = (size_t)bx * 512 + tid; i < (size_t)T * DM / 4; i += (size_t)G * 512) { f32x4* p = (f32x4*)a->out + i; *p = *p * DN_ALPHA; }
        }
        xcd_barrier(bar);
#ifdef PROBE_BAR2
        xcd_barrier(bar);
#endif
#endif
        { const CArgs a = AP(); TIDS(); ln_phase(a->out, a->in[9] + layer * DM, a->in[10] + layer * DM, a->out, STP(a), XBP(a), nullptr, nullptr, nullptr, lds, tid, lane, wave);
#ifdef PROBE_P0LN
          ln_phase(a->out, a->in[9] + layer * DM, a->in[10] + layer * DM, a->out, STP(a), XBP(a), nullptr, nullptr, nullptr, lds, tid, lane, wave);
#endif
 }
        xcd_barrier(bar);
#ifdef PROBE_BAR2
        xcd_barrier(bar);
#endif
#ifndef NO_P8
        { const CArgs a = AP(); pg8::StaticOrder S; pg8::Gemm g{XBP(a), WLP(a) + W_GU, 1024, 1024, 1024}; S.init(T, 2 * DFF, G, bx); EpiSwiglu E{(bf16_t*)(a->ws + WS_H)}; pg8::gemm_phase<EpiSwiglu, true>(lds, g, S, E);
#ifdef PROBE_DUP
          pg8::gemm_phase<EpiSwiglu, true>(lds, g, S, E);
#endif
 }
#endif
        xcd_barrier(bar);
#ifdef PROBE_BAR2
        xcd_barrier(bar);
#endif
#ifndef NO_P9
        { const CArgs a = AP(); pg8::StaticOrder S; pg8::Gemm g{(const bf16_t*)(a->ws + WS_H), WLP(a) + W_D, DFF, DFF, DFF}; S.init(T, 1024, G, bx); EpiResid E{a->out, a->out, STP(a), a->in[9] + layer * DM, a->in[10] + layer * DM}; pg8::gemm_phase<EpiResid, true>(lds, g, S, E); }
#endif
        xcd_barrier(bar);
#ifdef PROBE_BAR2
        xcd_barrier(bar);
#endif
        if (layer + 1 < DEPTH) {
            { const CArgs a = AP(); TIDS(); ln_phase(a->out, a->in[14] + layer * DM, a->in[15] + layer * DM, a->out, STP(a), XBP(a), a->in[3] + (size_t)(layer + 1) * 1024 * DIN, a->in[4] + (layer + 1) * 6, LFP(a), lds, tid, lane, wave);
#ifdef PROBE_P0LN
              ln_phase(a->out, a->in[14] + layer * DM, a->in[15] + layer * DM, a->out, STP(a), XBP(a), a->in[3] + (size_t)(layer + 1) * 1024 * DIN, a->in[4] + (layer + 1) * 6, LFP(a), lds, tid, lane, wave);
#endif
 }
            xcd_barrier(bar);
#ifdef PROBE_BAR2
        xcd_barrier(bar);
#endif
        } else {
            const CArgs a = AP(); TIDS(); ln_phase(a->out, a->in[14] + layer * DM, a->in[15] + layer * DM, a->out, nullptr, XBP(a), nullptr, nullptr, nullptr, lds, tid, lane, wave);
        }
}

__global__ void __launch_bounds__(NWAVES * 64, 2) fwd_kernel(Args a_unused) {
    extern __shared__ __attribute__((aligned(16))) unsigned char lds_raw[];
    cg::grid_group grid = cg::this_grid();
    LAS unsigned char* lds = (LAS unsigned char*)lds_raw;
    const CArgs kp = (CArgs)__builtin_amdgcn_kernarg_segment_ptr();
    if (threadIdx.x < 16) ((LAS unsigned*)(lds + LDS_QW + 64))[threadIdx.x] = 0u;
    __syncthreads();
    const XcdBarrier bar = xcd_barrier_post((unsigned*)(kp->ws + WS_CTL) + CW_BAR, (volatile LAS unsigned*)(lds + LDS_QW + 64));

    {
        const CArgs a = AP(); TIDS();
        LAS float* scr = (LAS float*)(lds + wave * 16384);
        for (int it = bx * NWAVES + wave; it < 2 * IT_LAYER; it += G * NWAVES) prologue_item(a, it, scr, lane);
        f32x2* rope = (f32x2*)(a->ws + WS_ROPE);
        for (int i = bx * (NWAVES * 64) + tid; i < SEQ * 8; i += G * NWAVES * 64) {
            const int pos = i >> 3, fi = i & 7; double t = (double)pos * ROPE_FR[fi]; t -= floor(t); const float fr = (float)t;
            rope[i] = (f32x2){__builtin_amdgcn_cosf(fr), __builtin_amdgcn_sinf(fr)};
        }
        __syncthreads();
        ln_phase(a->in[0], a->in[1], a->in[2], a->out, STP(a), XBP(a), a->in[3], a->in[4], LFP(a), lds, tid, lane, wave);
#ifdef PROBE_P0LN
        for (int it = bx * NWAVES + wave; it < 2 * IT_LAYER; it += G * NWAVES) prologue_item(a, it, scr, lane);
        __syncthreads();
        ln_phase(a->in[0], a->in[1], a->in[2], a->out, STP(a), XBP(a), a->in[3], a->in[4], LFP(a), lds, tid, lane, wave);
#endif
    }
    grid.sync();

    layer_body<0>(kp, lds, lds_raw, bar);
    layer_body<1>(kp, lds, lds_raw, bar);
}

extern "C" void kernel_launch(void* const* d_in, const int* in_sizes, int n_in, void* d_out, int out_size, void* d_ws, size_t ws_size, hipStream_t stream) {
    static int grid = 0;
    if (grid == 0) {
        if (n_in != 16 || in_sizes[0] != T * DM || out_size != T * DM || ws_size < WS_END) {
            fprintf(stderr, "kernel_launch: unexpected problem geometry (n_in %d, in0 %d, out %d, ws %zu)\n", n_in, n_in > 0 ? in_sizes[0] : -1, out_size, ws_size); grid = -1; return; }
        int dev = 0, cus = 0, per_cu = 0;
        (void)hipGetDevice(&dev); (void)hipDeviceGetAttribute(&cus, hipDeviceAttributeMultiprocessorCount, dev);
        if (hipFuncSetAttribute((const void*)fwd_kernel, hipFuncAttributeMaxDynamicSharedMemorySize, LDS_BYTES) != hipSuccess) { fprintf(stderr, "kernel_launch: hipFuncSetAttribute failed\n"); grid = -1; return; }
        if (hipOccupancyMaxActiveBlocksPerMultiprocessor(&per_cu, (const void*)fwd_kernel, NWAVES * 64, LDS_BYTES) != hipSuccess || per_cu < 1) { fprintf(stderr, "kernel_launch: occupancy query says %d\n", per_cu); per_cu = 1; }
        (void)hipGetLastError();
        grid = cus * 1;
        if (grid % 8 != 0 || grid <= 0) grid = 256;
    }
    if (grid < 0) return;
    (void)hipMemsetAsync((char*)d_ws + WS_CTL, 0, CTL_BYTES, stream);
    Args a{};
    for (int i = 0; i < 16; ++i) a.in[i] = (const float*)d_in[i];
    a.out = (float*)d_out; a.ws = (unsigned char*)d_ws;
    void* args[] = {&a};
    const hipError_t e = hipLaunchCooperativeKernel((const void*)fwd_kernel, dim3(grid), dim3(NWAVES * 64), args, LDS_BYTES, stream);
    if (e != hipSuccess) fprintf(stderr, "kernel_launch: cooperative launch failed: %s (grid %d)\n", hipGetErrorString(e), grid);
}
```
